# Optimizing an MI355X kernel written in HIP

```python
import jax
import jax.numpy as jnp
from jax import lax
import numpy as np

D_MODEL = 1024
BATCH = 4
SEQ = 4096
DEPTH = 4

GRID_W = 64
CTX_LEN = 256
D_MIX = D_MODEL
N_MIXERS = 4
W_GROUP = D_MIX // N_MIXERS
LRU_HEADS = 4
LRU_HD = W_GROUP // LRU_HEADS
LRU_C = 8.0
CONV_A_PAD = (2, 1)
POOL_WINDOWS = (2, 4, 8, 16)
POOL_HD = W_GROUP // len(POOL_WINDOWS)
CONV_C_PAD = (1, 1)
SGU_CHUNK = 128
SGU_HEADS = 4
SGU_HD = W_GROUP // SGU_HEADS
PROJ_SLABS = 8
PROJ_DIM = PROJ_SLABS * W_GROUP
PROJ_SPLITS = tuple(W_GROUP * k for k in range(1, PROJ_SLABS))
N_KEYS = 128
N_EXPERTS = N_KEYS * N_KEYS
PEER_HEADS = 8
PEER_QDIM = 256
PEER_HALF = PEER_QDIM // 2
PEER_TOPK = 16
PEER_BLOCK = 128
N_MOD = 6
EPS = 1e-6
POS_BASE = 10000.0

kernel_name = 'hybrid_lru_pool_conv_sgu_peer_dit'


def rmsnorm(x, g):
    xf = x.astype(jnp.float32)
    y = xf * lax.rsqrt(jnp.mean(xf * xf, axis=-1, keepdims=True) + EPS)
    return (y * g.astype(jnp.float32)).astype(x.dtype)


def layernorm(x, g):
    xf = x.astype(jnp.float32)
    xc = xf - jnp.mean(xf, axis=-1, keepdims=True)
    var = jnp.mean(xc * xc, axis=-1, keepdims=True)
    return (xc * lax.rsqrt(var + EPS) * g.astype(jnp.float32)).astype(x.dtype)


def modulate(x, shift, scale):
    return x * (1 + scale) + shift


def grid_sincos(n, dim, dtype):
    rows = n // GRID_W
    row = jnp.repeat(jnp.arange(rows, dtype=jnp.float32), GRID_W)
    col = jnp.tile(jnp.arange(GRID_W, dtype=jnp.float32), rows)
    quarter = dim // 4
    omega = POS_BASE ** (-jnp.arange(quarter, dtype=jnp.float32) / quarter)

    def axis_emb(p):
        ang = p[:, None] * omega[None, :]
        return jnp.concatenate([jnp.sin(ang), jnp.cos(ang)], axis=-1)

    return jnp.concatenate([axis_emb(row), axis_emb(col)], axis=-1).astype(dtype)


def dwconv(x, w, pad):
    return lax.conv_general_dilated(
        x, w[:, None, :].astype(x.dtype), window_strides=(1,), padding=[pad],
        dimension_numbers=('NWC', 'WIO', 'NWC'), feature_group_count=x.shape[-1])


def blockdiag(x, w, b):
    bsz, n, _ = x.shape
    xh = x.reshape(bsz, n, LRU_HEADS, LRU_HD)
    return (jnp.einsum('bnhi,hij->bnhj', xh, w) + b).reshape(bsz, n, LRU_HEADS * LRU_HD)


def linear_scan(a, b, h0):
    def combine(left, right):
        a1, b1 = left
        a2, b2 = right
        return a1 * a2, a2 * b1 + b2

    a_cum, b_cum = lax.associative_scan(combine, (a, b), axis=1)
    return a_cum * h0[:, None, :] + b_cum


def rglru_bidir(xa, lam, w_r, b_r, w_i, b_i, h0_f, h0_b):
    xf = xa.astype(jnp.float32)
    hs, finals = [], []
    for d, h0 in enumerate((h0_f, h0_b)):
        r = jax.nn.sigmoid(blockdiag(xa, w_r[d], b_r[d]).astype(jnp.float32))
        i = jax.nn.sigmoid(blockdiag(xa, w_i[d], b_i[d]).astype(jnp.float32))
        log_a = -LRU_C * r * jax.nn.softplus(-lam[d].astype(jnp.float32))
        a = jnp.exp(log_a)
        b = jnp.sqrt(-jnp.expm1(2.0 * log_a)) * (i * xf)
        if d == 1:
            a, b = jnp.flip(a, axis=1), jnp.flip(b, axis=1)
        h = linear_scan(a, b, h0)
        finals.append(h[:, -1])
        hs.append(jnp.flip(h, axis=1) if d == 1 else h)
    return hs[0] + hs[1], finals[0], finals[1]


def pool_mixer(x, w, scale):
    bsz, n, _ = x.shape
    xf = x.astype(jnp.float32)
    cs = jnp.pad(jnp.cumsum(xf, axis=1), ((0, 0), (1, 0), (0, 0)))
    t = jnp.arange(n)
    diffs = []
    for gi, win in enumerate(POOL_WINDOWS):
        lo = jnp.clip(t - win // 2, 0, n)
        hi = jnp.clip(t - win // 2 + win, 0, n)
        sl = slice(gi * POOL_HD, (gi + 1) * POOL_HD)
        cg = cs[:, :, sl]
        mean = (cg[:, hi] - cg[:, lo]) / (hi - lo).astype(jnp.float32)[None, :, None]
        diffs.append(mean - xf[:, :, sl])
    d = jnp.stack(diffs, axis=2).astype(x.dtype)
    y = jnp.einsum('bngi,gij->bngj', d, w).reshape(bsz, n, W_GROUP)
    return y * scale


def sgu(u, v, g, w_s, b_s):
    bsz, n, _ = u.shape
    u = jax.nn.gelu(u)
    v = layernorm(jax.nn.gelu(v), g)
    vc = v.reshape(bsz, n // SGU_CHUNK, SGU_CHUNK, SGU_HEADS, SGU_HD)
    mixed = jnp.einsum('bcphe,hqp->bcqhe', vc, w_s) + b_s.T[:, :, None]
    return u * mixed.reshape(bsz, n, W_GROUP)


def token_mix(p, lp, h0_f, h0_b):
    ax, ag, bx, cb, cc, ch, du, dv = jnp.split(p, PROJ_SPLITS, axis=-1)
    xa = dwconv(ax, lp['conv_a_w'], CONV_A_PAD) + lp['conv_a_b']
    h, fin_f, fin_b = rglru_bidir(xa, lp['lru_l'], lp['lru_wr'], lp['lru_br'],
                                  lp['lru_wi'], lp['lru_bi'], h0_f, h0_b)
    y_a = h.astype(ag.dtype) * jax.nn.gelu(ag)
    y_b = pool_mixer(bx, lp['pool_w'], lp['pool_scale'])
    y_c = cb * dwconv(cc * ch, lp['conv_c_w'], CONV_C_PAD)
    y_d = sgu(du, dv, lp['sgu_g'], lp['sgu_w'], lp['sgu_b'])
    return jnp.concatenate([y_a, y_b, y_c, y_d], axis=-1), fin_f, fin_b


def peer_ffn(tok, wq, k1, k2, u_tab, v_tab):
    n_tok, dim = tok.shape
    blocks = tok.reshape(n_tok // PEER_BLOCK, PEER_BLOCK, dim)

    def one_block(xb):
        q = (xb @ wq).reshape(PEER_BLOCK, PEER_HEADS, PEER_QDIM).astype(jnp.float32)
        s1 = jnp.einsum('thk,nk->thn', q[..., :PEER_HALF], k1.astype(jnp.float32))
        s2 = jnp.einsum('thk,nk->thn', q[..., PEER_HALF:], k2.astype(jnp.float32))
        v1, i1 = lax.top_k(s1, PEER_TOPK)
        v2, i2 = lax.top_k(s2, PEER_TOPK)
        cand = (v1[..., :, None] + v2[..., None, :]).reshape(PEER_BLOCK, PEER_HEADS, PEER_TOPK * PEER_TOPK)
        vs, ic = lax.top_k(cand, PEER_TOPK)
        e = (jnp.take_along_axis(i1, ic // PEER_TOPK, axis=-1) * N_KEYS
             + jnp.take_along_axis(i2, ic % PEER_TOPK, axis=-1))
        gate = jax.nn.softmax(vs, axis=-1)
        ue = u_tab[e]
        act = jax.nn.gelu(jnp.einsum('thkd,td->thk', ue, xb).astype(jnp.float32)) * gate
        ve = v_tab[e]
        return jnp.einsum('thk,thkd->td', act.astype(xb.dtype), ve)

    return lax.map(one_block, blocks).reshape(n_tok, dim)


def setup_inputs(seed: int = 0) -> dict:
    key = jax.random.key(seed)
    ks = jax.random.split(key, 32)

    def nrm(k, shape, std):
        return jax.random.normal(k, shape, jnp.float32) * std

    u = jax.random.uniform(ks[11], (DEPTH, 2, W_GROUP), jnp.float32, minval=0.9, maxval=0.999)
    s = u ** (1.0 / LRU_C)
    lru_l = jnp.log(s) - jnp.log1p(-s)
    return {
        'x': nrm(ks[0], (BATCH, SEQ, D_MODEL), 1.0),
        'c': nrm(ks[1], (BATCH, D_MODEL), 1.0),
        'ctx': nrm(ks[2], (BATCH, CTX_LEN, D_MODEL), 1.0),
        'c_ctx': nrm(ks[3], (D_MODEL,), 1.0),
        'w_ada': nrm(ks[4], (DEPTH, D_MODEL, N_MOD * D_MODEL), 0.5 * D_MODEL ** -0.5),
        'b_ada': nrm(ks[5], (DEPTH, N_MOD * D_MODEL), 0.01),
        'g_mix': 1.0 + nrm(ks[6], (DEPTH, D_MODEL), 0.02),
        'g_ffn': 1.0 + nrm(ks[7], (DEPTH, D_MODEL), 0.02),
        'w_in': nrm(ks[8], (DEPTH, D_MODEL, PROJ_DIM), D_MODEL ** -0.5),
        'w_out': nrm(ks[9], (DEPTH, D_MIX, D_MODEL), D_MIX ** -0.5),
        'conv_a_w': nrm(ks[10], (DEPTH, 4, W_GROUP), 0.5),
        'conv_a_b': nrm(ks[12], (DEPTH, W_GROUP), 0.01),
        'lru_l': lru_l,
        'lru_wr': nrm(ks[13], (DEPTH, 2, LRU_HEADS, LRU_HD, LRU_HD), LRU_HD ** -0.5),
        'lru_br': nrm(ks[14], (DEPTH, 2, LRU_HEADS, LRU_HD), 0.01),
        'lru_wi': nrm(ks[15], (DEPTH, 2, LRU_HEADS, LRU_HD, LRU_HD), LRU_HD ** -0.5),
        'lru_bi': nrm(ks[16], (DEPTH, 2, LRU_HEADS, LRU_HD), 0.01),
        'pool_w': nrm(ks[17], (DEPTH, len(POOL_WINDOWS), POOL_HD, POOL_HD), POOL_HD ** -0.5),
        'pool_scale': 1.0 + nrm(ks[18], (DEPTH, W_GROUP), 0.02),
        'conv_c_w': nrm(ks[19], (DEPTH, 3, W_GROUP), 3 ** -0.5),
        'sgu_g': 1.0 + nrm(ks[20], (DEPTH, W_GROUP), 0.02),
        'sgu_w': nrm(ks[21], (DEPTH, SGU_HEADS, SGU_CHUNK, SGU_CHUNK), SGU_CHUNK ** -0.5),
        'sgu_b': 1.0 + nrm(ks[22], (DEPTH, SGU_HEADS, SGU_CHUNK), 0.01),
        'peer_wq': nrm(ks[23], (DEPTH, D_MODEL, PEER_HEADS * PEER_QDIM), D_MODEL ** -0.5),
        'peer_k1': nrm(ks[24], (DEPTH, N_KEYS, PEER_HALF), PEER_HALF ** -0.5),
        'peer_k2': nrm(ks[25], (DEPTH, N_KEYS, PEER_HALF), PEER_HALF ** -0.5),
        'peer_u': nrm(ks[26], (DEPTH, N_EXPERTS, D_MODEL), D_MODEL ** -0.5),
        'peer_v': nrm(ks[27], (DEPTH, N_EXPERTS, D_MODEL), 1.0),
        'g_final': 1.0 + nrm(ks[28], (D_MODEL,), 0.02),
    }


def reference(x, c, ctx, c_ctx, w_ada, b_ada, g_mix, g_ffn, w_in, w_out, conv_a_w, conv_a_b,
              lru_l, lru_wr, lru_br, lru_wi, lru_bi, pool_w, pool_scale, conv_c_w,
              sgu_g, sgu_w, sgu_b, peer_wq, peer_k1, peer_k2, peer_u, peer_v, g_final):
    bsz, n, dim = x.shape
    pos = grid_sincos(n, dim, x.dtype)
    z_x, z_c = x, ctx
    h0 = jnp.zeros((ctx.shape[0], W_GROUP), jnp.float32)
    for l in range(DEPTH):
        last = l == DEPTH - 1
        lp = {'conv_a_w': conv_a_w[l], 'conv_a_b': conv_a_b[l], 'lru_l': lru_l[l],
              'lru_wr': lru_wr[l], 'lru_br': lru_br[l], 'lru_wi': lru_wi[l], 'lru_bi': lru_bi[l],
              'pool_w': pool_w[l], 'pool_scale': pool_scale[l], 'conv_c_w': conv_c_w[l],
              'sgu_g': sgu_g[l], 'sgu_w': sgu_w[l], 'sgu_b': sgu_b[l]}
        mod_x = jnp.split(jax.nn.silu(c) @ w_ada[l] + b_ada[l], N_MOD, axis=-1)
        mod_c = jnp.split(jax.nn.silu(c_ctx)[None] @ w_ada[l] + b_ada[l], N_MOD, axis=-1)
        sh1x, sc1x, g1x, sh2x, sc2x, g2x = [m[:, None, :] for m in mod_x]
        sh1c, sc1c, g1c, sh2c, sc2c, g2c = [m[:, None, :] for m in mod_c]

        a_x = modulate(rmsnorm(z_x, g_mix[l]), sh1x, sc1x) + pos
        a_c = modulate(rmsnorm(z_c, g_mix[l]), sh1c, sc1c)
        if last:
            xa_c = dwconv(a_c @ w_in[l][:, :W_GROUP], lp['conv_a_w'], CONV_A_PAD) + lp['conv_a_b']
            _, fin_f, fin_b = rglru_bidir(xa_c, lp['lru_l'], lp['lru_wr'], lp['lru_br'],
                                          lp['lru_wi'], lp['lru_bi'], h0, h0)
        else:
            y_c, fin_f, fin_b = token_mix(a_c @ w_in[l], lp, h0, h0)
            z_c = z_c + g1c * (y_c @ w_out[l])
        y_x, _, _ = token_mix(a_x @ w_in[l], lp, fin_f, fin_b)
        z_x = z_x + g1x * (y_x @ w_out[l])

        f_x = modulate(rmsnorm(z_x, g_ffn[l]), sh2x, sc2x)
        if last:
            out_x = peer_ffn(f_x.reshape(-1, dim), peer_wq[l], peer_k1[l], peer_k2[l], peer_u[l], peer_v[l])
            z_x = z_x + g2x * out_x.reshape(bsz, n, dim)
        else:
            f_c = modulate(rmsnorm(z_c, g_ffn[l]), sh2c, sc2c)
            n_c = z_c.shape[0] * z_c.shape[1]
            tok = jnp.concatenate([f_c.reshape(-1, dim), f_x.reshape(-1, dim)], axis=0)
            out = peer_ffn(tok, peer_wq[l], peer_k1[l], peer_k2[l], peer_u[l], peer_v[l])
            z_c = z_c + g2c * out[:n_c].reshape(z_c.shape)
            z_x = z_x + g2x * out[n_c:].reshape(bsz, n, dim)
    return rmsnorm(z_x, g_final)
```

```cpp
#include <hip/hip_runtime.h>
#include <cstdio>
#include <cstdint>

#ifndef MK_SINGLE
#define MK_SINGLE 1
#endif

namespace pg8 {
#define PG8_LAS __attribute__((address_space(3)))
typedef unsigned short bf16_t;
typedef short bf16x8 __attribute__((ext_vector_type(8)));
typedef float f32x4 __attribute__((ext_vector_type(4)));
typedef unsigned u32x4 __attribute__((ext_vector_type(4)));
constexpr int BM = 256, BK = 64, HALF = 128, HTB = HALF * BK * 2  , STAGE_BYTES = 8 * HTB, NXCD = 8, WGM = 8;

__host__ __device__ __forceinline__ int lds_byte(int r, int c) { const int st = (r >> 4) * 2 + (c >> 5), rr = r & 15, cc = c & 31, ob = rr * 64 + cc * 2; return st * 1024 + (ob ^ (((ob >> 9) & 1) << 5)); }
__host__ __device__ __forceinline__ void stage_rc(int b, int& R, int& C) { const int st = b / 1024, sb = b % 1024, swz = sb ^ (((sb >> 9) & 1) << 5); R = (st >> 1) * 16 + swz / 64; C = (st & 1) * 32 + (swz % 64) / 2; }
__host__ __device__ __forceinline__ int perm32(int rho) { const int n = rho >> 4, i = rho & 15; return 8 * (i >> 2) + 4 * n + (i & 3); }

struct Unit { int pm, pn; };
struct Gemm { const bf16_t* A; const bf16_t* Bt; int M, N, K; };

struct StaticOrder {
    int nM, nN, nwg, G, c;
    __host__ __device__ void init(int M, int N, int G_, int c_) { nM = M / BM; nN = N / BM; nwg = nM * nN; G = G_; c = c_; }
    __host__ __device__ bool next(int i, Unit& u) const {
        const long L = (long)i * G + c; if (L >= nwg) return false;
        int wgid = (int)L; { const int q = nwg / NXCD, r = nwg % NXCD, xcd = wgid % NXCD, off = wgid / NXCD; wgid = (xcd < r ? xcd * (q + 1) : r * (q + 1) + (xcd - r) * q) + off; }
        const int nig = WGM * nN, gid = wgid / nig, fm = gid * WGM, gsz = (nM - fm) < WGM ? (nM - fm) : WGM;
        u.pm = fm + ((wgid % nig) % gsz); u.pn = (wgid % nig) / gsz; return true;
    }
    __device__ __forceinline__ void a_ready(const Unit&) const {}
    __device__ __forceinline__ void done(const Unit&) const {}
};

__device__ __forceinline__ unsigned cvt_pk_bf16(float lo, float hi) { unsigned r; asm volatile("v_cvt_pk_bf16_f32 %0, %1, %2" : "=v"(r) : "v"(lo), "v"(hi)); return r; }

struct EpiBf16 {
    static constexpr bool PERM = true, AFTER_DRAIN = false;
    bf16_t* O; int ldc;
    __device__ __forceinline__ void operator()(const f32x4 (&acc)[2][2][4][2], const Unit& u, int wr, int wc, int fr, int fq) const {
        const int row0 = u.pm * BM + wr * 64 + fr; const int col0 = u.pn * BM + wc * 32 + 8 * fq;
#pragma unroll
        for (int ai = 0; ai < 2; ++ai)
#pragma unroll
            for (int m = 0; m < 4; ++m) { bf16_t* rowp = O + (size_t)(row0 + ai * HALF + m * 16) * ldc + col0;
#pragma unroll
                for (int bj = 0; bj < 2; ++bj) { const f32x4 v0 = acc[ai][bj][m][0], v1 = acc[ai][bj][m][1];
                    u32x4 w; w.x = cvt_pk_bf16(v0[0], v0[1]); w.y = cvt_pk_bf16(v0[2], v0[3]); w.z = cvt_pk_bf16(v1[0], v1[1]); w.w = cvt_pk_bf16(v1[2], v1[3]);
                    *(u32x4*)(rowp + bj * HALF) = w; } }
    }
};
struct EpiF32 {
    static constexpr bool PERM = false, AFTER_DRAIN = false;
    float* C; int ldc;
    __device__ __forceinline__ void operator()(const f32x4 (&acc)[2][2][4][2], const Unit& u, int wr, int wc, int fr, int fq) const {
        const int row0 = u.pm * BM + wr * 64 + fr, col0 = u.pn * BM + wc * 32 + 4 * fq;
#pragma unroll
        for (int ai = 0; ai < 2; ++ai)
#pragma unroll
            for (int m = 0; m < 4; ++m) { float* rowp = C + (size_t)(row0 + ai * HALF + m * 16) * ldc + col0;
#pragma unroll
                for (int bj = 0; bj < 2; ++bj)
#pragma unroll
                    for (int n = 0; n < 2; ++n) *(f32x4*)(rowp + bj * HALF + n * 16) = acc[ai][bj][m][n]; }
    }
};
struct EpiResid {
    static constexpr bool PERM = true, AFTER_DRAIN = false;
    unsigned short* Z; int ldc; const float* gate0; int gstride; int pmoff;
    __device__ __forceinline__ void operator()(const f32x4 (&acc)[2][2][4][2], const Unit& u, int wr, int wc, int fr, int fq) const {
        const int row0 = u.pm * BM + wr * 64 + fr, col0 = u.pn * BM + wc * 32 + 8 * fq;
        const int pmg = u.pm + pmoff; const int mr = (pmg < 4) ? 4 : ((pmg - 4) >> 4);
        const float* gp = gate0 + (size_t)mr * gstride + col0;
        f32x4 gv[2][2];
#pragma unroll
        for (int bj = 0; bj < 2; ++bj)
#pragma unroll
            for (int n = 0; n < 2; ++n) gv[bj][n] = *(const f32x4*)(gp + bj * HALF + n * 4);
#pragma unroll
        for (int ai = 0; ai < 2; ++ai) {
            u32x4 zv[4][2];
#pragma unroll
            for (int m = 0; m < 4; ++m)
#pragma unroll
                for (int bj = 0; bj < 2; ++bj) zv[m][bj] = *(const u32x4*)(Z + (size_t)(row0 + ai * HALF + m * 16) * ldc + col0 + bj * HALF);
#pragma unroll
            for (int m = 0; m < 4; ++m)
#pragma unroll
                for (int bj = 0; bj < 2; ++bj) { const u32x4 z = zv[m][bj]; const f32x4 a0 = acc[ai][bj][m][0] * gv[bj][0], a1 = acc[ai][bj][m][1] * gv[bj][1];
                    u32x4 w;
                    w.x = cvt_pk_bf16(__builtin_bit_cast(float, z.x << 16) + a0[0], __builtin_bit_cast(float, z.x & 0xffff0000u) + a0[1]);
                    w.y = cvt_pk_bf16(__builtin_bit_cast(float, z.y << 16) + a0[2], __builtin_bit_cast(float, z.y & 0xffff0000u) + a0[3]);
                    w.z = cvt_pk_bf16(__builtin_bit_cast(float, z.z << 16) + a1[0], __builtin_bit_cast(float, z.z & 0xffff0000u) + a1[1]);
                    w.w = cvt_pk_bf16(__builtin_bit_cast(float, z.w << 16) + a1[2], __builtin_bit_cast(float, z.w & 0xffff0000u) + a1[3]);
                    *(u32x4*)(Z + (size_t)(row0 + ai * HALF + m * 16) * ldc + col0 + bj * HALF) = w; }
        }
    }
};

struct EpiScoreT {
    static constexpr bool PERM = false, AFTER_DRAIN = false;
    float* S; int row_base;
    __device__ __forceinline__ void operator()(const f32x4 (&acc)[2][2][4][2], const Unit& u, int wr, int wc, int fr, int fq) const {
        const int row0 = row_base + u.pm * BM + wr * 64 + fr, cn0 = wc * 32 + 4 * fq, head = u.pn;
#pragma unroll
        for (int ai = 0; ai < 2; ++ai)
#pragma unroll
            for (int m = 0; m < 4; ++m) { const int row = row0 + ai * HALF + m * 16;
                float* bp = S + ((size_t)((row >> 6) * 8 + head) * 256) * 64 + (row & 63);
#pragma unroll
                for (int bj = 0; bj < 2; ++bj)
#pragma unroll
                    for (int n = 0; n < 2; ++n) { const int cn = cn0 + bj * HALF + n * 16; const f32x4 v = acc[ai][bj][m][n];
                        bp[(size_t)cn * 64] = v[0]; bp[(size_t)(cn + 1) * 64] = v[1]; bp[(size_t)(cn + 2) * 64] = v[2]; bp[(size_t)(cn + 3) * 64] = v[3]; } }
    }
};

template <class Epi, class Sched, bool ALIGN_EPI = false, bool SP2 = false>
__device__ __forceinline__ void gemm_phase(PG8_LAS unsigned char* lds, const Gemm g, const Sched& S, const Epi& E, const int tid) {
    const int wid = __builtin_amdgcn_readfirstlane(tid >> 6), lane = tid & 63, wr = wid >> 2, wc = wid & 3, fr = lane & 15, fq = lane >> 4;
    const int K = g.K, nt = K / BK;
    unsigned voffA[2], voffB[2];
#pragma unroll
    for (int i = 0; i < 2; ++i) { int R, C; stage_rc(tid * 16 + i * 8192, R, C); const int Rb = Epi::PERM ? ((R & ~31) + perm32(R & 31)) : R;
        voffA[i] = (unsigned)(R * K + C) * 2u; voffB[i] = (unsigned)(Rb * K + C) * 2u; }
    const size_t kstep = (size_t)(BK * 2);
    const size_t hstep = (size_t)HALF * K * 2;
    const size_t tstep = 2 * hstep;
    const unsigned ldsw = (unsigned)wid * 1024u;
    const int aoff = lds_byte(wr * 64 + fr, fq * 8), boff = lds_byte(wc * 32 + fr, fq * 8);
#define PG8_SA(b, h) (((b) * 2 + (h)) * HTB)
#define PG8_SB(b, h) ((4 + (b) * 2 + (h)) * HTB)
#define PG8_STAGE(bufoff, gbase, voff) do { _Pragma("unroll") for (int _i = 0; _i < 2; ++_i) \
        __builtin_amdgcn_global_load_lds((const unsigned*)((const char*)(gbase) + (voff)[_i]), (PG8_LAS unsigned*)(lds + (bufoff) + ldsw + _i * 8192), 16, 0, 0); } while (0)
#define PG8_LDA(dst, b, h) do { _Pragma("unroll") for (int m = 0; m < 4; ++m) _Pragma("unroll") for (int k = 0; k < 2; ++k) dst[m][k] = *(const PG8_LAS bf16x8*)(lds + PG8_SA(b, h) + aoff + m * 2048 + k * 1024); } while (0)
#define PG8_LDB(dst, b, h) do { _Pragma("unroll") for (int n = 0; n < 2; ++n) _Pragma("unroll") for (int k = 0; k < 2; ++k) dst[n][k] = *(const PG8_LAS bf16x8*)(lds + PG8_SB(b, h) + boff + n * 2048 + k * 1024); } while (0)
#define PG8_MMA(ai, bj, At, Bt) do { __builtin_amdgcn_s_setprio(1); _Pragma("unroll") for (int m = 0; m < 4; ++m) _Pragma("unroll") for (int n = 0; n < 2; ++n) _Pragma("unroll") for (int k = 0; k < 2; ++k) \
        acc[ai][bj][m][n] = __builtin_amdgcn_mfma_f32_16x16x32_bf16(Bt[n][k], At[m][k], acc[ai][bj][m][n], 0, 0, 0); __builtin_amdgcn_s_setprio(0); } while (0)
#define PG8_WAIT_V(n) asm volatile("s_waitcnt vmcnt(" #n ")" ::: "memory")
#define PG8_WAIT_L(n) asm volatile("s_waitcnt lgkmcnt(" #n ")" ::: "memory")
#define PG8_BAR __builtin_amdgcn_s_barrier()
#define PG8_SCHED __builtin_amdgcn_sched_barrier(0)
    Unit cur, nxt; int ui = 0;
    if (!S.next(0, cur)) return;
    f32x4 acc[2][2][4][2];
#pragma unroll
    for (int a = 0; a < 2; ++a)
#pragma unroll
        for (int b = 0; b < 2; ++b)
#pragma unroll
            for (int m = 0; m < 4; ++m)
#pragma unroll
                for (int n = 0; n < 2; ++n) acc[a][b][m][n] = (f32x4){0.f, 0.f, 0.f, 0.f};
    bf16x8 At[4][2], B0[2][2], B1[2][2];
    const char* cA = (const char*)g.A + (size_t)cur.pm * tstep; const char* cB = (const char*)g.Bt + (size_t)cur.pn * tstep;
    S.a_ready(cur);
    if constexpr (SP2) {
        PG8_STAGE(PG8_SB(0, 0), cB, voffB); PG8_STAGE(PG8_SB(0, 1), cB + hstep, voffB); PG8_STAGE(PG8_SA(0, 0), cA, voffA); PG8_STAGE(PG8_SA(0, 1), cA + hstep, voffA);
        if (wr == 1) PG8_BAR;
        PG8_WAIT_V(2); PG8_BAR;
        PG8_STAGE(PG8_SB(1, 0), cB + kstep, voffB); PG8_STAGE(PG8_SA(1, 0), cA + kstep, voffA); PG8_STAGE(PG8_SB(1, 1), cB + hstep + kstep, voffB);
        PG8_WAIT_V(6); PG8_BAR;
    } else {
        PG8_STAGE(PG8_SB(0, 0), cB, voffB); PG8_STAGE(PG8_SA(0, 0), cA, voffA); PG8_STAGE(PG8_SB(0, 1), cB + hstep, voffB); PG8_STAGE(PG8_SA(0, 1), cA + hstep, voffA);
        if (wr == 1) PG8_BAR;
        PG8_WAIT_V(4); PG8_BAR;
        PG8_STAGE(PG8_SB(1, 0), cB + kstep, voffB); PG8_STAGE(PG8_SA(1, 0), cA + kstep, voffA); PG8_STAGE(PG8_SB(1, 1), cB + hstep + kstep, voffB);
        PG8_WAIT_V(6); PG8_BAR;
    }
    for (;;) {
        const bool has_next = S.next(ui + 1, nxt);
        const char* nA = has_next ? (const char*)g.A + (size_t)nxt.pm * tstep : cA; const char* nB = has_next ? (const char*)g.Bt + (size_t)nxt.pn * tstep : cB;
        for (int t = 0; t < nt; t += 2) {
            const bool last = (t == nt - 2);
            const char* a1 = cA + (size_t)(t + 1) * kstep;
            const char* a2 = last ? nA : cA + (size_t)(t + 2) * kstep; const char* b2 = last ? nB : cB + (size_t)(t + 2) * kstep;
            const char* a3 = a2 + kstep; const char* b3 = b2 + kstep;
            if (last && has_next) S.a_ready(nxt);
            if constexpr (SP2) {
            PG8_LDB(B0, 0, 0); PG8_LDB(B1, 0, 1); PG8_SCHED; PG8_LDA(At, 0, 0); PG8_STAGE(PG8_SA(1, 1), a1 + hstep, voffA);
            PG8_WAIT_V(8); PG8_WAIT_L(0); PG8_BAR; PG8_MMA(0, 0, At, B0); PG8_MMA(0, 1, At, B1); PG8_BAR; PG8_SCHED;
            PG8_LDA(At, 0, 1); PG8_STAGE(PG8_SB(0, 0), b2, voffB); PG8_STAGE(PG8_SB(0, 1), b2 + hstep, voffB); PG8_STAGE(PG8_SA(0, 0), a2, voffA);
            PG8_WAIT_V(8); PG8_WAIT_L(0); PG8_BAR; PG8_MMA(1, 0, At, B0); PG8_MMA(1, 1, At, B1); PG8_BAR; PG8_SCHED;
            PG8_LDB(B0, 1, 0); PG8_LDB(B1, 1, 1); PG8_SCHED; PG8_LDA(At, 1, 0); PG8_STAGE(PG8_SA(0, 1), a2 + hstep, voffA);
            PG8_WAIT_V(8); PG8_WAIT_L(0); PG8_BAR; PG8_MMA(0, 0, At, B0); PG8_MMA(0, 1, At, B1); PG8_BAR; PG8_SCHED;
            PG8_LDA(At, 1, 1); PG8_STAGE(PG8_SB(1, 0), b3, voffB); PG8_STAGE(PG8_SB(1, 1), b3 + hstep, voffB); PG8_STAGE(PG8_SA(1, 0), a3, voffA);
            PG8_WAIT_V(8); PG8_WAIT_L(0); PG8_BAR; PG8_MMA(1, 0, At, B0); PG8_MMA(1, 1, At, B1); PG8_BAR; PG8_SCHED;
            } else {
            PG8_LDB(B0, 0, 0); PG8_SCHED; PG8_LDA(At, 0, 0); PG8_STAGE(PG8_SA(1, 1), a1 + hstep, voffA);
            PG8_WAIT_L(8); PG8_BAR; PG8_WAIT_L(0); PG8_MMA(0, 0, At, B0); PG8_BAR; PG8_SCHED;
            PG8_LDB(B1, 0, 1); PG8_STAGE(PG8_SB(0, 0), b2, voffB);
            PG8_BAR; PG8_WAIT_L(0); PG8_MMA(0, 1, At, B1); PG8_BAR;
            PG8_LDA(At, 0, 1); PG8_STAGE(PG8_SA(0, 0), a2, voffA);
            PG8_BAR; PG8_WAIT_L(0); PG8_MMA(1, 0, At, B0); PG8_BAR; PG8_SCHED;
            PG8_STAGE(PG8_SB(0, 1), b2 + hstep, voffB);
            PG8_WAIT_V(6); PG8_BAR; PG8_MMA(1, 1, At, B1); PG8_BAR;
            PG8_LDB(B0, 1, 0); PG8_SCHED; PG8_LDA(At, 1, 0); PG8_STAGE(PG8_SA(0, 1), a2 + hstep, voffA);
            PG8_WAIT_L(8); PG8_BAR; PG8_WAIT_L(0); PG8_MMA(0, 0, At, B0); PG8_BAR; PG8_SCHED;
            PG8_LDB(B1, 1, 1); PG8_STAGE(PG8_SB(1, 0), b3, voffB);
            PG8_BAR; PG8_WAIT_L(0); PG8_MMA(0, 1, At, B1); PG8_BAR;
            PG8_LDA(At, 1, 1); PG8_STAGE(PG8_SA(1, 0), a3, voffA);
            PG8_BAR; PG8_WAIT_L(0); PG8_MMA(1, 0, At, B0); PG8_BAR; PG8_SCHED;
            PG8_STAGE(PG8_SB(1, 1), b3 + hstep, voffB);
            PG8_WAIT_V(6); PG8_BAR; PG8_MMA(1, 1, At, B1); PG8_BAR;
            }
        }
        if constexpr (ALIGN_EPI) { if (wr == 0) PG8_BAR; }
        if constexpr (!Epi::AFTER_DRAIN) { E(acc, cur, wr, wc, fr, fq); S.done(cur); }
        if (!has_next) break;
#pragma unroll
        for (int a = 0; a < 2; ++a)
#pragma unroll
            for (int b = 0; b < 2; ++b)
#pragma unroll
                for (int m = 0; m < 4; ++m)
#pragma unroll
                    for (int n = 0; n < 2; ++n) acc[a][b][m][n] = (f32x4){0.f, 0.f, 0.f, 0.f};
        cur = nxt; cA = nA; cB = nB; ++ui;
        if constexpr (ALIGN_EPI) { if (wr == 1) PG8_BAR; }
    }
    PG8_WAIT_V(0);
    if constexpr (!ALIGN_EPI) { if (wr == 0) PG8_BAR; }
    PG8_BAR;
    if constexpr (Epi::AFTER_DRAIN) { E.fused(acc, cur, wr, wc, fr, fq, lds, wid, lane); S.done(cur); }
#undef PG8_SA
#undef PG8_SB
#undef PG8_STAGE
#undef PG8_LDA
#undef PG8_LDB
#undef PG8_MMA
#undef PG8_WAIT_V
#undef PG8_WAIT_L
#undef PG8_BAR
#undef PG8_SCHED
}
}

constexpr int DM = 1024, NB = 4, SEQ = 4096, DEPTH = 4, CTXL = 256;
constexpr int NCTX = NB * CTXL, NLAT = NB * SEQ, NTOK = NCTX + NLAT;
constexpr int PROJ = 2048, NEXP = 16384, NPICK = 128;
constexpr int NCHUNK = NTOK / 128;
constexpr float EPS = 1e-6f;
constexpr int NPH = 3 + 11 * DEPTH;

constexpr size_t MiB = 1u << 20;
constexpr size_t WS_CTL = 0, CTL_ZERO_BYTES = 1 * MiB;
constexpr size_t WS_MODP = 616 * MiB;
constexpr size_t WS_MOD  = 5 * MiB;
constexpr size_t WS_POS  = 6 * MiB;
constexpr size_t WS_AGG  = 7 * MiB;
constexpr size_t WS_WIN  = 8 * MiB;
constexpr size_t WS_WOUT = 24 * MiB;
constexpr size_t WS_WCMB = 32 * MiB;
constexpr size_t WS_PE   = 48 * MiB;
constexpr size_t WS_PC   = 58 * MiB;
constexpr size_t WS_Z    = 72 * MiB;
constexpr size_t WS_XN   = 140 * MiB;
constexpr size_t WS_P    = 176 * MiB;
constexpr size_t WS_Y    = 244 * MiB;
constexpr size_t WS_HS   = 280 * MiB;
constexpr size_t WS_SC   = 348 * MiB;
constexpr size_t WS_UQ   = 484 * MiB;
constexpr size_t WS_VQ   = 548 * MiB;
constexpr size_t WS_US   = 612 * MiB;
constexpr size_t WS_VS   = 613 * MiB;
constexpr size_t WS_SGW  = 614 * MiB;
constexpr size_t WS_CO   = 632 * MiB;
constexpr size_t WS_END  = 641 * MiB;
constexpr int CW_BAR = 4096;

constexpr int RING_BYTES = 131072;
constexpr int LDS_BYTES = 163840;
constexpr int LDSCTL_OFF = LDS_BYTES - 1024, MISC_OFF = LDSCTL_OFF + 320;

#define LAS __attribute__((address_space(3)))
typedef unsigned short bf16;
typedef unsigned v4u __attribute__((ext_vector_type(4)));
typedef unsigned v2u __attribute__((ext_vector_type(2)));
typedef int v4i __attribute__((ext_vector_type(4)));
typedef float f32x4 __attribute__((ext_vector_type(4)));
#define LDS_WAIT() asm volatile("s_waitcnt lgkmcnt(0)" ::: "memory")

__device__ __forceinline__ unsigned f2bf(float f) { unsigned u = __builtin_bit_cast(unsigned, f); return (u + 0x7fffu + ((u >> 16) & 1u)) >> 16; }
__device__ __forceinline__ unsigned pk2(float lo, float hi) { return f2bf(lo) | (f2bf(hi) << 16); }
__device__ __forceinline__ float bf2f(unsigned short b) { return __builtin_bit_cast(float, ((unsigned)b) << 16); }
__device__ __forceinline__ float bflo(unsigned w) { return __builtin_bit_cast(float, w << 16); }
__device__ __forceinline__ float bfhi(unsigned w) { return __builtin_bit_cast(float, w & 0xffff0000u); }
__device__ __forceinline__ float gelu_t(float x) {
    const float u = 0.7978845608028654f * (x + 0.044715f * x * x * x);
    const float e = expf(2.f * u);
    const float t = 1.f - 2.f / (e + 1.f);
    return 0.5f * x * (1.f + t);
}
__device__ __forceinline__ float sigmoid_f(float x) { return 1.f / (1.f + expf(-x)); }
#define DPPF(x, ctrl) __builtin_bit_cast(float, __builtin_amdgcn_update_dpp(0, __builtin_bit_cast(int, (x)), (ctrl), 0xf, 0xf, true))
__device__ __forceinline__ float wave_sum(float v) {
    v += DPPF(v, 0xB1); v += DPPF(v, 0x4E); v += DPPF(v, 0x141); v += DPPF(v, 0x140);
    const int iv = __builtin_bit_cast(int, v);
    const float r0 = __builtin_bit_cast(float, __builtin_amdgcn_readlane(iv, 0)), r1 = __builtin_bit_cast(float, __builtin_amdgcn_readlane(iv, 16)),
                r2 = __builtin_bit_cast(float, __builtin_amdgcn_readlane(iv, 32)), r3 = __builtin_bit_cast(float, __builtin_amdgcn_readlane(iv, 48));
    return (r0 + r1) + (r2 + r3);
}

__device__ __forceinline__ void wave_sum2(float& a, float& b) {
    a += DPPF(a, 0xB1); b += DPPF(b, 0xB1); a += DPPF(a, 0x4E); b += DPPF(b, 0x4E); a += DPPF(a, 0x141); b += DPPF(b, 0x141); a += DPPF(a, 0x140); b += DPPF(b, 0x140);
    const int ia = __builtin_bit_cast(int, a), ib = __builtin_bit_cast(int, b);
    const float a0 = __builtin_bit_cast(float, __builtin_amdgcn_readlane(ia, 0)), a1 = __builtin_bit_cast(float, __builtin_amdgcn_readlane(ia, 16)),
                a2 = __builtin_bit_cast(float, __builtin_amdgcn_readlane(ia, 32)), a3 = __builtin_bit_cast(float, __builtin_amdgcn_readlane(ia, 48));
    const float b0 = __builtin_bit_cast(float, __builtin_amdgcn_readlane(ib, 0)), b1 = __builtin_bit_cast(float, __builtin_amdgcn_readlane(ib, 16)),
                b2 = __builtin_bit_cast(float, __builtin_amdgcn_readlane(ib, 32)), b3 = __builtin_bit_cast(float, __builtin_amdgcn_readlane(ib, 48));
    a = (a0 + a1) + (a2 + a3); b = (b0 + b1) + (b2 + b3);
}

#define XB_TMO      128
#define XB_XCNT(j)  (256  + 64 * (j))
#define XB_XSUB(j)  (1280 + 64 * (j))
#define XB_XGEN(j)  (2304 + 64 * (j))
#define XB_TOP      3328
#define XB_TOPGEN   3392
#define XCD_BAR_WORDS 3456
#define XB_SPIN_CAP (1u << 20)

__device__ __forceinline__ unsigned xb_ld(unsigned* p)              { return __hip_atomic_load(p, __ATOMIC_RELAXED, __HIP_MEMORY_SCOPE_AGENT); }
__device__ __forceinline__ unsigned xb_add(unsigned* p, unsigned v) { return __hip_atomic_fetch_add(p, v, __ATOMIC_RELAXED, __HIP_MEMORY_SCOPE_AGENT); }
__device__ __forceinline__ unsigned xb_xcc_id() { return (unsigned)__builtin_amdgcn_s_getreg((3 << 11) | 20) & 0xFu; }
#define XB_SPIN(cond, bar) do { unsigned _sp = 0; while (cond) { __builtin_amdgcn_s_sleep(1); \
    if ((++_sp & 255u) == 0u) { if (xb_ld(&(bar)[XB_TMO])) break; if (_sp > XB_SPIN_CAP) { atomicAdd(&(bar)[XB_TMO], 1u); break; } } } } while (0)

struct XcdBarrier {
    unsigned* bar; unsigned x;
    volatile LAS unsigned* st;
};

__device__ __forceinline__ XcdBarrier xcd_barrier_post(unsigned* bar, volatile LAS unsigned* st) {
    XcdBarrier b; b.bar = bar; b.x = xb_xcc_id(); b.st = st;
    if (threadIdx.x == 0) (void)xb_add(&bar[XB_XCNT(b.x)], 1u);
    return b;
}
__device__ __forceinline__ void xcd_barrier_complete(unsigned* bar, unsigned x, unsigned& nloc, unsigned& nx) {
    const unsigned G = gridDim.x * gridDim.y * gridDim.z;
    unsigned sum, cnt, mine, sp = 0u;
    for (;;) {
        sum = 0u; cnt = 0u; mine = 0u;
#pragma unroll
        for (unsigned j = 0; j < 16; ++j) { const unsigned c = xb_ld(&bar[XB_XCNT(j)]); sum += c; cnt += (c > 0u) ? 1u : 0u; mine = (j == x) ? c : mine; }
        if (sum == G) break;
        __builtin_amdgcn_s_sleep(1);
        if ((++sp & 255u) == 0u) { if (xb_ld(&bar[XB_TMO])) break; if (sp > XB_SPIN_CAP) { atomicAdd(&bar[XB_TMO], 1u); break; } }
    }
    nloc = mine > 0u ? mine : 1u; nx = cnt > 0u ? cnt : 1u;
}

__device__ __forceinline__ void xcd_barrier(const XcdBarrier& b) {
    asm volatile("s_waitcnt vmcnt(0)" ::: "memory");
    __syncthreads();
    if (threadIdx.x == 0) {
        unsigned* bar = b.bar;
        __builtin_amdgcn_s_waitcnt(0);
        unsigned nloc = b.st[0], nx = b.st[1];
        if (nloc == 0u) { xcd_barrier_complete(bar, b.x, nloc, nx); b.st[0] = nloc; b.st[1] = nx; }
        const unsigned old = xb_add(&bar[XB_XSUB(b.x)], 1u);
        const unsigned gen = old / nloc;
        if (old + 1u == (gen + 1u) * nloc) {
            __builtin_amdgcn_fence(__ATOMIC_RELEASE, "agent");
            asm volatile("s_waitcnt vmcnt(0)" ::: "memory");
            const unsigned og = xb_add(&bar[XB_TOP], 1u);
            const unsigned tg = og / nx;
            if (og + 1u == (tg + 1u) * nx) xb_add(&bar[XB_TOPGEN], 1u);
            else XB_SPIN(xb_ld(&bar[XB_TOPGEN]) == tg, bar);
            __builtin_amdgcn_fence(__ATOMIC_ACQUIRE, "agent");
            xb_add(&bar[XB_XGEN(b.x)], 1u);
            asm volatile("s_waitcnt vmcnt(0)" ::: "memory");
        } else {
            XB_SPIN(xb_ld(&bar[XB_XGEN(b.x)]) == gen, bar);
            __builtin_amdgcn_fence(__ATOMIC_ACQUIRE, "agent");
            asm volatile("s_waitcnt vmcnt(0)" ::: "memory");
        }
    }
    __syncthreads();
}


#define AS4 __attribute__((address_space(4)))
struct Ctx {
    LAS unsigned char* lds;
    int tid, lane, wave, vcu, G, bx;
    const AS4 unsigned char* kp;
    unsigned char* ws; float* out;
};
#define IN_(C, k) (*(const float* const AS4*)((C).kp + 8 * (k)))

typedef short bf16x8 __attribute__((ext_vector_type(8)));
#define MFMA16(a, b, c) __builtin_amdgcn_mfma_f32_16x16x32_bf16((a), (b), (c), 0, 0, 0)
__device__ __forceinline__ void p0_transpose_item(const float* W, int K, int N, bf16* WT, LAS float* scr, int item, int lane) {
    const int nblk = N / 32, kb = item / nblk, nb = item % nblk, k0 = 64 * kb, n0 = 32 * nb;
#pragma unroll 8
    for (int i = 0; i < 32; ++i) { const int kk = 2 * i + (lane >> 5); scr[kk * 33 + (lane & 31)] = W[(size_t)(k0 + kk) * N + n0 + (lane & 31)]; }
    LDS_WAIT(); asm volatile("" ::: "memory");
    const int c = lane & 7;
#pragma unroll
    for (int j = 0; j < 4; ++j) { const int n = (lane >> 3) + 8 * j; const LAS float* s = scr + (8 * c) * 33 + n;
        v4u o; o.x = pk2(s[0 * 33], s[1 * 33]); o.y = pk2(s[2 * 33], s[3 * 33]); o.z = pk2(s[4 * 33], s[5 * 33]); o.w = pk2(s[6 * 33], s[7 * 33]);
        *(v4u*)(WT + (size_t)(n0 + n) * K + k0 + 8 * c) = o; }
    LDS_WAIT(); asm volatile("" ::: "memory");
}

__device__ __forceinline__ void convert_tables(const Ctx& C, int l, int it0, int it1) {
    const int gw = C.vcu * 8 + C.wave, NGW = C.G * 8;
    for (int q0 = (it0 * NGW + gw) * 4; q0 < 2 * NEXP && q0 < (it1 * NGW) * 4; q0 += NGW * 4) {
        const bool isv = q0 >= NEXP; const int rr0 = l * NEXP + (isv ? q0 - NEXP : q0);
        const f32x4* src = (const f32x4*)((isv ? IN_(C, 27) : IN_(C, 26)) + (size_t)rr0 * DM) + C.lane;
        f32x4 v[4][4];
#pragma unroll
        for (int q = 0; q < 4; ++q)
#pragma unroll
            for (int j = 0; j < 4; ++j) v[q][j] = src[q * 256 + 64 * j];
        const int bias = 0;
#pragma unroll
        for (int q = 0; q < 4; ++q) {
            float am = 0.f;
#pragma unroll
            for (int j = 0; j < 4; ++j) am = fmaxf(am, fmaxf(fmaxf(fabsf(v[q][j].x), fabsf(v[q][j].y)), fmaxf(fabsf(v[q][j].z), fabsf(v[q][j].w))));
            am = fmaxf(am, DPPF(am, 0xB1)); am = fmaxf(am, DPPF(am, 0x4E)); am = fmaxf(am, DPPF(am, 0x141)); am = fmaxf(am, DPPF(am, 0x140));
            { const int iv = __builtin_bit_cast(int, am);
              am = fmaxf(fmaxf(__builtin_bit_cast(float, __builtin_amdgcn_readlane(iv, 0)), __builtin_bit_cast(float, __builtin_amdgcn_readlane(iv, 16))),
                         fmaxf(__builtin_bit_cast(float, __builtin_amdgcn_readlane(iv, 32)), __builtin_bit_cast(float, __builtin_amdgcn_readlane(iv, 48)))); }
            const float inv = am > 0.f ? 127.0f / am : 0.f;
            unsigned* dst = (unsigned*)(C.ws + (isv ? WS_VQ : WS_UQ) + (size_t)(rr0 + q) * DM) + C.lane;
#pragma unroll
            for (int j = 0; j < 4; ++j) {
                const int q0 = (int)rintf(v[q][j].x * inv) + bias, q1 = (int)rintf(v[q][j].y * inv) + bias, q2 = (int)rintf(v[q][j].z * inv) + bias, q3 = (int)rintf(v[q][j].w * inv) + bias;
                dst[64 * j] = (unsigned)(q0 & 255) | ((unsigned)(q1 & 255) << 8) | ((unsigned)(q2 & 255) << 16) | ((unsigned)(q3 & 255) << 24);
            }
            if (C.lane == 0) ((float*)(C.ws + (isv ? WS_VS : WS_US)))[rr0 + q] = am * (1.0f / 127.0f);
        }
    }
}

__device__ __forceinline__ void phase_p0a(const Ctx& C, int mask) {
    const int gw = C.vcu * 8 + C.wave, NGW = C.G * 8;
    const int gt = C.vcu * 512 + C.tid, NGT = C.G * 512;
    LAS float* scr = (LAS float*)(C.lds + C.wave * 16384);
    if (mask & 1) for (int it = gw; it < 4 * 1024 + 4 * 512; it += NGW) {
        if (it < 4096) { const int l = it >> 10, r = it & 1023; p0_transpose_item(IN_(C, 8) + (size_t)l * 1024 * 2048, 1024, 2048, ((bf16*)(C.ws + WS_WIN)) + (size_t)l * 2048 * 1024, scr, r, C.lane); }
        else { const int q = it - 4096, l = q >> 9, r = q & 511; p0_transpose_item(IN_(C, 9) + (size_t)l * 1024 * 1024, 1024, 1024, ((bf16*)(C.ws + WS_WOUT)) + (size_t)l * 1024 * 1024, scr, r, C.lane); }
    }
    for (int i = gt; i < 4 * 4 * 128 * 128; i += NGT) ((bf16*)(C.ws + WS_SGW))[i] = (bf16)f2bf(IN_(C, 21)[i]);
    for (int i = gt; i < 64 * 512; i += NGT) {
        const int p = i >> 9, j = i & 511, q = j & 255;
        const float omega = powf(10000.0f, -(float)q / 256.0f);
        const float ang = (float)p * omega;
        ((float*)(C.ws + WS_POS))[i] = (j < 256) ? sinf(ang) : cosf(ang);
    }
    if (mask & 2) convert_tables(C, 0, 0, 64);
    if (mask & 4) for (int it = gw; it < 4 * 32 * 24; it += NGW) {
        const int cb = it % 24, ks = (it / 24) & 31, l = it / 768;
        const int col = cb * 256 + 4 * C.lane;
        const float* w = IN_(C, 4) + ((size_t)l * 1024 + ks * 32) * 6144 + col;
        f32x4 wv[32];
#pragma unroll
        for (int k = 0; k < 32; ++k) wv[k] = *(const f32x4*)(w + (size_t)k * 6144);
        int sl[5];
        { const int kk = ks * 32 + (C.lane & 31);
#pragma unroll
          for (int r = 0; r < 5; ++r) { const float v = (r < 4) ? IN_(C, 1)[r * 1024 + kk] : IN_(C, 3)[kk]; sl[r] = __builtin_bit_cast(int, v / (1.f + expf(-v))); } }
        f32x4 a[5];
#pragma unroll
        for (int r = 0; r < 5; ++r) a[r] = (f32x4){0.f, 0.f, 0.f, 0.f};
#pragma unroll
        for (int k = 0; k < 32; ++k)
#pragma unroll
            for (int r = 0; r < 5; ++r) a[r] = a[r] + wv[k] * __builtin_bit_cast(float, __builtin_amdgcn_readlane(sl[r], k));
        float* o = ((float*)(C.ws + WS_MODP)) + (((size_t)ks * 4 + l) * 5) * 6144 + col;
#pragma unroll
        for (int r = 0; r < 5; ++r) *(f32x4*)(o + (size_t)r * 6144) = a[r];
    }
    {
        const int fr = C.lane & 15, fq = C.lane >> 4;
        if (mask & 8) for (int it = gw; it < 8192; it += NGW) {
            const int nt = it & 7, kt = (it >> 3) & 15, side = (it >> 7) & 1, h = (it >> 8) & 7, l = it >> 11;
            const float* key = (side ? IN_(C, 25) : IN_(C, 24)) + (size_t)l * 16384 + (size_t)(nt * 16 + fr) * 128 + 8 * fq;
            const float* wq = IN_(C, 23) + (size_t)l * 1024 * 2048 + (size_t)(kt * 64 + fr) * 2048 + h * 256 + side * 128 + 8 * fq;
            f32x4 kx[4][2], wx[4][4][2];
#pragma unroll
            for (int ks = 0; ks < 4; ++ks) { kx[ks][0] = *(const f32x4*)(key + 32 * ks); kx[ks][1] = *(const f32x4*)(key + 32 * ks + 4); }
#pragma unroll
            for (int ct = 0; ct < 4; ++ct)
#pragma unroll
                for (int ks = 0; ks < 4; ++ks) { const float* wp = wq + (size_t)(16 * ct) * 2048 + 32 * ks; wx[ct][ks][0] = *(const f32x4*)wp; wx[ct][ks][1] = *(const f32x4*)(wp + 4); }
            bf16x8 Bh[4], Bl[4];
#pragma unroll
            for (int ks = 0; ks < 4; ++ks) { const f32x4 x0 = kx[ks][0], x1 = kx[ks][1];
                const float xv[8] = {x0.x, x0.y, x0.z, x0.w, x1.x, x1.y, x1.z, x1.w};
#pragma unroll
                for (int e = 0; e < 8; ++e) { const unsigned hb = f2bf(xv[e]); Bh[ks][e] = (short)hb; Bl[ks][e] = (short)f2bf(xv[e] - __builtin_bit_cast(float, hb << 16)); } }
            bf16* o = (bf16*)(C.ws + WS_WCMB) + ((size_t)l * 2048 + h * 256 + side * 128 + nt * 16 + fr) * 1024 + kt * 64 + 4 * fq;
#pragma unroll
            for (int ct = 0; ct < 4; ++ct) {
                f32x4 acc = {0.f, 0.f, 0.f, 0.f};
#pragma unroll
                for (int ks = 0; ks < 4; ++ks) { const f32x4 x0 = wx[ct][ks][0], x1 = wx[ct][ks][1];
                    const float xv[8] = {x0.x, x0.y, x0.z, x0.w, x1.x, x1.y, x1.z, x1.w};
                    bf16x8 Ah, Al;
#pragma unroll
                    for (int e = 0; e < 8; ++e) { const unsigned hb = f2bf(xv[e]); Ah[e] = (short)hb; Al[e] = (short)f2bf(xv[e] - __builtin_bit_cast(float, hb << 16)); }
                    acc = MFMA16(Ah, Bh[ks], acc); acc = MFMA16(Ah, Bl[ks], acc); acc = MFMA16(Al, Bh[ks], acc); }
                v2u w; w.x = pk2(acc[0], acc[1]); w.y = pk2(acc[2], acc[3]);
                *(v2u*)(o + 16 * ct) = w;
            }
        }
    }
}

__device__ __forceinline__ void phase_p0b(const Ctx& C) {
    const int gt = C.vcu * 512 + C.tid, NGT = C.G * 512;
    for (int i = gt; i < 4 * 5 * 6144; i += NGT) {
        const int l = i / 30720, rem = i % 30720, r = rem / 6144, col = rem % 6144;
        float v = IN_(C, 5)[l * 6144 + col];
#pragma unroll 8
        for (int ks = 0; ks < 32; ++ks) v += ((float*)(C.ws + WS_MODP))[(((size_t)ks * 4 + l) * 5 + r) * 6144 + col];
        ((float*)(C.ws + WS_MOD))[i] = v;
    }
}

template <int MODE>
__device__ __forceinline__ void phase_rows(const Ctx& C, int l, int row_lo) {
    const int gw = C.vcu * 8 + C.wave, NGW = C.G * 8;
    const bool first = (MODE == 0 && l == 0);
    const int n = NTOK - row_lo, per = n / NGW, rem = n - per * NGW;
    int row = row_lo + gw * per + (gw < rem ? gw : rem);
    const int rend = row + per + (gw < rem ? 1 : 0);
#define ROW_LOAD(dst, r) do { if ((r) < rend) { if (first) { const f32x4* sp_ = (const f32x4*)((r) < NCTX ? IN_(C, 2) + (size_t)(r) * DM : IN_(C, 0) + (size_t)((r) - NCTX) * DM) + C.lane; \
            _Pragma("unroll") for (int j = 0; j < 4; ++j) dst[j] = sp_[64 * j]; } \
        else { const v2u* sp_ = (const v2u*)(((const bf16*)(C.ws + WS_Z)) + (size_t)(r) * DM) + C.lane; \
            _Pragma("unroll") for (int j = 0; j < 4; ++j) { const v2u w_ = sp_[64 * j]; dst[j] = (f32x4){bflo(w_.x), bfhi(w_.x), bflo(w_.y), bfhi(w_.y)}; } } } } while (0)
    f32x4 v[4], v1[4], v2[4];
    ROW_LOAD(v, row); ROW_LOAD(v1, row + 1);
    f32x4 gq[4], shq[4], scq[4]; int mr_cur = -1;
    if (MODE != 2) { const f32x4* gp = (const f32x4*)((MODE == 0 ? IN_(C, 6) : IN_(C, 7)) + (size_t)l * DM) + C.lane;
#pragma unroll
        for (int j = 0; j < 4; ++j) gq[j] = gp[64 * j]; }
    else { const f32x4* gp = (const f32x4*)IN_(C, 28) + C.lane;
#pragma unroll
        for (int j = 0; j < 4; ++j) gq[j] = gp[64 * j]; }
    while (row < rend) {
        ROW_LOAD(v2, row + 2);
        float ss = 0.f;
#pragma unroll
        for (int j = 0; j < 4; ++j) ss += (v[j].x * v[j].x + v[j].y * v[j].y) + (v[j].z * v[j].z + v[j].w * v[j].w);
        if (first) { v2u* zp = (v2u*)(((bf16*)(C.ws + WS_Z)) + (size_t)row * DM) + C.lane;
#pragma unroll
            for (int j = 0; j < 4; ++j) { v2u w; w.x = pk2(v[j].x, v[j].y); w.y = pk2(v[j].z, v[j].w); zp[64 * j] = w;
                v[j] = (f32x4){bflo(w.x), bfhi(w.x), bflo(w.y), bfhi(w.y)}; } }
        int mr, t; if (row < NCTX) { mr = 4; t = row & 255; } else { mr = (row - NCTX) >> 12; t = (row - NCTX) & 4095; }
        if (MODE != 2 && mr != mr_cur) { mr_cur = mr;
            const float* mb = ((float*)(C.ws + WS_MOD)) + ((size_t)(l * 5 + mr) * 6 + (MODE == 0 ? 0 : 3)) * DM;
            const f32x4* shp = (const f32x4*)mb + C.lane; const f32x4* scp = (const f32x4*)(mb + DM) + C.lane;
#pragma unroll
            for (int j = 0; j < 4; ++j) { shq[j] = shp[64 * j]; scq[j] = scp[64 * j] + 1.0f; } }
        const float rs = __builtin_amdgcn_rsqf(wave_sum(ss) * (1.0f / DM) + EPS);
        if (MODE == 2) {
            f32x4* op = (f32x4*)(C.out + (size_t)(row - NCTX) * DM) + C.lane;
#pragma unroll
            for (int j = 0; j < 4; ++j) op[64 * j] = v[j] * rs * gq[j];
        } else {
            v2u* op = (v2u*)(((bf16*)(C.ws + WS_XN)) + (size_t)row * DM) + C.lane;
#pragma unroll
            for (int j = 0; j < 4; ++j) {
                f32x4 o = (v[j] * rs * gq[j]) * scq[j] + shq[j];
                if (MODE == 0 && row >= NCTX) {
                    const int p = (j < 2) ? (t >> 6) : (t & 63);
                    o = o + *((const f32x4*)(((float*)(C.ws + WS_POS)) + (size_t)p * 512 + (j & 1) * 256) + C.lane);
                }
                v2u w; w.x = pk2(o.x, o.y); w.y = pk2(o.z, o.w); op[64 * j] = w;
            }
        }
#pragma unroll
        for (int j = 0; j < 4; ++j) { v[j] = v1[j]; v1[j] = v2[j]; }
        ++row;
    }
#undef ROW_LOAD
}

constexpr int XS = 264;
constexpr int VTS = 136;
__device__ __forceinline__ float fexp(float x) { return __builtin_amdgcn_exp2f(x * 1.4426950408889634f); }
__device__ __forceinline__ float fsigmoid(float x) { return __builtin_amdgcn_rcpf(1.0f + fexp(-x)); }
__device__ __forceinline__ float fgelu(float x) {
    const float x2 = x * x;
    const float e = __builtin_amdgcn_exp2f(x * (x2 * (-0.044715f * 2.302208198f) - 2.302208198f));
    return x * __builtin_amdgcn_rcpf(1.0f + e);
}
__device__ __forceinline__ float one_minus_exp(float x) {
    const float p = -x * (1.0f + x * (0.5f + x * (0.16666667f + x * (0.041666668f + x * (0.0083333338f + x * 0.0013888889f)))));
    const float q = 1.0f - fexp(x);
    return (x > -0.25f) ? p : q;
}
__device__ __forceinline__ void seq_of_row(int row0, int& seq0, int& len) { if (row0 < NCTX) { seq0 = row0 & ~255; len = 256; } else { seq0 = NCTX + ((row0 - NCTX) & ~4095); len = 4096; } }
__device__ __forceinline__ void load_bfrags(const float* W, int lane, bf16x8 (&B)[4][2]) {
    const float* w0 = W + (8 * (lane >> 4)) * 64 + (lane & 15);
#pragma unroll
    for (int ct = 0; ct < 4; ++ct)
#pragma unroll
        for (int ks = 0; ks < 2; ++ks) {
            bf16x8 b;
#pragma unroll
            for (int e = 0; e < 8; ++e) b[e] = (short)f2bf(w0[(32 * ks + e) * 64 + 16 * ct]);
            B[ct][ks] = b;
        }
}

__device__ __forceinline__ void mixer_a(const Ctx& C, int l, int chunk) {
    const int row0 = chunk * 128; int seq0, len; seq_of_row(row0, seq0, len); const int t0 = row0 - seq0;
    LAS bf16* xa = (LAS bf16*)C.lds;
    LAS float* tile = (LAS float*)(C.lds + 128 * XS * 2 + C.wave * 8192);
    const bf16* P = (const bf16*)(C.ws + WS_P);
    {
        const float* cw = IN_(C, 10) + (size_t)l * 4 * 256; const float* cbias = IN_(C, 11) + (size_t)l * 256;
        const int c4 = (C.tid & 63) * 4, i0 = (C.tid >> 6) * 16;
        v2u pv[19];
#pragma unroll
        for (int q = 0; q < 19; ++q) { const int t = t0 + i0 - 2 + q; pv[q] = (v2u){0u, 0u}; if (t >= 0 && t < len) pv[q] = *(const v2u*)(P + (size_t)(seq0 + t) * PROJ + c4); }
        f32x4 w[4];
#pragma unroll
        for (int k = 0; k < 4; ++k) w[k] = *(const f32x4*)(cw + k * 256 + c4);
        const f32x4 bias = *(const f32x4*)(cbias + c4);
#pragma unroll
        for (int i = 0; i < 16; ++i) {
            f32x4 acc = bias;
#pragma unroll
            for (int k = 0; k < 4; ++k) { const v2u x = pv[i + k]; acc.x += w[k].x * bflo(x.x); acc.y += w[k].y * bfhi(x.x); acc.z += w[k].z * bflo(x.y); acc.w += w[k].w * bfhi(x.y); }
            v2u o; o.x = pk2(acc.x, acc.y); o.y = pk2(acc.z, acc.w);
            *(LAS v2u*)(xa + (i0 + i) * XS + c4) = o;
        }
    }
    __syncthreads();
    const int d = C.wave >> 2, h = C.wave & 3, fr = C.lane & 15, fq = C.lane >> 4;
    bf16x8 Br[4][2], Bi[4][2];
    load_bfrags(IN_(C, 13) + ((size_t)(l * 2 + d) * 4 + h) * 4096, C.lane, Br);
    load_bfrags(IN_(C, 15) + ((size_t)(l * 2 + d) * 4 + h) * 4096, C.lane, Bi);
    float brv[4], biv[4], spv[4];
#pragma unroll
    for (int ct = 0; ct < 4; ++ct) { const int j = 16 * ct + fr;
        brv[ct] = IN_(C, 14)[((l * 2 + d) * 4 + h) * 64 + j]; biv[ct] = IN_(C, 16)[((l * 2 + d) * 4 + h) * 64 + j];
        const float lam = IN_(C, 12)[(l * 2 + d) * 256 + h * 64 + j]; spv[ct] = fmaxf(-lam, 0.f) + log1pf(expf(-fabsf(lam))); }
    float hst = 0.f, acum = 1.f;
    bf16* HX = (bf16*)(C.ws + WS_HS) + (size_t)d * NTOK * 256 + h * 64 + C.lane; bf16* AX = (bf16*)(C.ws + WS_HS) + (size_t)(2 + d) * NTOK * 256 + h * 64 + C.lane;
    for (int it = 0; it < 8; ++it) {
        const int rt = d ? 7 - it : it;
        const LAS bf16* ap = xa + (16 * rt + fr) * XS + h * 64 + 8 * fq;
        const bf16x8 a0 = *(const LAS bf16x8*)ap, a1 = *(const LAS bf16x8*)(ap + 32);
        f32x4 ar[4], ai[4];
#pragma unroll
        for (int ct = 0; ct < 4; ++ct) {
            ar[ct] = MFMA16(a0, Br[ct][0], ((f32x4){0.f, 0.f, 0.f, 0.f})); ar[ct] = MFMA16(a1, Br[ct][1], ar[ct]);
            ai[ct] = MFMA16(a0, Bi[ct][0], ((f32x4){0.f, 0.f, 0.f, 0.f})); ai[ct] = MFMA16(a1, Bi[ct][1], ai[ct]);
        }
#pragma unroll
        for (int ct = 0; ct < 4; ++ct)
#pragma unroll
            for (int r = 0; r < 4; ++r) {
                const int tl = 4 * fq + r, j = 16 * ct + fr;
                const float xav = bf2f(xa[(16 * rt + tl) * XS + h * 64 + j]);
                const float rg = fsigmoid(ar[ct][r] + brv[ct]), ig = fsigmoid(ai[ct][r] + biv[ct]);
                const float la = -8.0f * rg * spv[ct];
                tile[tl * 64 + j] = fexp(la);
                tile[1024 + tl * 64 + j] = __builtin_amdgcn_sqrtf(one_minus_exp(2.0f * la)) * (ig * xav);
            }
        asm volatile("s_waitcnt lgkmcnt(0)" ::: "memory");
#pragma unroll 4
        for (int s = 0; s < 16; ++s) {
            const int tl = d ? 15 - s : s;
            const float a = tile[tl * 64 + C.lane], b = tile[1024 + tl * 64 + C.lane];
            hst = a * hst + b; acum *= a;
            const size_t ro = (size_t)(row0 + 16 * rt + tl) * 256;
            HX[ro] = (bf16)f2bf(hst); AX[ro] = (bf16)f2bf(acum);
        }
        asm volatile("s_waitcnt lgkmcnt(0)" ::: "memory");
    }
    { float* ag = (float*)(C.ws + WS_AGG) + ((size_t)(chunk * 2 + d) * 2) * 256 + h * 64 + C.lane; ag[0] = acum; ag[256] = hst; }
    __syncthreads();
}

__device__ __forceinline__ void mixer_b(const Ctx& C, int l, int chunk) {
    const int row0 = chunk * 128; int seq0, len; seq_of_row(row0, seq0, len); const int t0 = row0 - seq0;
    LAS bf16* dm = (LAS bf16*)C.lds;
    LAS bf16* xs = (LAS bf16*)(C.lds + 128 * XS * 2);
    const bf16* P = (const bf16*)(C.ws + WS_P); bf16* Y = (bf16*)(C.ws + WS_Y);
    const int half = C.wave >> 2, g = C.wave & 3, fr = C.lane & 15, fq = C.lane >> 4;
    bf16x8 Bw[4][2];
    load_bfrags(IN_(C, 17) + ((size_t)(l * 4 + g)) * 4096, C.lane, Bw);
    float scv[4];
#pragma unroll
    for (int ct = 0; ct < 4; ++ct) scv[ct] = IN_(C, 18)[l * 256 + g * 64 + 16 * ct + fr];
    {
        v4u tmp[9];
#pragma unroll
        for (int q = 0; q < 9; ++q) { const int idx = C.tid + 512 * q, i = idx >> 5, c8 = (idx & 31) * 8, t = t0 - 8 + i;
            tmp[q] = (v4u){0u, 0u, 0u, 0u}; if (t >= 0 && t < len) tmp[q] = *(const v4u*)(P + (size_t)(seq0 + t) * PROJ + 512 + c8); }
#pragma unroll
        for (int q = 0; q < 9; ++q) { const int idx = C.tid + 512 * q, i = idx >> 5, c8 = (idx & 31) * 8; *(LAS v4u*)(xs + i * 256 + c8) = tmp[q]; }
    }
    __syncthreads();
    {
        const int wh = C.wave >> 2, ri = C.lane >> 4, c4 = g * 64 + (C.lane & 15) * 4, hw = 1 << g;
        const int i0 = wh * 64 + ri * 16;
        f32x4 s = {0.f, 0.f, 0.f, 0.f};
        for (int o = -hw; o < hw; ++o) { const v2u pv = *(const LAS v2u*)(xs + (i0 + 8 + o) * 256 + c4); s.x += bflo(pv.x); s.y += bfhi(pv.x); s.z += bflo(pv.y); s.w += bfhi(pv.y); }
#pragma unroll 4
        for (int it = 0; it < 16; ++it) {
            const int i = i0 + it, t = t0 + i;
            int lo = t - hw, hi = t + hw; lo = lo < 0 ? 0 : lo; hi = hi > len ? len : hi;
            const float inv = 1.0f / (float)(hi - lo);
            const v2u xv = *(const LAS v2u*)(xs + (i + 8) * 256 + c4);
            v2u o2; o2.x = pk2(s.x * inv - bflo(xv.x), s.y * inv - bfhi(xv.x)); o2.y = pk2(s.z * inv - bflo(xv.y), s.w * inv - bfhi(xv.y));
            *(LAS v2u*)(dm + i * XS + c4) = o2;
            const v2u pa = *(const LAS v2u*)(xs + (i + 8 + hw) * 256 + c4), pd = *(const LAS v2u*)(xs + (i + 8 - hw) * 256 + c4);
            s.x += bflo(pa.x) - bflo(pd.x); s.y += bfhi(pa.x) - bfhi(pd.x); s.z += bflo(pa.y) - bflo(pd.y); s.w += bfhi(pa.y) - bfhi(pd.y);
        }
    }
    __syncthreads();
#pragma unroll
    for (int q = 0; q < 4; ++q) {
        const int rt = half * 4 + q;
        const LAS bf16* ap = dm + (16 * rt + fr) * XS + g * 64 + 8 * fq;
        const bf16x8 a0 = *(const LAS bf16x8*)ap, a1 = *(const LAS bf16x8*)(ap + 32);
#pragma unroll
        for (int ct = 0; ct < 4; ++ct) {
            f32x4 acc = MFMA16(a0, Bw[ct][0], ((f32x4){0.f, 0.f, 0.f, 0.f})); acc = MFMA16(a1, Bw[ct][1], acc);
#pragma unroll
            for (int r = 0; r < 4; ++r) Y[(size_t)(row0 + 16 * rt + 4 * fq + r) * DM + 256 + g * 64 + 16 * ct + fr] = (bf16)f2bf(acc[r] * scv[ct]);
        }
    }
    __syncthreads();
}

__device__ __forceinline__ void mixer_c(const Ctx& C, int l, int chunk) {
    const int row0 = chunk * 128; int seq0, len; seq_of_row(row0, seq0, len); const int t0 = row0 - seq0;
    const float* cw = IN_(C, 19) + (size_t)l * 3 * 256;
    const bf16* P = (const bf16*)(C.ws + WS_P); bf16* Y = (bf16*)(C.ws + WS_Y);
    const int c4 = (C.tid & 63) * 4;
    f32x4 w[3];
#pragma unroll
    for (int k = 0; k < 3; ++k) w[k] = *(const f32x4*)(cw + k * 256 + c4);
#pragma unroll 1
    for (int hf = 0; hf < 2; ++hf) {
        const int i0 = (C.tid >> 6) * 16 + hf * 8;
        v2u pa[10], pb[10], pc[8];
#pragma unroll
        for (int q = 0; q < 10; ++q) { const int t = t0 + i0 - 1 + q; pa[q] = (v2u){0u, 0u}; pb[q] = (v2u){0u, 0u};
            if (t >= 0 && t < len) { const bf16* p = P + (size_t)(seq0 + t) * PROJ; pa[q] = *(const v2u*)(p + 1024 + c4); pb[q] = *(const v2u*)(p + 1280 + c4); } }
#pragma unroll
        for (int i = 0; i < 8; ++i) pc[i] = *(const v2u*)(P + (size_t)(row0 + i0 + i) * PROJ + 768 + c4);
        f32x4 pr[10];
#pragma unroll
        for (int q = 0; q < 10; ++q) { pr[q].x = bflo(pa[q].x) * bflo(pb[q].x); pr[q].y = bfhi(pa[q].x) * bfhi(pb[q].x); pr[q].z = bflo(pa[q].y) * bflo(pb[q].y); pr[q].w = bfhi(pa[q].y) * bfhi(pb[q].y); }
#pragma unroll
        for (int i = 0; i < 8; ++i) {
            const f32x4 acc = w[0] * pr[i] + w[1] * pr[i + 1] + w[2] * pr[i + 2];
            v2u o; o.x = pk2(bflo(pc[i].x) * acc.x, bfhi(pc[i].x) * acc.y); o.y = pk2(bflo(pc[i].y) * acc.z, bfhi(pc[i].y) * acc.w);
            *(v2u*)(Y + (size_t)(row0 + i0 + i) * DM + 512 + c4) = o;
        }
    }
}

__device__ __forceinline__ void mixer_d(const Ctx& C, int l, int chunk) {
    const int row0 = chunk * 128;
    LAS bf16* vt = (LAS bf16*)C.lds;
    const bf16* P = (const bf16*)(C.ws + WS_P); bf16* Y = (bf16*)(C.ws + WS_Y);
    const int qh = C.wave >> 2, h = C.wave & 3, fr = C.lane & 15, fq = C.lane >> 4;
    const bf16* WSb = (const bf16*)(C.ws + WS_SGW) + ((size_t)(l * 4 + h) * 128) * 128;
    bf16x8 Bqa[4][4];
#pragma unroll
    for (int qq = 0; qq < 4; ++qq)
#pragma unroll
        for (int ks = 0; ks < 4; ++ks) Bqa[qq][ks] = *(const bf16x8*)(WSb + (size_t)(16 * (qh * 4 + qq) + fr) * 128 + 32 * ks + 8 * fq);
    {
        v2u pvv[16];
#pragma unroll
        for (int q = 0; q < 16; ++q) pvv[q] = *(const v2u*)(P + (size_t)(row0 + C.wave + 8 * q) * PROJ + 1792 + 4 * C.lane);
        const f32x4 gg = *(const f32x4*)(IN_(C, 20) + (size_t)l * 256 + 4 * C.lane);
#pragma unroll 4
        for (int q = 0; q < 16; ++q) {
            const int i = C.wave + 8 * q; const v2u pv = pvv[q];
            f32x4 g; g.x = fgelu(bflo(pv.x)); g.y = fgelu(bfhi(pv.x)); g.z = fgelu(bflo(pv.y)); g.w = fgelu(bfhi(pv.y));
            float s1 = (g.x + g.y) + (g.z + g.w), s2 = (g.x * g.x + g.y * g.y) + (g.z * g.z + g.w * g.w);
            wave_sum2(s1, s2);
            const float mean = s1 * (1.0f / 256.0f);
            const float var = fmaxf(s2 * (1.0f / 256.0f) - mean * mean, 0.f);
            const float rs = __builtin_amdgcn_rsqf(var + EPS);
            g = g - mean;
            g = g * rs * gg;
            LAS bf16* o = vt + (4 * C.lane) * VTS + i;
            o[0] = (bf16)f2bf(g.x); o[VTS] = (bf16)f2bf(g.y); o[2 * VTS] = (bf16)f2bf(g.z); o[3 * VTS] = (bf16)f2bf(g.w);
        }
    }
    __syncthreads();
    bf16x8 Av[4][4];
#pragma unroll
    for (int ct = 0; ct < 4; ++ct)
#pragma unroll
        for (int ks = 0; ks < 4; ++ks) Av[ct][ks] = *(const LAS bf16x8*)(vt + (h * 64 + 16 * ct + fr) * VTS + 32 * ks + 8 * fq);
    const float* BS = IN_(C, 22) + (size_t)(l * 4 + h) * 128;
#pragma unroll
    for (int qq = 0; qq < 4; ++qq) {
        const int qt = qh * 4 + qq, q = 16 * qt + fr;
        const float bias = BS[q];
        const size_t row = (size_t)(row0 + q);
#pragma unroll
        for (int ct = 0; ct < 4; ++ct) {
            f32x4 acc = {0.f, 0.f, 0.f, 0.f};
#pragma unroll
            for (int ks = 0; ks < 4; ++ks) acc = MFMA16(Av[ct][ks], Bqa[qq][ks], acc);
            const int c0 = h * 64 + 16 * ct + 4 * fq;
            const v2u pu = *(const v2u*)(P + row * PROJ + 1536 + c0);
            v2u o; o.x = pk2(fgelu(bflo(pu.x)) * (acc[0] + bias), fgelu(bfhi(pu.x)) * (acc[1] + bias)); o.y = pk2(fgelu(bflo(pu.y)) * (acc[2] + bias), fgelu(bfhi(pu.y)) * (acc[3] + bias));
            *(v2u*)(Y + row * DM + 768 + c0) = o;
        }
    }
    __syncthreads();
}

__device__ __forceinline__ void phase_mixers(const Ctx& C, int l, int sel) {
    if (C.G >= 2 * NCHUNK - 16) {
        if (C.bx < NCHUNK) { if (sel != 2) { mixer_a(C, l, C.bx); mixer_c(C, l, C.bx); } }
        else if (sel != 1) { const int nb = C.G - NCHUNK;
            for (int u = C.bx - NCHUNK; u < 2 * NCHUNK; u += nb) {
                if (u < NCHUNK) mixer_d(C, l, u); else mixer_b(C, l, u - NCHUNK); } }
    } else {
        for (int u = C.bx; u < 4 * NCHUNK; u += C.G) {
            if (u < NCHUNK) mixer_a(C, l, u); else if (u < 2 * NCHUNK) mixer_d(C, l, u - NCHUNK); else if (u < 3 * NCHUNK) mixer_b(C, l, u - 2 * NCHUNK); else mixer_c(C, l, u - 3 * NCHUNK); }
    }
}

__device__ __forceinline__ void phase_fixup(const Ctx& C, int l) {
    LAS float* cr = (LAS float*)C.lds;
    const bf16* P = (const bf16*)(C.ws + WS_P); bf16* Y = (bf16*)(C.ws + WS_Y);
    for (int u = C.bx; u < 2 * NCHUNK; u += C.G) {
        const int chunk = u >> 1, hf = u & 1;
        const bf16* H0 = (const bf16*)(C.ws + WS_HS); const bf16* H1 = H0 + (size_t)NTOK * 256; const bf16* A0 = H0 + (size_t)2 * NTOK * 256; const bf16* A1 = H0 + (size_t)3 * NTOK * 256;
        v2u hv[8][5];
#pragma unroll
        for (int q = 0; q < 8; ++q) { const int idx = C.tid + 512 * q, i = idx >> 6, c4 = (idx & 63) * 4; const size_t row = (size_t)chunk * 128 + hf * 64 + i;
            hv[q][0] = *(const v2u*)(H0 + row * 256 + c4); hv[q][1] = *(const v2u*)(H1 + row * 256 + c4); hv[q][2] = *(const v2u*)(A0 + row * 256 + c4); hv[q][3] = *(const v2u*)(A1 + row * 256 + c4);
            hv[q][4] = *(const v2u*)(P + row * PROJ + 256 + c4); }
        {
            const int c = C.tid & 255, d = C.wave >> 2;
            const bool isctx = chunk < 8; const int b = isctx ? (chunk >> 1) : ((chunk - 8) >> 5), k = isctx ? (chunk & 1) : ((chunk - 8) & 31);
            const int n = isctx ? (d ? 1 - k : k) : (d ? 2 + 31 - k : 2 + k);
            const float* AG = (const float*)(C.ws + WS_AGG);
            float av[33], bv[33];
#pragma unroll
            for (int q = 0; q < 33; ++q) {
                const int cid = (q < 2) ? (b * 2 + (d ? 1 - q : q)) : (8 + b * 32 + (d ? 31 - (q - 2) : (q - 2)));
                const float* ag = AG + ((size_t)(cid * 2 + d) * 2) * 256 + c;
                av[q] = (q < n) ? ag[0] : 1.0f; bv[q] = (q < n) ? ag[256] : 0.0f;
            }
            float carry = 0.f;
#pragma unroll
            for (int q = 0; q < 33; ++q) carry = av[q] * carry + bv[q];
            cr[d * 256 + c] = carry;
        }
        __syncthreads();
#pragma unroll
        for (int q = 0; q < 8; ++q) {
            const int idx = C.tid + 512 * q, i = idx >> 6, c4 = (idx & 63) * 4; const size_t row = (size_t)chunk * 128 + hf * 64 + i;
            const v2u h0 = hv[q][0], h1 = hv[q][1], a0 = hv[q][2], a1 = hv[q][3], ag = hv[q][4];
            const f32x4 cf = *(const LAS f32x4*)(cr + c4), cb = *(const LAS f32x4*)(cr + 256 + c4);
            const float y0 = (bflo(h0.x) + bflo(a0.x) * cf.x + bflo(h1.x) + bflo(a1.x) * cb.x) * fgelu(bflo(ag.x));
            const float y1 = (bfhi(h0.x) + bfhi(a0.x) * cf.y + bfhi(h1.x) + bfhi(a1.x) * cb.y) * fgelu(bfhi(ag.x));
            const float y2 = (bflo(h0.y) + bflo(a0.y) * cf.z + bflo(h1.y) + bflo(a1.y) * cb.z) * fgelu(bflo(ag.y));
            const float y3 = (bfhi(h0.y) + bfhi(a0.y) * cf.w + bfhi(h1.y) + bfhi(a1.y) * cb.w) * fgelu(bfhi(ag.y));
            v2u o; o.x = pk2(y0, y1); o.y = pk2(y2, y3);
            *(v2u*)(Y + row * DM + c4) = o;
        }
        __syncthreads();
    }
}

__device__ __forceinline__ unsigned okey(float x) { const int u = __builtin_bit_cast(int, x); return (unsigned)(u ^ ((u >> 31) | (int)0x80000000)); }
__device__ __forceinline__ unsigned med3u(unsigned a, unsigned b, unsigned c) { unsigned r; asm("v_med3_u32 %0, %1, %2, %3" : "=v"(r) : "v"(a), "v"(b), "v"(c)); return r; }
#define TK_INS(L, xx) do { const unsigned x_ = (xx); _Pragma("unroll") for (int k_ = 15; k_ >= 1; --k_) L[k_] = med3u(L[k_ - 1], L[k_], x_); L[0] = L[0] > x_ ? L[0] : x_; } while (0)

__device__ __forceinline__ void phase_topk(const Ctx& C, int row_lo) {
    LAS unsigned* tl = (LAS unsigned*)C.lds;
    const int NGW = C.G * 8, u0 = (row_lo >> 6) * 8, nun = (NTOK >> 6) * 8 - u0;
    for (int j = 0; ; ++j) {
        int unit;
        if ((j + 1) * NGW <= nun) unit = u0 + j * NGW + C.vcu * 8 + C.wave;
        else { const int rem = nun - j * NGW; if (rem <= 0) break;
               const int q = C.wave * C.G + C.bx; if (q >= rem) break; unit = u0 + j * NGW + q; }
        const int tb = unit >> 3, h = unit & 7; const int row = tb * 64 + C.lane;
        const float* s = ((float*)(C.ws + WS_SC)) + ((size_t)unit * 256) * 64 + C.lane;
#pragma unroll 1
        for (int side = 0; side < 2; ++side) {
            unsigned L[16];
#pragma unroll
            for (int k = 0; k < 16; ++k) L[k] = 0u;
            const float* ss = s + (size_t)(side * 128) * 64;
            float va[32], vb[32];
#pragma unroll
            for (int q = 0; q < 32; ++q) va[q] = ss[(size_t)q * 64];
#pragma unroll
            for (int nb = 0; nb < 128; nb += 64) {
#pragma unroll
                for (int q = 0; q < 32; ++q) vb[q] = ss[(size_t)(nb + 32 + q) * 64];
#pragma unroll
                for (int q = 0; q < 32; ++q) TK_INS(L, (okey(va[q]) & ~127u) | (unsigned)(127 - (nb + q)));
                if (nb + 64 < 128) {
#pragma unroll
                    for (int q = 0; q < 32; ++q) va[q] = ss[(size_t)(nb + 64 + q) * 64];
                }
#pragma unroll
                for (int q = 0; q < 32; ++q) TK_INS(L, (okey(vb[q]) & ~127u) | (unsigned)(127 - (nb + 32 + q)));
            }
            float vals[16];
#pragma unroll
            for (int k = 0; k < 16; ++k) vals[k] = ss[(size_t)(127 - (int)(L[k] & 127u)) * 64];
#pragma unroll
            for (int k = 0; k < 16; ++k) {
                tl[(side * 32 + k) * 512 + C.tid] = 127u - (L[k] & 127u); tl[(side * 32 + 16 + k) * 512 + C.tid] = __builtin_bit_cast(unsigned, vals[k]);
            }
        }
        float v1[16], v2[16];
#pragma unroll
        for (int k = 0; k < 16; ++k) { v1[k] = __builtin_bit_cast(float, tl[(16 + k) * 512 + C.tid]); v2[k] = __builtin_bit_cast(float, tl[(48 + k) * 512 + C.tid]); }
        unsigned M[16];
#pragma unroll
        for (int k = 0; k < 16; ++k) M[k] = 0u;
#pragma unroll
        for (int a = 0; a < 16; ++a)
#pragma unroll
            for (int b = 0; b < 16; ++b)
                if ((a + 1) * (b + 1) <= 16) { const float sm = v1[a] + v2[b]; TK_INS(M, (okey(sm) & ~255u) | (unsigned)(255 - (a * 16 + b))); }
        float sums[16]; int ex[16]; float mx = -3.0e38f;
#pragma unroll
        for (int k = 0; k < 16; ++k) {
            const int f = 255 - (int)(M[k] & 255u), a = f >> 4, b = f & 15;
            const int i1 = (int)tl[a * 512 + C.tid], i2 = (int)tl[(32 + b) * 512 + C.tid];
            const float va = __builtin_bit_cast(float, tl[(16 + a) * 512 + C.tid]), vb = __builtin_bit_cast(float, tl[(48 + b) * 512 + C.tid]);
            sums[k] = va + vb; ex[k] = i1 * 128 + i2; mx = fmaxf(mx, sums[k]);
        }
        float den = 0.f;
#pragma unroll
        for (int k = 0; k < 16; ++k) { sums[k] = expf(sums[k] - mx); den += sums[k]; }
        const float inv = 1.0f / den;
        v4i* pe = (v4i*)(((int*)(C.ws + WS_PE)) + (size_t)row * NPICK + h * 16); f32x4* pc = (f32x4*)(((float*)(C.ws + WS_PC)) + (size_t)row * NPICK + h * 16);
#pragma unroll
        for (int q = 0; q < 4; ++q) { v4i e4; e4.x = ex[4 * q]; e4.y = ex[4 * q + 1]; e4.z = ex[4 * q + 2]; e4.w = ex[4 * q + 3]; pe[q] = e4;
            f32x4 c4; c4.x = sums[4 * q] * inv; c4.y = sums[4 * q + 1] * inv; c4.z = sums[4 * q + 2] * inv; c4.w = sums[4 * q + 3] * inv; pc[q] = c4; }
    }
}

__device__ __forceinline__ int red16_add(int x) {
    x += __builtin_amdgcn_update_dpp(0, x, 0xB1, 0xf, 0xf, true);
    x += __builtin_amdgcn_update_dpp(0, x, 0x4E, 0xf, 0xf, true);
    x += __builtin_amdgcn_update_dpp(0, x, 0x141, 0xf, 0xf, true);
    x += __builtin_amdgcn_update_dpp(0, x, 0x140, 0xf, 0xf, true);
    return x;
}
__device__ __forceinline__ float red16_max(float x) {
    x = fmaxf(x, __builtin_bit_cast(float, __builtin_amdgcn_update_dpp(0, __builtin_bit_cast(int, x), 0xB1, 0xf, 0xf, true)));
    x = fmaxf(x, __builtin_bit_cast(float, __builtin_amdgcn_update_dpp(0, __builtin_bit_cast(int, x), 0x4E, 0xf, 0xf, true)));
    x = fmaxf(x, __builtin_bit_cast(float, __builtin_amdgcn_update_dpp(0, __builtin_bit_cast(int, x), 0x141, 0xf, 0xf, true)));
    x = fmaxf(x, __builtin_bit_cast(float, __builtin_amdgcn_update_dpp(0, __builtin_bit_cast(int, x), 0x140, 0xf, 0xf, true)));
    return x;
}
#define UB0(w) ((float)((w) & 0xffu))
#define UB1(w) ((float)(((w) >> 8) & 0xffu))
#define UB2(w) ((float)(((w) >> 16) & 0xffu))
#define UB3(w) ((float)((w) >> 24))
struct UBuf { v4u u[4]; };
struct VBuf { v4u v[4]; };
__device__ __forceinline__ void u_issue(UBuf& B, int k, int g, int i16, int e_lo, int e_hi, const unsigned char* UQ) {
    const int p = 4 * k + g;
    const int e = __builtin_amdgcn_ds_bpermute((p & 63) << 2, (k < 16) ? e_lo : e_hi);
    const unsigned char* ur = UQ + (size_t)e * DM + 16 * i16;
#pragma unroll
    for (int c = 0; c < 4; ++c) B.u[c] = *(const v4u*)(ur + 256 * c);
}
__device__ __forceinline__ void u_compute(const UBuf& B, int k, int lane, const int (&fq)[16], int& d_lo, int& d_hi) {
    int acc = 0;
#pragma unroll
    for (int c = 0; c < 4; ++c) {
        acc = __builtin_amdgcn_sdot4((int)B.u[c].x, fq[4 * c + 0], acc, false); acc = __builtin_amdgcn_sdot4((int)B.u[c].y, fq[4 * c + 1], acc, false);
        acc = __builtin_amdgcn_sdot4((int)B.u[c].z, fq[4 * c + 2], acc, false); acc = __builtin_amdgcn_sdot4((int)B.u[c].w, fq[4 * c + 3], acc, false);
    }
    acc = red16_add(acc);
#pragma unroll
    for (int q = 0; q < 4; ++q) {
        const int sq = __builtin_amdgcn_readlane(acc, 16 * q); const int tgt = (4 * k + q) & 63;
        if (k < 16) d_lo = (lane == tgt) ? sq : d_lo; else d_hi = (lane == tgt) ? sq : d_hi;
    }
}
__device__ __forceinline__ void v_issue(VBuf& B, int k, int lane, int e_lo, int e_hi, const unsigned char* VQ) {
    const int ev = (k < 16) ? e_lo : e_hi;
#pragma unroll
    for (int q = 0; q < 4; ++q) { const int eq = __builtin_amdgcn_readlane(ev, (4 * k + q) & 63); B.v[q] = *((const v4u*)(VQ + (size_t)eq * DM) + lane); }
}
__device__ __forceinline__ void v_compute(const VBuf& B, int k, int pk_lo, int pk_hi, int (&acc)[16]) {
    const int cq4 = __builtin_amdgcn_readlane((k < 16) ? pk_lo : pk_hi, (4 * k) & 63);
    const unsigned a[4] = {B.v[0].x, B.v[0].y, B.v[0].z, B.v[0].w}, b[4] = {B.v[1].x, B.v[1].y, B.v[1].z, B.v[1].w},
                   c[4] = {B.v[2].x, B.v[2].y, B.v[2].z, B.v[2].w}, d[4] = {B.v[3].x, B.v[3].y, B.v[3].z, B.v[3].w};
#pragma unroll
    for (int w = 0; w < 4; ++w) {
        const unsigned ab_lo = __builtin_amdgcn_perm(b[w], a[w], 0x05010400u), ab_hi = __builtin_amdgcn_perm(b[w], a[w], 0x07030602u);
        const unsigned cd_lo = __builtin_amdgcn_perm(d[w], c[w], 0x05010400u), cd_hi = __builtin_amdgcn_perm(d[w], c[w], 0x07030602u);
        const unsigned t0 = __builtin_amdgcn_perm(cd_lo, ab_lo, 0x05040100u), t1 = __builtin_amdgcn_perm(cd_lo, ab_lo, 0x07060302u);
        const unsigned t2 = __builtin_amdgcn_perm(cd_hi, ab_hi, 0x05040100u), t3 = __builtin_amdgcn_perm(cd_hi, ab_hi, 0x07060302u);
        acc[4 * w + 0] = __builtin_amdgcn_sdot4((int)t0, cq4, acc[4 * w + 0], false); acc[4 * w + 1] = __builtin_amdgcn_sdot4((int)t1, cq4, acc[4 * w + 1], false);
        acc[4 * w + 2] = __builtin_amdgcn_sdot4((int)t2, cq4, acc[4 * w + 2], false); acc[4 * w + 3] = __builtin_amdgcn_sdot4((int)t3, cq4, acc[4 * w + 3], false);
    }
}
__device__ __forceinline__ void phase_gather(const Ctx& C, int l, bf16* Zt, bool fuse_next, int row_lo) {
    const int gw = C.vcu * 8 + C.wave, NGW = C.G * 8;
    const unsigned char* UQ = C.ws + WS_UQ + (size_t)l * NEXP * DM; const unsigned char* VQ = C.ws + WS_VQ + (size_t)l * NEXP * DM;
    const float* US = (const float*)(C.ws + WS_US) + (size_t)l * NEXP; const float* VS = (const float*)(C.ws + WS_VS) + (size_t)l * NEXP;
    const int g = C.lane >> 4, i16 = C.lane & 15;
    const int nrows_all = NTOK - row_lo, nfull = nrows_all / NGW, nrem = nrows_all - nfull * NGW, xq = C.wave * C.G + C.bx;
    const int nmine = nfull + (xq < nrem ? 1 : 0);
#define G_CONV_ITERS ((2 * NEXP + 4 * NGW - 1) / (4 * NGW))
#define G_ROW(k) (((k) < nfull) ? (row_lo + (k) * NGW + gw) : (((k) < nmine) ? (row_lo + nfull * NGW + xq) : NTOK))
    v4u nfa[4], nfb[4]; int ne_lo = 0, ne_hi = 0; float nc_lo = 0.f, nc_hi = 0.f;
#define U_PREFETCH(r) do { if ((r) < NTOK) { const bf16* fr_ = ((bf16*)(C.ws + WS_XN)) + (size_t)(r) * DM + 16 * i16; \
        _Pragma("unroll") for (int c = 0; c < 4; ++c) { nfa[c] = *(const v4u*)(fr_ + 256 * c); nfb[c] = *(const v4u*)(fr_ + 256 * c + 8); } \
        const int* pe_ = ((int*)(C.ws + WS_PE)) + (size_t)(r) * NPICK; const float* pc_ = ((float*)(C.ws + WS_PC)) + (size_t)(r) * NPICK; \
        ne_lo = pe_[C.lane]; ne_hi = pe_[64 + C.lane]; nc_lo = pc_[C.lane]; nc_hi = pc_[64 + C.lane]; } } while (0)
#ifdef PROBE_GSEL
    if (fuse_next || PROBE_GSEL == 1)
#endif
    U_PREFETCH(G_ROW(0));
#ifdef PROBE_GSEL
    if (fuse_next || PROBE_GSEL == 1)
#endif
    for (int kr = 0; kr < nmine; ++kr) {
        const int row = G_ROW(kr);
        int fq[16]; float fs;
        const int e_lo = ne_lo, e_hi = ne_hi; const float c_lo = nc_lo, c_hi = nc_hi;
        {
            float fv[64]; float am = 0.f;
#pragma unroll
            for (int c = 0; c < 4; ++c) { const v4u a = nfa[c], b = nfb[c];
                fv[16 * c + 0] = bflo(a.x); fv[16 * c + 1] = bfhi(a.x); fv[16 * c + 2] = bflo(a.y); fv[16 * c + 3] = bfhi(a.y); fv[16 * c + 4] = bflo(a.z); fv[16 * c + 5] = bfhi(a.z); fv[16 * c + 6] = bflo(a.w); fv[16 * c + 7] = bfhi(a.w);
                fv[16 * c + 8] = bflo(b.x); fv[16 * c + 9] = bfhi(b.x); fv[16 * c + 10] = bflo(b.y); fv[16 * c + 11] = bfhi(b.y); fv[16 * c + 12] = bflo(b.z); fv[16 * c + 13] = bfhi(b.z); fv[16 * c + 14] = bflo(b.w); fv[16 * c + 15] = bfhi(b.w); }
#pragma unroll
            for (int q = 0; q < 64; ++q) am = fmaxf(am, fabsf(fv[q]));
            am = red16_max(am);
            const float inv = am > 0.f ? 127.0f / am : 0.f; fs = am * (1.0f / 127.0f);
#pragma unroll
            for (int q = 0; q < 16; ++q) {
                const int q0 = (int)rintf(fv[4 * q] * inv), q1 = (int)rintf(fv[4 * q + 1] * inv), q2 = (int)rintf(fv[4 * q + 2] * inv), q3 = (int)rintf(fv[4 * q + 3] * inv);
                fq[q] = (int)((unsigned)(q0 & 255) | ((unsigned)(q1 & 255) << 8) | ((unsigned)(q2 & 255) << 16) | ((unsigned)(q3 & 255) << 24));
            }
        }
        U_PREFETCH(G_ROW(kr + 1));
        const float us_lo = US[e_lo], us_hi = US[e_hi], vs_lo = VS[e_lo], vs_hi = VS[e_hi];
        int d_lo = 0, d_hi = 0;
        UBuf A, B;
        u_issue(A, 0, g, i16, e_lo, e_hi, UQ);
#pragma unroll 1
        for (int k = 0; k < 32; k += 2) {
            u_issue(B, k + 1, g, i16, e_lo, e_hi, UQ);
            u_compute(A, k, C.lane, fq, d_lo, d_hi);
            if (k + 2 < 32) u_issue(A, k + 2, g, i16, e_lo, e_hi, UQ);
            u_compute(B, k + 1, C.lane, fq, d_lo, d_hi);
        }
        float* cor = ((float*)(C.ws + WS_CO)) + (size_t)row * NPICK;
        cor[C.lane] = gelu_t((float)d_lo * (fs * us_lo)) * (c_lo * vs_lo);
        cor[64 + C.lane] = gelu_t((float)d_hi * (fs * us_hi)) * (c_hi * vs_hi);
    }
#define V_PREFETCH(r) do { if ((r) < NTOK) { const int* pe_ = ((int*)(C.ws + WS_PE)) + (size_t)(r) * NPICK; const float* co_ = ((float*)(C.ws + WS_CO)) + (size_t)(r) * NPICK; \
        ne_lo = pe_[C.lane]; ne_hi = pe_[64 + C.lane]; nc_lo = co_[C.lane]; nc_hi = co_[64 + C.lane]; } } while (0)
    V_PREFETCH(G_ROW(0));
#ifdef PROBE_GSEL
    if (fuse_next || PROBE_GSEL == 2)
#endif
    for (int kr = 0; kr < nmine; ++kr) {
        const int row = G_ROW(kr);
        const int e_lo = ne_lo, e_hi = ne_hi;
        const float co_lo = nc_lo, co_hi = nc_hi;
        V_PREFETCH(G_ROW(kr + 1));
        if (fuse_next && l < DEPTH - 1 && !(kr & 1)) convert_tables(C, l + 1, kr >> 1, (kr >> 1) + 1);
        float cs; int pk_lo, pk_hi;
        {
            float am = fmaxf(fabsf(co_lo), fabsf(co_hi));
            am = fmaxf(am, DPPF(am, 0xB1)); am = fmaxf(am, DPPF(am, 0x4E)); am = fmaxf(am, DPPF(am, 0x141)); am = fmaxf(am, DPPF(am, 0x140));
            { const int iv = __builtin_bit_cast(int, am);
              am = fmaxf(fmaxf(__builtin_bit_cast(float, __builtin_amdgcn_readlane(iv, 0)), __builtin_bit_cast(float, __builtin_amdgcn_readlane(iv, 16))),
                         fmaxf(__builtin_bit_cast(float, __builtin_amdgcn_readlane(iv, 32)), __builtin_bit_cast(float, __builtin_amdgcn_readlane(iv, 48)))); }
            const float inv = am > 0.f ? 127.0f / am : 0.f; cs = am * (1.0f / 127.0f);
            const int sh = 8 * (C.lane & 3);
            int yl = (((int)rintf(co_lo * inv)) & 255) << sh, yh = (((int)rintf(co_hi * inv)) & 255) << sh;
            yl |= __builtin_amdgcn_update_dpp(0, yl, 0xB1, 0xf, 0xf, true); yl |= __builtin_amdgcn_update_dpp(0, yl, 0x4E, 0xf, 0xf, true);
            yh |= __builtin_amdgcn_update_dpp(0, yh, 0xB1, 0xf, 0xf, true); yh |= __builtin_amdgcn_update_dpp(0, yh, 0x4E, 0xf, 0xf, true);
            pk_lo = yl; pk_hi = yh;
        }
        int acc[16];
#pragma unroll
        for (int i = 0; i < 16; ++i) acc[i] = 0;
        const int mr = (row < NCTX) ? 4 : ((row - NCTX) >> 12);
        v4u* zp = (v4u*)(Zt + (size_t)row * DM) + 2 * C.lane;
        f32x4 zold[4], g2v[4], gpv[4], shv[4], scv[4], ppv[4];
        {
            const f32x4* g2 = (const f32x4*)(((float*)(C.ws + WS_MOD)) + ((size_t)(l * 5 + mr) * 6 + 5) * DM) + 4 * C.lane;
#pragma unroll
            for (int q = 0; q < 4; ++q) g2v[q] = g2[q];
            { const v4u za = zp[0], zb = zp[1];
              zold[0] = (f32x4){bflo(za.x), bfhi(za.x), bflo(za.y), bfhi(za.y)}; zold[1] = (f32x4){bflo(za.z), bfhi(za.z), bflo(za.w), bfhi(za.w)};
              zold[2] = (f32x4){bflo(zb.x), bfhi(zb.x), bflo(zb.y), bfhi(zb.y)}; zold[3] = (f32x4){bflo(zb.z), bfhi(zb.z), bflo(zb.w), bfhi(zb.w)}; }
            if (fuse_next) {
                if (l < DEPTH - 1) {
                    const int l1 = l + 1;
                    const f32x4* gp = (const f32x4*)(IN_(C, 6) + (size_t)l1 * DM) + 4 * C.lane;
                    const float* mb = ((float*)(C.ws + WS_MOD)) + ((size_t)(l1 * 5 + mr) * 6) * DM;
                    const f32x4* shp = (const f32x4*)mb + 4 * C.lane; const f32x4* scp = (const f32x4*)(mb + DM) + 4 * C.lane;
                    const int t = (row - NCTX) & 4095, seg = C.lane >> 4, p = (seg < 2) ? (t >> 6) : (t & 63);
                    const f32x4* pp = (const f32x4*)(((float*)(C.ws + WS_POS)) + (size_t)p * 512 + (seg & 1) * 256 + 16 * (C.lane & 15));
#pragma unroll
                    for (int q = 0; q < 4; ++q) { gpv[q] = gp[q]; shv[q] = shp[q]; scv[q] = scp[q]; ppv[q] = pp[q]; }
                } else {
                    const f32x4* gp = (const f32x4*)IN_(C, 28) + 4 * C.lane;
#pragma unroll
                    for (int q = 0; q < 4; ++q) gpv[q] = gp[q];
                }
            }
        }
        VBuf A, B;
        v_issue(A, 0, C.lane, e_lo, e_hi, VQ);
#pragma unroll 1
        for (int k = 0; k < 32; k += 2) {
            v_issue(B, k + 1, C.lane, e_lo, e_hi, VQ);
            v_compute(A, k, pk_lo, pk_hi, acc);
            if (k + 2 < 32) v_issue(A, k + 2, C.lane, e_lo, e_hi, VQ);
            v_compute(B, k + 1, pk_lo, pk_hi, acc);
        }
        float out[16];
#pragma unroll
        for (int i = 0; i < 16; ++i) out[i] = (float)acc[i] * cs;
        f32x4 zn[4]; float ss = 0.f;
#pragma unroll
        for (int q = 0; q < 4; ++q) { const f32x4 gg = g2v[q]; f32x4 z = zold[q];
            z.x += gg.x * out[4 * q]; z.y += gg.y * out[4 * q + 1]; z.z += gg.z * out[4 * q + 2]; z.w += gg.w * out[4 * q + 3];
            zn[q] = z; ss += (z.x * z.x + z.y * z.y) + (z.z * z.z + z.w * z.w); }
        if (l < DEPTH - 1 || !fuse_next) {
            v4u za, zb; za.x = pk2(zn[0].x, zn[0].y); za.y = pk2(zn[0].z, zn[0].w); za.z = pk2(zn[1].x, zn[1].y); za.w = pk2(zn[1].z, zn[1].w);
            zb.x = pk2(zn[2].x, zn[2].y); zb.y = pk2(zn[2].z, zn[2].w); zb.z = pk2(zn[3].x, zn[3].y); zb.w = pk2(zn[3].z, zn[3].w);
            zp[0] = za; zp[1] = zb;
        }
        if (fuse_next) {
            const float rs = __builtin_amdgcn_rsqf(wave_sum(ss) * (1.0f / DM) + EPS);
            if (l < DEPTH - 1) {
                unsigned w[8];
#pragma unroll
                for (int q = 0; q < 4; ++q) {
                    f32x4 o = (zn[q] * rs * gpv[q]) * (scv[q] + 1.0f) + shv[q];
                    if (row >= NCTX) o = o + ppv[q];
                    w[2 * q] = pk2(o.x, o.y); w[2 * q + 1] = pk2(o.z, o.w);
                }
                v4u* op = (v4u*)(((bf16*)(C.ws + WS_XN)) + (size_t)row * DM) + 2 * C.lane;
                v4u w0; w0.x = w[0]; w0.y = w[1]; w0.z = w[2]; w0.w = w[3]; v4u w1; w1.x = w[4]; w1.y = w[5]; w1.z = w[6]; w1.w = w[7];
                op[0] = w0; op[1] = w1;
            } else if (row >= NCTX) {
                f32x4* op = (f32x4*)(C.out + (size_t)(row - NCTX) * DM) + 4 * C.lane;
#pragma unroll
                for (int q = 0; q < 4; ++q) op[q] = zn[q] * rs * gpv[q];
            }
        }
    }
    if (fuse_next && l < DEPTH - 1) convert_tables(C, l + 1, (nmine + 1) >> 1, 64);
}

struct CtxEpiP { bf16* P; __device__ __forceinline__ void operator()(const f32x4 (&acc)[2][2], int m0, int n0, int fr, int fq) const {
#pragma unroll
    for (int mt = 0; mt < 2; ++mt)
#pragma unroll
        for (int nt = 0; nt < 2; ++nt) { const f32x4 v = acc[mt][nt]; v2u w; w.x = pk2(v[0], v[1]); w.y = pk2(v[2], v[3]);
            *(v2u*)(P + (size_t)(m0 + 16 * mt + fr) * PROJ + n0 + 16 * nt + 4 * fq) = w; } } };
struct CtxEpiResid { bf16* Z; const float* gate; __device__ __forceinline__ void operator()(const f32x4 (&acc)[2][2], int m0, int n0, int fr, int fq) const {
    v2u zv[2][2];
#pragma unroll
    for (int mt = 0; mt < 2; ++mt)
#pragma unroll
        for (int nt = 0; nt < 2; ++nt) zv[mt][nt] = *(const v2u*)(Z + (size_t)(m0 + 16 * mt + fr) * DM + n0 + 16 * nt + 4 * fq);
#pragma unroll
    for (int mt = 0; mt < 2; ++mt)
#pragma unroll
        for (int nt = 0; nt < 2; ++nt) { const f32x4 g = *(const f32x4*)(gate + n0 + 16 * nt + 4 * fq); const v2u z = zv[mt][nt]; const f32x4 a = g * acc[mt][nt];
            v2u w; w.x = pk2(bflo(z.x) + a[0], bfhi(z.x) + a[1]); w.y = pk2(bflo(z.y) + a[2], bfhi(z.y) + a[3]);
            *(v2u*)(Z + (size_t)(m0 + 16 * mt + fr) * DM + n0 + 16 * nt + 4 * fq) = w; } } };
struct CtxEpiScoreT { float* S; __device__ __forceinline__ void operator()(const f32x4 (&acc)[2][2], int m0, int n0, int fr, int fq) const {
#pragma unroll
    for (int mt = 0; mt < 2; ++mt)
#pragma unroll
        for (int nt = 0; nt < 2; ++nt) { const int row = m0 + 16 * mt + fr, col = n0 + 16 * nt + 4 * fq, head = col >> 8, cn = col & 255; const f32x4 v = acc[mt][nt];
            float* bp = S + ((size_t)((row >> 6) * 8 + head) * 256 + cn) * 64 + (row & 63);
            bp[0] = v[0]; bp[64] = v[1]; bp[128] = v[2]; bp[192] = v[3]; } } };

template <class Epi>
__device__ __forceinline__ void ctx_gemm(const Ctx& C, const bf16* A, const bf16* Bt, int M, int N, const Epi& E) {
    constexpr int AST = 1032;
    LAS bf16* As = (LAS bf16*)C.lds;
    const int ntn = N >> 8, ntiles = (M >> 5) * ntn, fr = C.lane & 15, fq = C.lane >> 4;
    for (int t = C.bx; t < ntiles; t += C.G) {
        const int tm = t / ntn, tn = t - tm * ntn, m0 = tm * 32, n0 = tn * 256 + 32 * C.wave;
        const bf16* bp = Bt + (size_t)(n0 + fr) * 1024 + 8 * fq;
        bf16x8 B0[8][2], B1[8][2];
#define CG_LOAD(BUF, ch) do { _Pragma("unroll") for (int ks = 0; ks < 8; ++ks) _Pragma("unroll") for (int nt = 0; nt < 2; ++nt) \
            BUF[ks][nt] = *(const bf16x8*)(bp + (size_t)(16 * nt) * 1024 + 32 * (8 * (ch) + ks)); } while (0)
#define CG_COMP(BUF, ch) do { _Pragma("unroll") for (int ks = 0; ks < 8; ++ks) { const LAS bf16* ap = As + fr * AST + 32 * (8 * (ch) + ks) + 8 * fq; \
            const bf16x8 a0 = *(const LAS bf16x8*)ap, a1 = *(const LAS bf16x8*)(ap + 16 * AST); \
            _Pragma("unroll") for (int nt = 0; nt < 2; ++nt) { acc[0][nt] = MFMA16(BUF[ks][nt], a0, acc[0][nt]); acc[1][nt] = MFMA16(BUF[ks][nt], a1, acc[1][nt]); } } } while (0)
        CG_LOAD(B0, 0);
        {
            v4u tmp[8];
#pragma unroll
            for (int q = 0; q < 8; ++q) { const int idx = C.tid + 512 * q, r = idx >> 7, c8 = (idx & 127) * 8; tmp[q] = *(const v4u*)(A + (size_t)(m0 + r) * 1024 + c8); }
#pragma unroll
            for (int q = 0; q < 8; ++q) { const int idx = C.tid + 512 * q, r = idx >> 7, c8 = (idx & 127) * 8; *(LAS v4u*)(As + r * AST + c8) = tmp[q]; }
        }
        __syncthreads();
        f32x4 acc[2][2];
#pragma unroll
        for (int mt = 0; mt < 2; ++mt)
#pragma unroll
            for (int nt = 0; nt < 2; ++nt) acc[mt][nt] = (f32x4){0.f, 0.f, 0.f, 0.f};
        CG_LOAD(B1, 1); CG_COMP(B0, 0);
        CG_LOAD(B0, 2); CG_COMP(B1, 1);
        CG_LOAD(B1, 3); CG_COMP(B0, 2);
        CG_COMP(B1, 3);
#undef CG_LOAD
#undef CG_COMP
        E(acc, m0, n0, fr, fq);
        __syncthreads();
    }
}

#ifndef PROBE_PHASE
#define PROBE_PHASE -1
#define PROBE_REP 0
#endif
#ifndef PGA
#define PGA true
#endif
#ifndef PGS
#define PGS true
#endif
#ifndef PROBE_P0MASK
#define PROBE_P0MASK 15
#endif
#ifndef PROBE_MIXSEL
#define PROBE_MIXSEL 0
#endif
struct Args { const float* in[29]; float* out; unsigned char* ws; int ph_lo, ph_hi; };
__global__ void __launch_bounds__(512, 2) mk_fwd(Args args) {
    extern __shared__ __attribute__((aligned(16))) unsigned char lds_raw[];
    {
        LAS unsigned char* l0 = (LAS unsigned char*)lds_raw;
        for (int u = threadIdx.x; u < (LDS_BYTES - LDSCTL_OFF) / 4; u += 512) ((LAS unsigned*)(l0 + LDSCTL_OFF))[u] = 0u;
        __syncthreads();
    }
    const int lo = args.ph_lo, hi = args.ph_hi;
    XcdBarrier bar; bar.bar = (unsigned*)(args.ws + WS_CTL) + CW_BAR; bar.x = 0; bar.st = nullptr;
    if (hi - lo > 1) bar = xcd_barrier_post((unsigned*)(args.ws + WS_CTL) + CW_BAR, (volatile LAS unsigned*)((LAS unsigned char*)lds_raw + MISC_OFF) + 8);

#if PROBE_REP > 0
    int ph = lo, rep = 0;
#else
    int ph = lo; constexpr int rep = 0;
#endif
    while (ph < hi) {
        int tid = threadIdx.x; asm volatile("" : "+v"(tid));
        int bx = blockIdx.x; asm volatile("" : "+s"(bx));
        const AS4 unsigned char* kp = (const AS4 unsigned char*)__builtin_amdgcn_kernarg_segment_ptr(); asm volatile("" : "+s"(kp));
        Ctx C;
        unsigned ldsoff = 0; asm volatile("" : "+s"(ldsoff));
        C.lds = (LAS unsigned char*)lds_raw + ldsoff;
        C.tid = tid; C.lane = tid & 63; C.wave = __builtin_amdgcn_readfirstlane(tid >> 6);
        C.G = gridDim.x; C.bx = bx; C.vcu = (C.G % 8 == 0) ? (bx % 8) * (C.G / 8) + bx / 8 : bx;
        C.kp = kp; C.out = *(float* const AS4*)(kp + 232); C.ws = *(unsigned char* const AS4*)(kp + 240);
        if (ph == 0) { const int m1 = (C.bx & 1) ? 12 : 3; phase_p0a(C, m1); phase_p0a(C, 15 ^ m1); if (PROBE_PHASE == 100) { xcd_barrier(bar); phase_p0a(C, PROBE_P0MASK & m1); phase_p0a(C, PROBE_P0MASK & (15 ^ m1)); } }
        else if (ph == 1) { phase_p0b(C); if (PROBE_PHASE == 200) { for (int q = 0; q < 32; ++q) xcd_barrier(bar); } }
        else if (ph == 2) phase_rows<0>(C, 0, 0);
        else {
            const int l = (ph - 3) / 11, st = (ph - 3) % 11;
            const int s = (st < 2) ? 1 : (st < 4) ? st : (st < 6) ? 4 : (st == 6) ? 5 : (st < 9) ? 6 : st - 2;
            const bool tail = (st == 1 || st == 5 || st == 8);
            bf16* Zt = (rep > 0) ? (bf16*)(C.ws + WS_SC) : (bf16*)(C.ws + WS_Z);
            if (s == 1 && !tail) { pg8::Gemm g{((bf16*)(C.ws + WS_XN)) + (size_t)NCTX * DM, ((bf16*)(C.ws + WS_WIN)) + (size_t)l * 2048 * 1024, NLAT, 2048, 1024}; pg8::StaticOrder S; S.init(NLAT, 2048, C.G, C.bx);
                pg8::EpiBf16 E{((bf16*)(C.ws + WS_P)) + (size_t)NCTX * PROJ, PROJ}; pg8::gemm_phase<pg8::EpiBf16, pg8::StaticOrder, PGA, PGS>(C.lds, g, S, E, C.tid); }
            else if (s == 1) {
                CtxEpiP EC{(bf16*)(C.ws + WS_P)}; ctx_gemm(C, (const bf16*)(C.ws + WS_XN), ((const bf16*)(C.ws + WS_WIN)) + (size_t)l * 2048 * 1024, NCTX, (l == DEPTH - 1) ? 256 : 2048, EC); }
            else if (s == 2) phase_mixers(C, l, rep > 0 ? PROBE_MIXSEL : 0);
            else if (s == 3) phase_fixup(C, l);
            else if (s == 4 && !tail) { const int r0 = NCTX;
                pg8::Gemm g{((bf16*)(C.ws + WS_Y)) + (size_t)r0 * DM, ((bf16*)(C.ws + WS_WOUT)) + (size_t)l * 1024 * 1024, NTOK - r0, 1024, 1024}; pg8::StaticOrder S; S.init(NTOK - r0, 1024, C.G, C.bx);
                pg8::EpiResid E{Zt + (size_t)r0 * DM, DM, ((float*)(C.ws + WS_MOD)) + ((size_t)(l * 5) * 6 + 2) * DM, 6 * DM, r0 / 256}; pg8::gemm_phase<pg8::EpiResid, pg8::StaticOrder, PGA, PGS>(C.lds, g, S, E, C.tid); }
            else if (s == 4) { if (l < DEPTH - 1) { CtxEpiResid EC{Zt, ((float*)(C.ws + WS_MOD)) + ((size_t)(l * 5 + 4) * 6 + 2) * DM}; ctx_gemm(C, (const bf16*)(C.ws + WS_Y), ((const bf16*)(C.ws + WS_WOUT)) + (size_t)l * 1024 * 1024, NCTX, 1024, EC); } }
            else if (s == 5) phase_rows<1>(C, l, (l == DEPTH - 1) ? NCTX : 0);
            else if (s == 6 && !tail) { const int r0 = NCTX;
                pg8::Gemm g{((bf16*)(C.ws + WS_XN)) + (size_t)r0 * DM, ((bf16*)(C.ws + WS_WCMB)) + (size_t)l * 2048 * 1024, NTOK - r0, 2048, 1024}; pg8::StaticOrder S; S.init(NTOK - r0, 2048, C.G, C.bx);
                pg8::EpiScoreT E{((float*)(C.ws + WS_SC)), r0}; pg8::gemm_phase<pg8::EpiScoreT, pg8::StaticOrder, PGA, PGS>(C.lds, g, S, E, C.tid); }
            else if (s == 6) { if (l < DEPTH - 1) { CtxEpiScoreT EC{(float*)(C.ws + WS_SC)}; ctx_gemm(C, (const bf16*)(C.ws + WS_XN), ((const bf16*)(C.ws + WS_WCMB)) + (size_t)l * 2048 * 1024, NCTX, 2048, EC); } }
            else if (s == 7) phase_topk(C, (l == DEPTH - 1) ? NCTX : 0);
            else phase_gather(C, l, Zt, rep == 0, (l == DEPTH - 1) ? NCTX : 0);
        }
        bool need_bar = true;
#if PROBE_REP > 0
        { const int st_ = (ph >= 3) ? (ph - 3) % 11 : -1;
          const int s_ = (st_ < 0) ? -1 : (st_ < 2) ? 1 : (st_ < 4) ? st_ : (st_ < 6) ? 4 : (st_ == 6) ? 5 : (st_ < 9) ? 6 : st_ - 2;
          const bool main_gemm = (st_ == 0 || st_ == 4 || st_ == 7);
          if (PROBE_PHASE == 11 && st_ == 1 && rep < PROBE_REP) ++rep;
          else if (PROBE_PHASE == 11) { ++ph; rep = 0; if (main_gemm) need_bar = false; }
          else if (s_ == PROBE_PHASE && rep < PROBE_REP && !main_gemm && st_ != 1 && st_ != 5 && st_ != 8) ++rep;
          else if (s_ == PROBE_PHASE && rep < PROBE_REP && (st_ == 1 || st_ == 5 || st_ == 8)) { ++rep; --ph; }
          else { ++ph; rep = (main_gemm ? rep : 0); if (main_gemm) need_bar = false; } }
#else
        { const int st_ = (ph >= 3) ? (ph - 3) % 11 : -1; need_bar = !(st_ == 0 || st_ == 4 || st_ == 7); ++ph; }
#endif
        if (ph < hi && need_bar) xcd_barrier(bar);
    }
}

extern "C" void kernel_launch(void* const* d_in, const int* in_sizes, int n_in, void* d_out, int out_size, void* d_ws, size_t ws_size, hipStream_t stream) {
    static int grid = 0;
    if (grid == 0) {
        if (n_in != 29 || out_size != NLAT * DM || ws_size < WS_END) { fprintf(stderr, "kernel_launch: unexpected shapes (n_in %d, out %d, ws %zu)\n", n_in, out_size, ws_size); grid = -1; return; }
        int dev = 0, cus = 0, per_cu = 0;
        if (hipGetDevice(&dev) != hipSuccess || hipDeviceGetAttribute(&cus, hipDeviceAttributeMultiprocessorCount, dev) != hipSuccess) { grid = -1; return; }
        if (hipFuncSetAttribute((const void*)mk_fwd, hipFuncAttributeMaxDynamicSharedMemorySize, LDS_BYTES) != hipSuccess) { fprintf(stderr, "kernel_launch: hipFuncSetAttribute failed\n"); grid = -1; return; }
        if (hipOccupancyMaxActiveBlocksPerMultiprocessor(&per_cu, (const void*)mk_fwd, 512, LDS_BYTES) != hipSuccess || per_cu < 1) { fprintf(stderr, "kernel_launch: occupancy query says %d blocks per CU\n", per_cu); (void)hipGetLastError(); grid = -1; return; }
        grid = cus;
    }
    if (grid < 0) return;
    if (hipMemsetAsync((char*)d_ws + WS_CTL, 0, CTL_ZERO_BYTES, stream) != hipSuccess) return;
    Args a{};
    for (int i = 0; i < 29; ++i) a.in[i] = (const float*)d_in[i];
    a.out = (float*)d_out; a.ws = (unsigned char*)d_ws;
#if MK_SINGLE
    a.ph_lo = 0; a.ph_hi = NPH;
    void* kargs[] = {&a};
    hipError_t le = hipLaunchCooperativeKernel((const void*)mk_fwd, dim3(grid), dim3(512), kargs, LDS_BYTES, stream);
    if (le != hipSuccess) fprintf(stderr, "kernel_launch: cooperative launch failed: %s (grid %d)\n", hipGetErrorName(le), grid);
#else
    for (int ph = 0; ph < NPH; ++ph) {
        a.ph_lo = ph; a.ph_hi = ph + 1;
        hipLaunchKernelGGL(mk_fwd, dim3(grid), dim3(512), LDS_BYTES, stream, a);
    }
#endif
}
```

```cpp
#include <hip/hip_runtime.h>
#include <cstdio>
#include <cstdint>

#ifndef MK_SINGLE
#define MK_SINGLE 1
#endif

namespace pg8 {
#define PG8_LAS __attribute__((address_space(3)))
typedef unsigned short bf16_t;
typedef short bf16x8 __attribute__((ext_vector_type(8)));
typedef float f32x4 __attribute__((ext_vector_type(4)));
typedef unsigned u32x4 __attribute__((ext_vector_type(4)));
constexpr int BM = 256, BK = 64, HALF = 128, HTB = HALF * BK * 2  , STAGE_BYTES = 8 * HTB, NXCD = 8, WGM = 8;

__host__ __device__ __forceinline__ int lds_byte(int r, int c) { const int st = (r >> 4) * 2 + (c >> 5), rr = r & 15, cc = c & 31, ob = rr * 64 + cc * 2; return st * 1024 + (ob ^ (((ob >> 9) & 1) << 5)); }
__host__ __device__ __forceinline__ void stage_rc(int b, int& R, int& C) { const int st = b / 1024, sb = b % 1024, swz = sb ^ (((sb >> 9) & 1) << 5); R = (st >> 1) * 16 + swz / 64; C = (st & 1) * 32 + (swz % 64) / 2; }
__host__ __device__ __forceinline__ int perm32(int rho) { const int n = rho >> 4, i = rho & 15; return 8 * (i >> 2) + 4 * n + (i & 3); }

struct Unit { int pm, pn; };
struct Gemm { const bf16_t* A; const bf16_t* Bt; int M, N, K; };

struct StaticOrder {
    int nM, nN, nwg, G, c;
    __host__ __device__ void init(int M, int N, int G_, int c_) { nM = M / BM; nN = N / BM; nwg = nM * nN; G = G_; c = c_; }
    __host__ __device__ bool next(int i, Unit& u) const {
        const long L = (long)i * G + c; if (L >= nwg) return false;
        int wgid = (int)L; { const int q = nwg / NXCD, r = nwg % NXCD, xcd = wgid % NXCD, off = wgid / NXCD; wgid = (xcd < r ? xcd * (q + 1) : r * (q + 1) + (xcd - r) * q) + off; }
        const int nig = WGM * nN, gid = wgid / nig, fm = gid * WGM, gsz = (nM - fm) < WGM ? (nM - fm) : WGM;
        u.pm = fm + ((wgid % nig) % gsz); u.pn = (wgid % nig) / gsz; return true;
    }
    __device__ __forceinline__ void a_ready(const Unit&) const {}
    __device__ __forceinline__ void done(const Unit&) const {}
};

__device__ __forceinline__ unsigned cvt_pk_bf16(float lo, float hi) { unsigned r; asm volatile("v_cvt_pk_bf16_f32 %0, %1, %2" : "=v"(r) : "v"(lo), "v"(hi)); return r; }

struct EpiBf16 {
    static constexpr bool PERM = true, AFTER_DRAIN = false;
    bf16_t* O; int ldc;
    __device__ __forceinline__ void operator()(const f32x4 (&acc)[2][2][4][2], const Unit& u, int wr, int wc, int fr, int fq) const {
        const int row0 = u.pm * BM + wr * 64 + fr; const int col0 = u.pn * BM + wc * 32 + 8 * fq;
#pragma unroll
        for (int ai = 0; ai < 2; ++ai)
#pragma unroll
            for (int m = 0; m < 4; ++m) { bf16_t* rowp = O + (size_t)(row0 + ai * HALF + m * 16) * ldc + col0;
#pragma unroll
                for (int bj = 0; bj < 2; ++bj) { const f32x4 v0 = acc[ai][bj][m][0], v1 = acc[ai][bj][m][1];
                    u32x4 w; w.x = cvt_pk_bf16(v0[0], v0[1]); w.y = cvt_pk_bf16(v0[2], v0[3]); w.z = cvt_pk_bf16(v1[0], v1[1]); w.w = cvt_pk_bf16(v1[2], v1[3]);
                    *(u32x4*)(rowp + bj * HALF) = w; } }
    }
};
struct EpiF32 {
    static constexpr bool PERM = false, AFTER_DRAIN = false;
    float* C; int ldc;
    __device__ __forceinline__ void operator()(const f32x4 (&acc)[2][2][4][2], const Unit& u, int wr, int wc, int fr, int fq) const {
        const int row0 = u.pm * BM + wr * 64 + fr, col0 = u.pn * BM + wc * 32 + 4 * fq;
#pragma unroll
        for (int ai = 0; ai < 2; ++ai)
#pragma unroll
            for (int m = 0; m < 4; ++m) { float* rowp = C + (size_t)(row0 + ai * HALF + m * 16) * ldc + col0;
#pragma unroll
                for (int bj = 0; bj < 2; ++bj)
#pragma unroll
                    for (int n = 0; n < 2; ++n) *(f32x4*)(rowp + bj * HALF + n * 16) = acc[ai][bj][m][n]; }
    }
};
struct EpiResid {
    static constexpr bool PERM = true, AFTER_DRAIN = false;
    unsigned short* Z; int ldc; const float* gate0; int gstride; int pmoff;
    __device__ __forceinline__ void operator()(const f32x4 (&acc)[2][2][4][2], const Unit& u, int wr, int wc, int fr, int fq) const {
        const int row0 = u.pm * BM + wr * 64 + fr, col0 = u.pn * BM + wc * 32 + 8 * fq;
        const int pmg = u.pm + pmoff; const int mr = (pmg < 4) ? 4 : ((pmg - 4) >> 4);
        const float* gp = gate0 + (size_t)mr * gstride + col0;
        f32x4 gv[2][2];
#pragma unroll
        for (int bj = 0; bj < 2; ++bj)
#pragma unroll
            for (int n = 0; n < 2; ++n) gv[bj][n] = *(const f32x4*)(gp + bj * HALF + n * 4);
#pragma unroll
        for (int ai = 0; ai < 2; ++ai) {
            u32x4 zv[4][2];
#pragma unroll
            for (int m = 0; m < 4; ++m)
#pragma unroll
                for (int bj = 0; bj < 2; ++bj) zv[m][bj] = *(const u32x4*)(Z + (size_t)(row0 + ai * HALF + m * 16) * ldc + col0 + bj * HALF);
#pragma unroll
            for (int m = 0; m < 4; ++m)
#pragma unroll
                for (int bj = 0; bj < 2; ++bj) { const u32x4 z = zv[m][bj]; const f32x4 a0 = acc[ai][bj][m][0] * gv[bj][0], a1 = acc[ai][bj][m][1] * gv[bj][1];
                    u32x4 w;
                    w.x = cvt_pk_bf16(__builtin_bit_cast(float, z.x << 16) + a0[0], __builtin_bit_cast(float, z.x & 0xffff0000u) + a0[1]);
                    w.y = cvt_pk_bf16(__builtin_bit_cast(float, z.y << 16) + a0[2], __builtin_bit_cast(float, z.y & 0xffff0000u) + a0[3]);
                    w.z = cvt_pk_bf16(__builtin_bit_cast(float, z.z << 16) + a1[0], __builtin_bit_cast(float, z.z & 0xffff0000u) + a1[1]);
                    w.w = cvt_pk_bf16(__builtin_bit_cast(float, z.w << 16) + a1[2], __builtin_bit_cast(float, z.w & 0xffff0000u) + a1[3]);
                    *(u32x4*)(Z + (size_t)(row0 + ai * HALF + m * 16) * ldc + col0 + bj * HALF) = w; }
        }
    }
};

struct EpiScoreT {
    static constexpr bool PERM = false, AFTER_DRAIN = false;
    float* S; int row_base;
    __device__ __forceinline__ void operator()(const f32x4 (&acc)[2][2][4][2], const Unit& u, int wr, int wc, int fr, int fq) const {
        const int row0 = row_base + u.pm * BM + wr * 64 + fr, cn0 = wc * 32 + 4 * fq, head = u.pn;
#pragma unroll
        for (int ai = 0; ai < 2; ++ai)
#pragma unroll
            for (int m = 0; m < 4; ++m) { const int row = row0 + ai * HALF + m * 16;
                float* bp = S + ((size_t)((row >> 6) * 8 + head) * 256) * 64 + (row & 63);
#pragma unroll
                for (int bj = 0; bj < 2; ++bj)
#pragma unroll
                    for (int n = 0; n < 2; ++n) { const int cn = cn0 + bj * HALF + n * 16; const f32x4 v = acc[ai][bj][m][n];
                        bp[(size_t)cn * 64] = v[0]; bp[(size_t)(cn + 1) * 64] = v[1]; bp[(size_t)(cn + 2) * 64] = v[2]; bp[(size_t)(cn + 3) * 64] = v[3]; } }
    }
};

template <class Epi, class Sched, bool ALIGN_EPI = false, bool SP2 = false>
__device__ __forceinline__ void gemm_phase(PG8_LAS unsigned char* lds, const Gemm g, const Sched& S, const Epi& E, const int tid) {
    const int wid = __builtin_amdgcn_readfirstlane(tid >> 6), lane = tid & 63, wr = wid >> 2, wc = wid & 3, fr = lane & 15, fq = lane >> 4;
    const int K = g.K, nt = K / BK;
    unsigned voffA[2], voffB[2];
#pragma unroll
    for (int i = 0; i < 2; ++i) { int R, C; stage_rc(tid * 16 + i * 8192, R, C); const int Rb = Epi::PERM ? ((R & ~31) + perm32(R & 31)) : R;
        voffA[i] = (unsigned)(R * K + C) * 2u; voffB[i] = (unsigned)(Rb * K + C) * 2u; }
    const size_t kstep = (size_t)(BK * 2);
    const size_t hstep = (size_t)HALF * K * 2;
    const size_t tstep = 2 * hstep;
    const unsigned ldsw = (unsigned)wid * 1024u;
    const int aoff = lds_byte(wr * 64 + fr, fq * 8), boff = lds_byte(wc * 32 + fr, fq * 8);
#define PG8_SA(b, h) (((b) * 2 + (h)) * HTB)
#define PG8_SB(b, h) ((4 + (b) * 2 + (h)) * HTB)
#define PG8_STAGE(bufoff, gbase, voff) do { _Pragma("unroll") for (int _i = 0; _i < 2; ++_i) \
        __builtin_amdgcn_global_load_lds((const unsigned*)((const char*)(gbase) + (voff)[_i]), (PG8_LAS unsigned*)(lds + (bufoff) + ldsw + _i * 8192), 16, 0, 0); } while (0)
#define PG8_LDA(dst, b, h) do { _Pragma("unroll") for (int m = 0; m < 4; ++m) _Pragma("unroll") for (int k = 0; k < 2; ++k) dst[m][k] = *(const PG8_LAS bf16x8*)(lds + PG8_SA(b, h) + aoff + m * 2048 + k * 1024); } while (0)
#define PG8_LDB(dst, b, h) do { _Pragma("unroll") for (int n = 0; n < 2; ++n) _Pragma("unroll") for (int k = 0; k < 2; ++k) dst[n][k] = *(const PG8_LAS bf16x8*)(lds + PG8_SB(b, h) + boff + n * 2048 + k * 1024); } while (0)
#define PG8_MMA(ai, bj, At, Bt) do { __builtin_amdgcn_s_setprio(1); _Pragma("unroll") for (int m = 0; m < 4; ++m) _Pragma("unroll") for (int n = 0; n < 2; ++n) _Pragma("unroll") for (int k = 0; k < 2; ++k) \
        acc[ai][bj][m][n] = __builtin_amdgcn_mfma_f32_16x16x32_bf16(Bt[n][k], At[m][k], acc[ai][bj][m][n], 0, 0, 0); __builtin_amdgcn_s_setprio(0); } while (0)
#define PG8_WAIT_V(n) asm volatile("s_waitcnt vmcnt(" #n ")" ::: "memory")
#define PG8_WAIT_L(n) asm volatile("s_waitcnt lgkmcnt(" #n ")" ::: "memory")
#define PG8_BAR __builtin_amdgcn_s_barrier()
#define PG8_SCHED __builtin_amdgcn_sched_barrier(0)
    Unit cur, nxt; int ui = 0;
    if (!S.next(0, cur)) return;
    f32x4 acc[2][2][4][2];
#pragma unroll
    for (int a = 0; a < 2; ++a)
#pragma unroll
        for (int b = 0; b < 2; ++b)
#pragma unroll
            for (int m = 0; m < 4; ++m)
#pragma unroll
                for (int n = 0; n < 2; ++n) acc[a][b][m][n] = (f32x4){0.f, 0.f, 0.f, 0.f};
    bf16x8 At[4][2], B0[2][2], B1[2][2];
    const char* cA = (const char*)g.A + (size_t)cur.pm * tstep; const char* cB = (const char*)g.Bt + (size_t)cur.pn * tstep;
    S.a_ready(cur);
    if constexpr (SP2) {
        PG8_STAGE(PG8_SB(0, 0), cB, voffB); PG8_STAGE(PG8_SB(0, 1), cB + hstep, voffB); PG8_STAGE(PG8_SA(0, 0), cA, voffA); PG8_STAGE(PG8_SA(0, 1), cA + hstep, voffA);
        if (wr == 1) PG8_BAR;
        PG8_WAIT_V(2); PG8_BAR;
        PG8_STAGE(PG8_SB(1, 0), cB + kstep, voffB); PG8_STAGE(PG8_SA(1, 0), cA + kstep, voffA); PG8_STAGE(PG8_SB(1, 1), cB + hstep + kstep, voffB);
        PG8_WAIT_V(6); PG8_BAR;
    } else {
        PG8_STAGE(PG8_SB(0, 0), cB, voffB); PG8_STAGE(PG8_SA(0, 0), cA, voffA); PG8_STAGE(PG8_SB(0, 1), cB + hstep, voffB); PG8_STAGE(PG8_SA(0, 1), cA + hstep, voffA);
        if (wr == 1) PG8_BAR;
        PG8_WAIT_V(4); PG8_BAR;
        PG8_STAGE(PG8_SB(1, 0), cB + kstep, voffB); PG8_STAGE(PG8_SA(1, 0), cA + kstep, voffA); PG8_STAGE(PG8_SB(1, 1), cB + hstep + kstep, voffB);
        PG8_WAIT_V(6); PG8_BAR;
    }
    for (;;) {
        const bool has_next = S.next(ui + 1, nxt);
        const char* nA = has_next ? (const char*)g.A + (size_t)nxt.pm * tstep : cA; const char* nB = has_next ? (const char*)g.Bt + (size_t)nxt.pn * tstep : cB;
        for (int t = 0; t < nt; t += 2) {
            const bool last = (t == nt - 2);
            const char* a1 = cA + (size_t)(t + 1) * kstep;
            const char* a2 = last ? nA : cA + (size_t)(t + 2) * kstep; const char* b2 = last ? nB : cB + (size_t)(t + 2) * kstep;
            const char* a3 = a2 + kstep; const char* b3 = b2 + kstep;
            if (last && has_next) S.a_ready(nxt);
            if constexpr (SP2) {
            PG8_LDB(B0, 0, 0); PG8_LDB(B1, 0, 1); PG8_SCHED; PG8_LDA(At, 0, 0); PG8_STAGE(PG8_SA(1, 1), a1 + hstep, voffA);
            PG8_WAIT_V(8); PG8_WAIT_L(0); PG8_BAR; PG8_MMA(0, 0, At, B0); PG8_MMA(0, 1, At, B1); PG8_BAR; PG8_SCHED;
            PG8_LDA(At, 0, 1); PG8_STAGE(PG8_SB(0, 0), b2, voffB); PG8_STAGE(PG8_SB(0, 1), b2 + hstep, voffB); PG8_STAGE(PG8_SA(0, 0), a2, voffA);
            PG8_WAIT_V(8); PG8_WAIT_L(0); PG8_BAR; PG8_MMA(1, 0, At, B0); PG8_MMA(1, 1, At, B1); PG8_BAR; PG8_SCHED;
            PG8_LDB(B0, 1, 0); PG8_LDB(B1, 1, 1); PG8_SCHED; PG8_LDA(At, 1, 0); PG8_STAGE(PG8_SA(0, 1), a2 + hstep, voffA);
            PG8_WAIT_V(8); PG8_WAIT_L(0); PG8_BAR; PG8_MMA(0, 0, At, B0); PG8_MMA(0, 1, At, B1); PG8_BAR; PG8_SCHED;
            PG8_LDA(At, 1, 1); PG8_STAGE(PG8_SB(1, 0), b3, voffB); PG8_STAGE(PG8_SB(1, 1), b3 + hstep, voffB); PG8_STAGE(PG8_SA(1, 0), a3, voffA);
            PG8_WAIT_V(8); PG8_WAIT_L(0); PG8_BAR; PG8_MMA(1, 0, At, B0); PG8_MMA(1, 1, At, B1); PG8_BAR; PG8_SCHED;
            } else {
            PG8_LDB(B0, 0, 0); PG8_SCHED; PG8_LDA(At, 0, 0); PG8_STAGE(PG8_SA(1, 1), a1 + hstep, voffA);
            PG8_WAIT_L(8); PG8_BAR; PG8_WAIT_L(0); PG8_MMA(0, 0, At, B0); PG8_BAR; PG8_SCHED;
            PG8_LDB(B1, 0, 1); PG8_STAGE(PG8_SB(0, 0), b2, voffB);
            PG8_BAR; PG8_WAIT_L(0); PG8_MMA(0, 1, At, B1); PG8_BAR;
            PG8_LDA(At, 0, 1); PG8_STAGE(PG8_SA(0, 0), a2, voffA);
            PG8_BAR; PG8_WAIT_L(0); PG8_MMA(1, 0, At, B0); PG8_BAR; PG8_SCHED;
            PG8_STAGE(PG8_SB(0, 1), b2 + hstep, voffB);
            PG8_WAIT_V(6); PG8_BAR; PG8_MMA(1, 1, At, B1); PG8_BAR;
            PG8_LDB(B0, 1, 0); PG8_SCHED; PG8_LDA(At, 1, 0); PG8_STAGE(PG8_SA(0, 1), a2 + hstep, voffA);
            PG8_WAIT_L(8); PG8_BAR; PG8_WAIT_L(0); PG8_MMA(0, 0, At, B0); PG8_BAR; PG8_SCHED;
            PG8_LDB(B1, 1, 1); PG8_STAGE(PG8_SB(1, 0), b3, voffB);
            PG8_BAR; PG8_WAIT_L(0); PG8_MMA(0, 1, At, B1); PG8_BAR;
            PG8_LDA(At, 1, 1); PG8_STAGE(PG8_SA(1, 0), a3, voffA);
            PG8_BAR; PG8_WAIT_L(0); PG8_MMA(1, 0, At, B0); PG8_BAR; PG8_SCHED;
            PG8_STAGE(PG8_SB(1, 1), b3 + hstep, voffB);
            PG8_WAIT_V(6); PG8_BAR; PG8_MMA(1, 1, At, B1); PG8_BAR;
            }
        }
        if constexpr (ALIGN_EPI) { if (wr == 0) PG8_BAR; }
        if constexpr (!Epi::AFTER_DRAIN) { E(acc, cur, wr, wc, fr, fq); S.done(cur); }
        if (!has_next) break;
#pragma unroll
        for (int a = 0; a < 2; ++a)
#pragma unroll
            for (int b = 0; b < 2; ++b)
#pragma unroll
                for (int m = 0; m < 4; ++m)
#pragma unroll
                    for (int n = 0; n < 2; ++n) acc[a][b][m][n] = (f32x4){0.f, 0.f, 0.f, 0.f};
        cur = nxt; cA = nA; cB = nB; ++ui;
        if constexpr (ALIGN_EPI) { if (wr == 1) PG8_BAR; }
    }
    PG8_WAIT_V(0);
    if constexpr (!ALIGN_EPI) { if (wr == 0) PG8_BAR; }
    PG8_BAR;
    if constexpr (Epi::AFTER_DRAIN) { E.fused(acc, cur, wr, wc, fr, fq, lds, wid, lane); S.done(cur); }
#undef PG8_SA
#undef PG8_SB
#undef PG8_STAGE
#undef PG8_LDA
#undef PG8_LDB
#undef PG8_MMA
#undef PG8_WAIT_V
#undef PG8_WAIT_L
#undef PG8_BAR
#undef PG8_SCHED
}
}

constexpr int DM = 1024, NB = 4, SEQ = 4096, DEPTH = 4, CTXL = 256;
constexpr int NCTX = NB * CTXL, NLAT = NB * SEQ, NTOK = NCTX + NLAT;
constexpr int PROJ = 2048, NEXP = 16384, NPICK = 128;
constexpr int NCHUNK = NTOK / 128;
constexpr float EPS = 1e-6f;
constexpr int NPH = 3 + 11 * DEPTH;

constexpr size_t MiB = 1u << 20;
constexpr size_t WS_CTL = 0, CTL_ZERO_BYTES = 1 * MiB;
constexpr size_t WS_MODP = 616 * MiB;
constexpr size_t WS_MOD  = 5 * MiB;
constexpr size_t WS_POS  = 6 * MiB;
constexpr size_t WS_AGG  = 7 * MiB;
constexpr size_t WS_WIN  = 8 * MiB;
constexpr size_t WS_WOUT = 24 * MiB;
constexpr size_t WS_WCMB = 32 * MiB;
constexpr size_t WS_PE   = 48 * MiB;
constexpr size_t WS_PC   = 58 * MiB;
constexpr size_t WS_Z    = 72 * MiB;
constexpr size_t WS_XN   = 140 * MiB;
constexpr size_t WS_P    = 176 * MiB;
constexpr size_t WS_Y    = 244 * MiB;
constexpr size_t WS_HS   = 280 * MiB;
constexpr size_t WS_SC   = 348 * MiB;
constexpr size_t WS_UQ   = 484 * MiB;
constexpr size_t WS_VQ   = 548 * MiB;
constexpr size_t WS_US   = 612 * MiB;
constexpr size_t WS_VS   = 613 * MiB;
constexpr size_t WS_SGW  = 614 * MiB;
constexpr size_t WS_CO   = 632 * MiB;
constexpr size_t WS_FQ   = 641 * MiB;
constexpr size_t WS_FS   = 658 * MiB;
constexpr size_t WS_END  = 659 * MiB;
constexpr int CW_BAR = 4096;

constexpr int RING_BYTES = 131072;
constexpr int LDS_BYTES = 163840;
constexpr int LDSCTL_OFF = LDS_BYTES - 1024, MISC_OFF = LDSCTL_OFF + 320;

#define LAS __attribute__((address_space(3)))
typedef unsigned short bf16;
typedef unsigned v4u __attribute__((ext_vector_type(4)));
typedef unsigned v2u __attribute__((ext_vector_type(2)));
typedef int v4i __attribute__((ext_vector_type(4)));
typedef float f32x4 __attribute__((ext_vector_type(4)));
#define LDS_WAIT() asm volatile("s_waitcnt lgkmcnt(0)" ::: "memory")

__device__ __forceinline__ unsigned f2bf(float f) { unsigned u = __builtin_bit_cast(unsigned, f); return (u + 0x7fffu + ((u >> 16) & 1u)) >> 16; }
__device__ __forceinline__ unsigned pk2(float lo, float hi) { return f2bf(lo) | (f2bf(hi) << 16); }
__device__ __forceinline__ float bf2f(unsigned short b) { return __builtin_bit_cast(float, ((unsigned)b) << 16); }
__device__ __forceinline__ float bflo(unsigned w) { return __builtin_bit_cast(float, w << 16); }
__device__ __forceinline__ float bfhi(unsigned w) { return __builtin_bit_cast(float, w & 0xffff0000u); }
__device__ __forceinline__ float gelu_t(float x) {
    const float u = 0.7978845608028654f * (x + 0.044715f * x * x * x);
    const float e = expf(2.f * u);
    const float t = 1.f - 2.f / (e + 1.f);
    return 0.5f * x * (1.f + t);
}
__device__ __forceinline__ float sigmoid_f(float x) { return 1.f / (1.f + expf(-x)); }
#define DPPF(x, ctrl) __builtin_bit_cast(float, __builtin_amdgcn_update_dpp(0, __builtin_bit_cast(int, (x)), (ctrl), 0xf, 0xf, true))
__device__ __forceinline__ float wave_sum(float v) {
    v += DPPF(v, 0xB1); v += DPPF(v, 0x4E); v += DPPF(v, 0x141); v += DPPF(v, 0x140);
    const int iv = __builtin_bit_cast(int, v);
    const float r0 = __builtin_bit_cast(float, __builtin_amdgcn_readlane(iv, 0)), r1 = __builtin_bit_cast(float, __builtin_amdgcn_readlane(iv, 16)),
                r2 = __builtin_bit_cast(float, __builtin_amdgcn_readlane(iv, 32)), r3 = __builtin_bit_cast(float, __builtin_amdgcn_readlane(iv, 48));
    return (r0 + r1) + (r2 + r3);
}

__device__ __forceinline__ void wave_sum2(float& a, float& b) {
    a += DPPF(a, 0xB1); b += DPPF(b, 0xB1); a += DPPF(a, 0x4E); b += DPPF(b, 0x4E); a += DPPF(a, 0x141); b += DPPF(b, 0x141); a += DPPF(a, 0x140); b += DPPF(b, 0x140);
    const int ia = __builtin_bit_cast(int, a), ib = __builtin_bit_cast(int, b);
    const float a0 = __builtin_bit_cast(float, __builtin_amdgcn_readlane(ia, 0)), a1 = __builtin_bit_cast(float, __builtin_amdgcn_readlane(ia, 16)),
                a2 = __builtin_bit_cast(float, __builtin_amdgcn_readlane(ia, 32)), a3 = __builtin_bit_cast(float, __builtin_amdgcn_readlane(ia, 48));
    const float b0 = __builtin_bit_cast(float, __builtin_amdgcn_readlane(ib, 0)), b1 = __builtin_bit_cast(float, __builtin_amdgcn_readlane(ib, 16)),
                b2 = __builtin_bit_cast(float, __builtin_amdgcn_readlane(ib, 32)), b3 = __builtin_bit_cast(float, __builtin_amdgcn_readlane(ib, 48));
    a = (a0 + a1) + (a2 + a3); b = (b0 + b1) + (b2 + b3);
}

#define XB_TMO      128
#define XB_XCNT(j)  (256  + 64 * (j))
#define XB_XSUB(j)  (1280 + 64 * (j))
#define XB_XGEN(j)  (2304 + 64 * (j))
#define XB_TOP      3328
#define XB_TOPGEN   3392
#define XCD_BAR_WORDS 3456
#define XB_SPIN_CAP (1u << 20)

__device__ __forceinline__ unsigned xb_ld(unsigned* p)              { return __hip_atomic_load(p, __ATOMIC_RELAXED, __HIP_MEMORY_SCOPE_AGENT); }
__device__ __forceinline__ unsigned xb_add(unsigned* p, unsigned v) { return __hip_atomic_fetch_add(p, v, __ATOMIC_RELAXED, __HIP_MEMORY_SCOPE_AGENT); }
__device__ __forceinline__ unsigned xb_xcc_id() { return (unsigned)__builtin_amdgcn_s_getreg((3 << 11) | 20) & 0xFu; }
#define XB_SPIN(cond, bar) do { unsigned _sp = 0; while (cond) { __builtin_amdgcn_s_sleep(1); \
    if ((++_sp & 255u) == 0u) { if (xb_ld(&(bar)[XB_TMO])) break; if (_sp > XB_SPIN_CAP) { atomicAdd(&(bar)[XB_TMO], 1u); break; } } } } while (0)

struct XcdBarrier {
    unsigned* bar; unsigned x;
    volatile LAS unsigned* st;
};

__device__ __forceinline__ XcdBarrier xcd_barrier_post(unsigned* bar, volatile LAS unsigned* st) {
    XcdBarrier b; b.bar = bar; b.x = xb_xcc_id(); b.st = st;
    if (threadIdx.x == 0) (void)xb_add(&bar[XB_XCNT(b.x)], 1u);
    return b;
}
__device__ __forceinline__ void xcd_barrier_complete(unsigned* bar, unsigned x, unsigned& nloc, unsigned& nx) {
    const unsigned G = gridDim.x * gridDim.y * gridDim.z;
    unsigned sum, cnt, mine, sp = 0u;
    for (;;) {
        sum = 0u; cnt = 0u; mine = 0u;
#pragma unroll
        for (unsigned j = 0; j < 16; ++j) { const unsigned c = xb_ld(&bar[XB_XCNT(j)]); sum += c; cnt += (c > 0u) ? 1u : 0u; mine = (j == x) ? c : mine; }
        if (sum == G) break;
        __builtin_amdgcn_s_sleep(1);
        if ((++sp & 255u) == 0u) { if (xb_ld(&bar[XB_TMO])) break; if (sp > XB_SPIN_CAP) { atomicAdd(&bar[XB_TMO], 1u); break; } }
    }
    nloc = mine > 0u ? mine : 1u; nx = cnt > 0u ? cnt : 1u;
}

__device__ __forceinline__ void xcd_barrier(const XcdBarrier& b) {
    asm volatile("s_waitcnt vmcnt(0)" ::: "memory");
    __syncthreads();
    if (threadIdx.x == 0) {
        unsigned* bar = b.bar;
        __builtin_amdgcn_s_waitcnt(0);
        unsigned nloc = b.st[0], nx = b.st[1];
        if (nloc == 0u) { xcd_barrier_complete(bar, b.x, nloc, nx); b.st[0] = nloc; b.st[1] = nx; }
        const unsigned old = xb_add(&bar[XB_XSUB(b.x)], 1u);
        const unsigned gen = old / nloc;
        if (old + 1u == (gen + 1u) * nloc) {
            __builtin_amdgcn_fence(__ATOMIC_RELEASE, "agent");
            asm volatile("s_waitcnt vmcnt(0)" ::: "memory");
            const unsigned og = xb_add(&bar[XB_TOP], 1u);
            const unsigned tg = og / nx;
            if (og + 1u == (tg + 1u) * nx) xb_add(&bar[XB_TOPGEN], 1u);
            else XB_SPIN(xb_ld(&bar[XB_TOPGEN]) == tg, bar);
            __builtin_amdgcn_fence(__ATOMIC_ACQUIRE, "agent");
            xb_add(&bar[XB_XGEN(b.x)], 1u);
            asm volatile("s_waitcnt vmcnt(0)" ::: "memory");
        } else {
            XB_SPIN(xb_ld(&bar[XB_XGEN(b.x)]) == gen, bar);
            __builtin_amdgcn_fence(__ATOMIC_ACQUIRE, "agent");
            asm volatile("s_waitcnt vmcnt(0)" ::: "memory");
        }
    }
    __syncthreads();
}


#define AS4 __attribute__((address_space(4)))
struct Ctx {
    LAS unsigned char* lds;
    int tid, lane, wave, vcu, G, bx;
    const AS4 unsigned char* kp;
    unsigned char* ws; float* out;
};
#define IN_(C, k) (*(const float* const AS4*)((C).kp + 8 * (k)))

typedef short bf16x8 __attribute__((ext_vector_type(8)));
#define MFMA16(a, b, c) __builtin_amdgcn_mfma_f32_16x16x32_bf16((a), (b), (c), 0, 0, 0)
__device__ __forceinline__ void p0_transpose_item(const float* W, int K, int N, bf16* WT, LAS float* scr, int item, int lane) {
    const int nblk = N / 32, kb = item / nblk, nb = item % nblk, k0 = 64 * kb, n0 = 32 * nb;
#pragma unroll 8
    for (int i = 0; i < 32; ++i) { const int kk = 2 * i + (lane >> 5); scr[kk * 33 + (lane & 31)] = W[(size_t)(k0 + kk) * N + n0 + (lane & 31)]; }
    LDS_WAIT(); asm volatile("" ::: "memory");
    const int c = lane & 7;
#pragma unroll
    for (int j = 0; j < 4; ++j) { const int n = (lane >> 3) + 8 * j; const LAS float* s = scr + (8 * c) * 33 + n;
        v4u o; o.x = pk2(s[0 * 33], s[1 * 33]); o.y = pk2(s[2 * 33], s[3 * 33]); o.z = pk2(s[4 * 33], s[5 * 33]); o.w = pk2(s[6 * 33], s[7 * 33]);
        *(v4u*)(WT + (size_t)(n0 + n) * K + k0 + 8 * c) = o; }
    LDS_WAIT(); asm volatile("" ::: "memory");
}

__device__ __forceinline__ void convert_tables(const Ctx& C, int l, int it0, int it1) {
    const int gw = C.vcu * 8 + C.wave, NGW = C.G * 8;
    for (int q0 = (it0 * NGW + gw) * 4; q0 < 2 * NEXP && q0 < (it1 * NGW) * 4; q0 += NGW * 4) {
        const bool isv = q0 >= NEXP; const int rr0 = l * NEXP + (isv ? q0 - NEXP : q0);
        const f32x4* src = (const f32x4*)((isv ? IN_(C, 27) : IN_(C, 26)) + (size_t)rr0 * DM) + C.lane;
        f32x4 v[4][4];
#pragma unroll
        for (int q = 0; q < 4; ++q)
#pragma unroll
            for (int j = 0; j < 4; ++j) v[q][j] = src[q * 256 + 64 * j];
        const int bias = 0;
#pragma unroll
        for (int q = 0; q < 4; ++q) {
            float am = 0.f;
#pragma unroll
            for (int j = 0; j < 4; ++j) am = fmaxf(am, fmaxf(fmaxf(fabsf(v[q][j].x), fabsf(v[q][j].y)), fmaxf(fabsf(v[q][j].z), fabsf(v[q][j].w))));
            am = fmaxf(am, DPPF(am, 0xB1)); am = fmaxf(am, DPPF(am, 0x4E)); am = fmaxf(am, DPPF(am, 0x141)); am = fmaxf(am, DPPF(am, 0x140));
            { const int iv = __builtin_bit_cast(int, am);
              am = fmaxf(fmaxf(__builtin_bit_cast(float, __builtin_amdgcn_readlane(iv, 0)), __builtin_bit_cast(float, __builtin_amdgcn_readlane(iv, 16))),
                         fmaxf(__builtin_bit_cast(float, __builtin_amdgcn_readlane(iv, 32)), __builtin_bit_cast(float, __builtin_amdgcn_readlane(iv, 48)))); }
            const float inv = am > 0.f ? 127.0f / am : 0.f;
            unsigned* dst = (unsigned*)(C.ws + (isv ? WS_VQ : WS_UQ) + (size_t)(rr0 + q) * DM) + C.lane;
#pragma unroll
            for (int j = 0; j < 4; ++j) {
                const int q0 = (int)rintf(v[q][j].x * inv) + bias, q1 = (int)rintf(v[q][j].y * inv) + bias, q2 = (int)rintf(v[q][j].z * inv) + bias, q3 = (int)rintf(v[q][j].w * inv) + bias;
                dst[64 * j] = (unsigned)(q0 & 255) | ((unsigned)(q1 & 255) << 8) | ((unsigned)(q2 & 255) << 16) | ((unsigned)(q3 & 255) << 24);
            }
            if (C.lane == 0) ((float*)(C.ws + (isv ? WS_VS : WS_US)))[rr0 + q] = am * (1.0f / 127.0f);
        }
    }
}

__device__ __forceinline__ void phase_p0a(const Ctx& C, int mask) {
    const int gw = C.vcu * 8 + C.wave, NGW = C.G * 8;
    const int gt = C.vcu * 512 + C.tid, NGT = C.G * 512;
    LAS float* scr = (LAS float*)(C.lds + C.wave * 16384);
    if (mask & 1) for (int it = gw; it < 4 * 1024 + 4 * 512; it += NGW) {
        if (it < 4096) { const int l = it >> 10, r = it & 1023; p0_transpose_item(IN_(C, 8) + (size_t)l * 1024 * 2048, 1024, 2048, ((bf16*)(C.ws + WS_WIN)) + (size_t)l * 2048 * 1024, scr, r, C.lane); }
        else { const int q = it - 4096, l = q >> 9, r = q & 511; p0_transpose_item(IN_(C, 9) + (size_t)l * 1024 * 1024, 1024, 1024, ((bf16*)(C.ws + WS_WOUT)) + (size_t)l * 1024 * 1024, scr, r, C.lane); }
    }
    for (int i = gt; i < 4 * 4 * 128 * 128; i += NGT) ((bf16*)(C.ws + WS_SGW))[i] = (bf16)f2bf(IN_(C, 21)[i]);
    for (int i = gt; i < 64 * 512; i += NGT) {
        const int p = i >> 9, j = i & 511, q = j & 255;
        const float omega = powf(10000.0f, -(float)q / 256.0f);
        const float ang = (float)p * omega;
        ((float*)(C.ws + WS_POS))[i] = (j < 256) ? sinf(ang) : cosf(ang);
    }
    if (mask & 2) convert_tables(C, 0, 0, 64);
    if (mask & 4) for (int it = gw; it < 4 * 32 * 24; it += NGW) {
        const int cb = it % 24, ks = (it / 24) & 31, l = it / 768;
        const int col = cb * 256 + 4 * C.lane;
        const float* w = IN_(C, 4) + ((size_t)l * 1024 + ks * 32) * 6144 + col;
        f32x4 wv[32];
#pragma unroll
        for (int k = 0; k < 32; ++k) wv[k] = *(const f32x4*)(w + (size_t)k * 6144);
        int sl[5];
        { const int kk = ks * 32 + (C.lane & 31);
#pragma unroll
          for (int r = 0; r < 5; ++r) { const float v = (r < 4) ? IN_(C, 1)[r * 1024 + kk] : IN_(C, 3)[kk]; sl[r] = __builtin_bit_cast(int, v / (1.f + expf(-v))); } }
        f32x4 a[5];
#pragma unroll
        for (int r = 0; r < 5; ++r) a[r] = (f32x4){0.f, 0.f, 0.f, 0.f};
#pragma unroll
        for (int k = 0; k < 32; ++k)
#pragma unroll
            for (int r = 0; r < 5; ++r) a[r] = a[r] + wv[k] * __builtin_bit_cast(float, __builtin_amdgcn_readlane(sl[r], k));
        float* o = ((float*)(C.ws + WS_MODP)) + (((size_t)ks * 4 + l) * 5) * 6144 + col;
#pragma unroll
        for (int r = 0; r < 5; ++r) *(f32x4*)(o + (size_t)r * 6144) = a[r];
    }
    {
        const int fr = C.lane & 15, fq = C.lane >> 4;
        if (mask & 8) for (int it = gw; it < 8192; it += NGW) {
            const int nt = it & 7, kt = (it >> 3) & 15, side = (it >> 7) & 1, h = (it >> 8) & 7, l = it >> 11;
            const float* key = (side ? IN_(C, 25) : IN_(C, 24)) + (size_t)l * 16384 + (size_t)(nt * 16 + fr) * 128 + 8 * fq;
            const float* wq = IN_(C, 23) + (size_t)l * 1024 * 2048 + (size_t)(kt * 64 + fr) * 2048 + h * 256 + side * 128 + 8 * fq;
            f32x4 kx[4][2], wx[4][4][2];
#pragma unroll
            for (int ks = 0; ks < 4; ++ks) { kx[ks][0] = *(const f32x4*)(key + 32 * ks); kx[ks][1] = *(const f32x4*)(key + 32 * ks + 4); }
#pragma unroll
            for (int ct = 0; ct < 4; ++ct)
#pragma unroll
                for (int ks = 0; ks < 4; ++ks) { const float* wp = wq + (size_t)(16 * ct) * 2048 + 32 * ks; wx[ct][ks][0] = *(const f32x4*)wp; wx[ct][ks][1] = *(const f32x4*)(wp + 4); }
            bf16x8 Bh[4], Bl[4];
#pragma unroll
            for (int ks = 0; ks < 4; ++ks) { const f32x4 x0 = kx[ks][0], x1 = kx[ks][1];
                const float xv[8] = {x0.x, x0.y, x0.z, x0.w, x1.x, x1.y, x1.z, x1.w};
#pragma unroll
                for (int e = 0; e < 8; ++e) { const unsigned hb = f2bf(xv[e]); Bh[ks][e] = (short)hb; Bl[ks][e] = (short)f2bf(xv[e] - __builtin_bit_cast(float, hb << 16)); } }
            bf16* o = (bf16*)(C.ws + WS_WCMB) + ((size_t)l * 2048 + h * 256 + side * 128 + nt * 16 + fr) * 1024 + kt * 64 + 4 * fq;
#pragma unroll
            for (int ct = 0; ct < 4; ++ct) {
                f32x4 acc = {0.f, 0.f, 0.f, 0.f};
#pragma unroll
                for (int ks = 0; ks < 4; ++ks) { const f32x4 x0 = wx[ct][ks][0], x1 = wx[ct][ks][1];
                    const float xv[8] = {x0.x, x0.y, x0.z, x0.w, x1.x, x1.y, x1.z, x1.w};
                    bf16x8 Ah, Al;
#pragma unroll
                    for (int e = 0; e < 8; ++e) { const unsigned hb = f2bf(xv[e]); Ah[e] = (short)hb; Al[e] = (short)f2bf(xv[e] - __builtin_bit_cast(float, hb << 16)); }
                    acc = MFMA16(Ah, Bh[ks], acc); acc = MFMA16(Ah, Bl[ks], acc); acc = MFMA16(Al, Bh[ks], acc); }
                v2u w; w.x = pk2(acc[0], acc[1]); w.y = pk2(acc[2], acc[3]);
                *(v2u*)(o + 16 * ct) = w;
            }
        }
    }
}

__device__ __forceinline__ void phase_p0b(const Ctx& C) {
    const int gt = C.vcu * 512 + C.tid, NGT = C.G * 512;
    for (int i = gt; i < 4 * 5 * 6144; i += NGT) {
        const int l = i / 30720, rem = i % 30720, r = rem / 6144, col = rem % 6144;
        float v = IN_(C, 5)[l * 6144 + col];
#pragma unroll 8
        for (int ks = 0; ks < 32; ++ks) v += ((float*)(C.ws + WS_MODP))[(((size_t)ks * 4 + l) * 5 + r) * 6144 + col];
        ((float*)(C.ws + WS_MOD))[i] = v;
    }
}

template <int MODE>
__device__ __forceinline__ void phase_rows(const Ctx& C, int l, int row_lo) {
    const int gw = C.vcu * 8 + C.wave, NGW = C.G * 8;
    const bool first = (MODE == 0 && l == 0);
    const int n = NTOK - row_lo, per = n / NGW, rem = n - per * NGW;
    int row = row_lo + gw * per + (gw < rem ? gw : rem);
    const int rend = row + per + (gw < rem ? 1 : 0);
#define ROW_LOAD(dst, r) do { if ((r) < rend) { if (first) { const f32x4* sp_ = (const f32x4*)((r) < NCTX ? IN_(C, 2) + (size_t)(r) * DM : IN_(C, 0) + (size_t)((r) - NCTX) * DM) + C.lane; \
            _Pragma("unroll") for (int j = 0; j < 4; ++j) dst[j] = sp_[64 * j]; } \
        else { const v2u* sp_ = (const v2u*)(((const bf16*)(C.ws + WS_Z)) + (size_t)(r) * DM) + C.lane; \
            _Pragma("unroll") for (int j = 0; j < 4; ++j) { const v2u w_ = sp_[64 * j]; dst[j] = (f32x4){bflo(w_.x), bfhi(w_.x), bflo(w_.y), bfhi(w_.y)}; } } } } while (0)
    f32x4 v[4], v1[4], v2[4];
    ROW_LOAD(v, row); ROW_LOAD(v1, row + 1);
    f32x4 gq[4], shq[4], scq[4]; int mr_cur = -1;
    if (MODE != 2) { const f32x4* gp = (const f32x4*)((MODE == 0 ? IN_(C, 6) : IN_(C, 7)) + (size_t)l * DM) + C.lane;
#pragma unroll
        for (int j = 0; j < 4; ++j) gq[j] = gp[64 * j]; }
    else { const f32x4* gp = (const f32x4*)IN_(C, 28) + C.lane;
#pragma unroll
        for (int j = 0; j < 4; ++j) gq[j] = gp[64 * j]; }
    while (row < rend) {
        ROW_LOAD(v2, row + 2);
        float ss = 0.f;
#pragma unroll
        for (int j = 0; j < 4; ++j) ss += (v[j].x * v[j].x + v[j].y * v[j].y) + (v[j].z * v[j].z + v[j].w * v[j].w);
        if (first) { v2u* zp = (v2u*)(((bf16*)(C.ws + WS_Z)) + (size_t)row * DM) + C.lane;
#pragma unroll
            for (int j = 0; j < 4; ++j) { v2u w; w.x = pk2(v[j].x, v[j].y); w.y = pk2(v[j].z, v[j].w); zp[64 * j] = w;
                v[j] = (f32x4){bflo(w.x), bfhi(w.x), bflo(w.y), bfhi(w.y)}; } }
        int mr, t; if (row < NCTX) { mr = 4; t = row & 255; } else { mr = (row - NCTX) >> 12; t = (row - NCTX) & 4095; }
        if (MODE != 2 && mr != mr_cur) { mr_cur = mr;
            const float* mb = ((float*)(C.ws + WS_MOD)) + ((size_t)(l * 5 + mr) * 6 + (MODE == 0 ? 0 : 3)) * DM;
            const f32x4* shp = (const f32x4*)mb + C.lane; const f32x4* scp = (const f32x4*)(mb + DM) + C.lane;
#pragma unroll
            for (int j = 0; j < 4; ++j) { shq[j] = shp[64 * j]; scq[j] = scp[64 * j] + 1.0f; } }
        const float rs = __builtin_amdgcn_rsqf(wave_sum(ss) * (1.0f / DM) + EPS);
        if (MODE == 2) {
            f32x4* op = (f32x4*)(C.out + (size_t)(row - NCTX) * DM) + C.lane;
#pragma unroll
            for (int j = 0; j < 4; ++j) op[64 * j] = v[j] * rs * gq[j];
        } else {
            v2u* op = (v2u*)(((bf16*)(C.ws + WS_XN)) + (size_t)row * DM) + C.lane;
            f32x4 ov[4]; float am = 0.f;
#pragma unroll
            for (int j = 0; j < 4; ++j) {
                f32x4 o = (v[j] * rs * gq[j]) * scq[j] + shq[j];
                if (MODE == 0 && row >= NCTX) {
                    const int p = (j < 2) ? (t >> 6) : (t & 63);
                    o = o + *((const f32x4*)(((float*)(C.ws + WS_POS)) + (size_t)p * 512 + (j & 1) * 256) + C.lane);
                }
                v2u w; w.x = pk2(o.x, o.y); w.y = pk2(o.z, o.w); op[64 * j] = w;
                if (MODE == 1) { ov[j] = (f32x4){bflo(w.x), bfhi(w.x), bflo(w.y), bfhi(w.y)};
                    am = fmaxf(am, fmaxf(fmaxf(fabsf(ov[j].x), fabsf(ov[j].y)), fmaxf(fabsf(ov[j].z), fabsf(ov[j].w)))); }
            }
            if (MODE == 1) {
                am = fmaxf(am, DPPF(am, 0xB1)); am = fmaxf(am, DPPF(am, 0x4E)); am = fmaxf(am, DPPF(am, 0x141)); am = fmaxf(am, DPPF(am, 0x140));
                { const int iv = __builtin_bit_cast(int, am);
                  am = fmaxf(fmaxf(__builtin_bit_cast(float, __builtin_amdgcn_readlane(iv, 0)), __builtin_bit_cast(float, __builtin_amdgcn_readlane(iv, 16))),
                             fmaxf(__builtin_bit_cast(float, __builtin_amdgcn_readlane(iv, 32)), __builtin_bit_cast(float, __builtin_amdgcn_readlane(iv, 48)))); }
                const float inv = am > 0.f ? 127.0f / am : 0.f;
                unsigned* qp = (unsigned*)(C.ws + WS_FQ + (size_t)row * DM) + C.lane;
#pragma unroll
                for (int j = 0; j < 4; ++j) { const int q0 = (int)rintf(ov[j].x * inv), q1 = (int)rintf(ov[j].y * inv), q2 = (int)rintf(ov[j].z * inv), q3 = (int)rintf(ov[j].w * inv);
                    qp[64 * j] = (unsigned)(q0 & 255) | ((unsigned)(q1 & 255) << 8) | ((unsigned)(q2 & 255) << 16) | ((unsigned)(q3 & 255) << 24); }
                if (C.lane == 0) ((float*)(C.ws + WS_FS))[row] = am * (1.0f / 127.0f);
            }
        }
#pragma unroll
        for (int j = 0; j < 4; ++j) { v[j] = v1[j]; v1[j] = v2[j]; }
        ++row;
    }
#undef ROW_LOAD
}

constexpr int XS = 264;
constexpr int VTS = 136;
__device__ __forceinline__ float fexp(float x) { return __builtin_amdgcn_exp2f(x * 1.4426950408889634f); }
__device__ __forceinline__ float fsigmoid(float x) { return __builtin_amdgcn_rcpf(1.0f + fexp(-x)); }
__device__ __forceinline__ float fgelu(float x) {
    const float x2 = x * x;
    const float e = __builtin_amdgcn_exp2f(x * (x2 * (-0.044715f * 2.302208198f) - 2.302208198f));
    return x * __builtin_amdgcn_rcpf(1.0f + e);
}
__device__ __forceinline__ float one_minus_exp(float x) {
    const float p = -x * (1.0f + x * (0.5f + x * (0.16666667f + x * (0.041666668f + x * (0.0083333338f + x * 0.0013888889f)))));
    const float q = 1.0f - fexp(x);
    return (x > -0.25f) ? p : q;
}
__device__ __forceinline__ void seq_of_row(int row0, int& seq0, int& len) { if (row0 < NCTX) { seq0 = row0 & ~255; len = 256; } else { seq0 = NCTX + ((row0 - NCTX) & ~4095); len = 4096; } }
__device__ __forceinline__ void load_bfrags(const float* W, int lane, bf16x8 (&B)[4][2]) {
    const float* w0 = W + (8 * (lane >> 4)) * 64 + (lane & 15);
#pragma unroll
    for (int ct = 0; ct < 4; ++ct)
#pragma unroll
        for (int ks = 0; ks < 2; ++ks) {
            bf16x8 b;
#pragma unroll
            for (int e = 0; e < 8; ++e) b[e] = (short)f2bf(w0[(32 * ks + e) * 64 + 16 * ct]);
            B[ct][ks] = b;
        }
}

__device__ __forceinline__ void mixer_a(const Ctx& C, int l, int chunk) {
    const int row0 = chunk * 128; int seq0, len; seq_of_row(row0, seq0, len); const int t0 = row0 - seq0;
    LAS bf16* xa = (LAS bf16*)C.lds;
    LAS float* tile = (LAS float*)(C.lds + 128 * XS * 2 + C.wave * 8192);
    const bf16* P = (const bf16*)(C.ws + WS_P);
    {
        const float* cw = IN_(C, 10) + (size_t)l * 4 * 256; const float* cbias = IN_(C, 11) + (size_t)l * 256;
        const int c4 = (C.tid & 63) * 4, i0 = (C.tid >> 6) * 16;
        v2u pv[19];
#pragma unroll
        for (int q = 0; q < 19; ++q) { const int t = t0 + i0 - 2 + q; pv[q] = (v2u){0u, 0u}; if (t >= 0 && t < len) pv[q] = *(const v2u*)(P + (size_t)(seq0 + t) * PROJ + c4); }
        f32x4 w[4];
#pragma unroll
        for (int k = 0; k < 4; ++k) w[k] = *(const f32x4*)(cw + k * 256 + c4);
        const f32x4 bias = *(const f32x4*)(cbias + c4);
#pragma unroll
        for (int i = 0; i < 16; ++i) {
            f32x4 acc = bias;
#pragma unroll
            for (int k = 0; k < 4; ++k) { const v2u x = pv[i + k]; acc.x += w[k].x * bflo(x.x); acc.y += w[k].y * bfhi(x.x); acc.z += w[k].z * bflo(x.y); acc.w += w[k].w * bfhi(x.y); }
            v2u o; o.x = pk2(acc.x, acc.y); o.y = pk2(acc.z, acc.w);
            *(LAS v2u*)(xa + (i0 + i) * XS + c4) = o;
        }
    }
    __syncthreads();
    const int d = C.wave >> 2, h = C.wave & 3, fr = C.lane & 15, fq = C.lane >> 4;
    bf16x8 Br[4][2], Bi[4][2];
    load_bfrags(IN_(C, 13) + ((size_t)(l * 2 + d) * 4 + h) * 4096, C.lane, Br);
    load_bfrags(IN_(C, 15) + ((size_t)(l * 2 + d) * 4 + h) * 4096, C.lane, Bi);
    float brv[4], biv[4], spv[4];
#pragma unroll
    for (int ct = 0; ct < 4; ++ct) { const int j = 16 * ct + fr;
        brv[ct] = IN_(C, 14)[((l * 2 + d) * 4 + h) * 64 + j]; biv[ct] = IN_(C, 16)[((l * 2 + d) * 4 + h) * 64 + j];
        const float lam = IN_(C, 12)[(l * 2 + d) * 256 + h * 64 + j]; spv[ct] = fmaxf(-lam, 0.f) + log1pf(expf(-fabsf(lam))); }
    float hst = 0.f, acum = 1.f;
    bf16* HX = (bf16*)(C.ws + WS_HS) + (size_t)d * NTOK * 256 + h * 64 + C.lane; bf16* AX = (bf16*)(C.ws + WS_HS) + (size_t)(2 + d) * NTOK * 256 + h * 64 + C.lane;
    for (int it = 0; it < 8; ++it) {
        const int rt = d ? 7 - it : it;
        const LAS bf16* ap = xa + (16 * rt + fr) * XS + h * 64 + 8 * fq;
        const bf16x8 a0 = *(const LAS bf16x8*)ap, a1 = *(const LAS bf16x8*)(ap + 32);
        f32x4 ar[4], ai[4];
#pragma unroll
        for (int ct = 0; ct < 4; ++ct) {
            ar[ct] = MFMA16(a0, Br[ct][0], ((f32x4){0.f, 0.f, 0.f, 0.f})); ar[ct] = MFMA16(a1, Br[ct][1], ar[ct]);
            ai[ct] = MFMA16(a0, Bi[ct][0], ((f32x4){0.f, 0.f, 0.f, 0.f})); ai[ct] = MFMA16(a1, Bi[ct][1], ai[ct]);
        }
#pragma unroll
        for (int ct = 0; ct < 4; ++ct)
#pragma unroll
            for (int r = 0; r < 4; ++r) {
                const int tl = 4 * fq + r, j = 16 * ct + fr;
                const float xav = bf2f(xa[(16 * rt + tl) * XS + h * 64 + j]);
                const float rg = fsigmoid(ar[ct][r] + brv[ct]), ig = fsigmoid(ai[ct][r] + biv[ct]);
                const float la = -8.0f * rg * spv[ct];
                tile[tl * 64 + j] = fexp(la);
                tile[1024 + tl * 64 + j] = __builtin_amdgcn_sqrtf(one_minus_exp(2.0f * la)) * (ig * xav);
            }
        asm volatile("s_waitcnt lgkmcnt(0)" ::: "memory");
#pragma unroll 4
        for (int s = 0; s < 16; ++s) {
            const int tl = d ? 15 - s : s;
            const float a = tile[tl * 64 + C.lane], b = tile[1024 + tl * 64 + C.lane];
            hst = a * hst + b; acum *= a;
            const size_t ro = (size_t)(row0 + 16 * rt + tl) * 256;
            HX[ro] = (bf16)f2bf(hst); AX[ro] = (bf16)f2bf(acum);
        }
        asm volatile("s_waitcnt lgkmcnt(0)" ::: "memory");
    }
    { float* ag = (float*)(C.ws + WS_AGG) + ((size_t)(chunk * 2 + d) * 2) * 256 + h * 64 + C.lane; ag[0] = acum; ag[256] = hst; }
    __syncthreads();
}

__device__ __forceinline__ void mixer_b(const Ctx& C, int l, int chunk) {
    const int row0 = chunk * 128; int seq0, len; seq_of_row(row0, seq0, len); const int t0 = row0 - seq0;
    LAS bf16* dm = (LAS bf16*)C.lds;
    LAS bf16* xs = (LAS bf16*)(C.lds + 128 * XS * 2);
    const bf16* P = (const bf16*)(C.ws + WS_P); bf16* Y = (bf16*)(C.ws + WS_Y);
    const int half = C.wave >> 2, g = C.wave & 3, fr = C.lane & 15, fq = C.lane >> 4;
    bf16x8 Bw[4][2];
    load_bfrags(IN_(C, 17) + ((size_t)(l * 4 + g)) * 4096, C.lane, Bw);
    float scv[4];
#pragma unroll
    for (int ct = 0; ct < 4; ++ct) scv[ct] = IN_(C, 18)[l * 256 + g * 64 + 16 * ct + fr];
    {
        v4u tmp[9];
#pragma unroll
        for (int q = 0; q < 9; ++q) { const int idx = C.tid + 512 * q, i = idx >> 5, c8 = (idx & 31) * 8, t = t0 - 8 + i;
            tmp[q] = (v4u){0u, 0u, 0u, 0u}; if (t >= 0 && t < len) tmp[q] = *(const v4u*)(P + (size_t)(seq0 + t) * PROJ + 512 + c8); }
#pragma unroll
        for (int q = 0; q < 9; ++q) { const int idx = C.tid + 512 * q, i = idx >> 5, c8 = (idx & 31) * 8; *(LAS v4u*)(xs + i * 256 + c8) = tmp[q]; }
    }
    __syncthreads();
    {
        const int wh = C.wave >> 2, ri = C.lane >> 4, c4 = g * 64 + (C.lane & 15) * 4, hw = 1 << g;
        const int i0 = wh * 64 + ri * 16;
        f32x4 s = {0.f, 0.f, 0.f, 0.f};
        for (int o = -hw; o < hw; ++o) { const v2u pv = *(const LAS v2u*)(xs + (i0 + 8 + o) * 256 + c4); s.x += bflo(pv.x); s.y += bfhi(pv.x); s.z += bflo(pv.y); s.w += bfhi(pv.y); }
#pragma unroll 4
        for (int it = 0; it < 16; ++it) {
            const int i = i0 + it, t = t0 + i;
            int lo = t - hw, hi = t + hw; lo = lo < 0 ? 0 : lo; hi = hi > len ? len : hi;
            const float inv = 1.0f / (float)(hi - lo);
            const v2u xv = *(const LAS v2u*)(xs + (i + 8) * 256 + c4);
            v2u o2; o2.x = pk2(s.x * inv - bflo(xv.x), s.y * inv - bfhi(xv.x)); o2.y = pk2(s.z * inv - bflo(xv.y), s.w * inv - bfhi(xv.y));
            *(LAS v2u*)(dm + i * XS + c4) = o2;
            const v2u pa = *(const LAS v2u*)(xs + (i + 8 + hw) * 256 + c4), pd = *(const LAS v2u*)(xs + (i + 8 - hw) * 256 + c4);
            s.x += bflo(pa.x) - bflo(pd.x); s.y += bfhi(pa.x) - bfhi(pd.x); s.z += bflo(pa.y) - bflo(pd.y); s.w += bfhi(pa.y) - bfhi(pd.y);
        }
    }
    __syncthreads();
#pragma unroll
    for (int q = 0; q < 4; ++q) {
        const int rt = half * 4 + q;
        const LAS bf16* ap = dm + (16 * rt + fr) * XS + g * 64 + 8 * fq;
        const bf16x8 a0 = *(const LAS bf16x8*)ap, a1 = *(const LAS bf16x8*)(ap + 32);
#pragma unroll
        for (int ct = 0; ct < 4; ++ct) {
            f32x4 acc = MFMA16(a0, Bw[ct][0], ((f32x4){0.f, 0.f, 0.f, 0.f})); acc = MFMA16(a1, Bw[ct][1], acc);
#pragma unroll
            for (int r = 0; r < 4; ++r) Y[(size_t)(row0 + 16 * rt + 4 * fq + r) * DM + 256 + g * 64 + 16 * ct + fr] = (bf16)f2bf(acc[r] * scv[ct]);
        }
    }
    __syncthreads();
}

__device__ __forceinline__ void mixer_c(const Ctx& C, int l, int chunk) {
    const int row0 = chunk * 128; int seq0, len; seq_of_row(row0, seq0, len); const int t0 = row0 - seq0;
    const float* cw = IN_(C, 19) + (size_t)l * 3 * 256;
    const bf16* P = (const bf16*)(C.ws + WS_P); bf16* Y = (bf16*)(C.ws + WS_Y);
    const int c4 = (C.tid & 63) * 4;
    f32x4 w[3];
#pragma unroll
    for (int k = 0; k < 3; ++k) w[k] = *(const f32x4*)(cw + k * 256 + c4);
#pragma unroll 1
    for (int hf = 0; hf < 2; ++hf) {
        const int i0 = (C.tid >> 6) * 16 + hf * 8;
        v2u pa[10], pb[10], pc[8];
#pragma unroll
        for (int q = 0; q < 10; ++q) { const int t = t0 + i0 - 1 + q; pa[q] = (v2u){0u, 0u}; pb[q] = (v2u){0u, 0u};
            if (t >= 0 && t < len) { const bf16* p = P + (size_t)(seq0 + t) * PROJ; pa[q] = *(const v2u*)(p + 1024 + c4); pb[q] = *(const v2u*)(p + 1280 + c4); } }
#pragma unroll
        for (int i = 0; i < 8; ++i) pc[i] = *(const v2u*)(P + (size_t)(row0 + i0 + i) * PROJ + 768 + c4);
        f32x4 pr[10];
#pragma unroll
        for (int q = 0; q < 10; ++q) { pr[q].x = bflo(pa[q].x) * bflo(pb[q].x); pr[q].y = bfhi(pa[q].x) * bfhi(pb[q].x); pr[q].z = bflo(pa[q].y) * bflo(pb[q].y); pr[q].w = bfhi(pa[q].y) * bfhi(pb[q].y); }
#pragma unroll
        for (int i = 0; i < 8; ++i) {
            const f32x4 acc = w[0] * pr[i] + w[1] * pr[i + 1] + w[2] * pr[i + 2];
            v2u o; o.x = pk2(bflo(pc[i].x) * acc.x, bfhi(pc[i].x) * acc.y); o.y = pk2(bflo(pc[i].y) * acc.z, bfhi(pc[i].y) * acc.w);
            *(v2u*)(Y + (size_t)(row0 + i0 + i) * DM + 512 + c4) = o;
        }
    }
}

__device__ __forceinline__ void mixer_d(const Ctx& C, int l, int chunk) {
    const int row0 = chunk * 128;
    LAS bf16* vt = (LAS bf16*)C.lds;
    const bf16* P = (const bf16*)(C.ws + WS_P); bf16* Y = (bf16*)(C.ws + WS_Y);
    const int qh = C.wave >> 2, h = C.wave & 3, fr = C.lane & 15, fq = C.lane >> 4;
    const bf16* WSb = (const bf16*)(C.ws + WS_SGW) + ((size_t)(l * 4 + h) * 128) * 128;
    bf16x8 Bqa[4][4];
#pragma unroll
    for (int qq = 0; qq < 4; ++qq)
#pragma unroll
        for (int ks = 0; ks < 4; ++ks) Bqa[qq][ks] = *(const bf16x8*)(WSb + (size_t)(16 * (qh * 4 + qq) + fr) * 128 + 32 * ks + 8 * fq);
    {
        v2u pvv[16];
#pragma unroll
        for (int q = 0; q < 16; ++q) pvv[q] = *(const v2u*)(P + (size_t)(row0 + C.wave + 8 * q) * PROJ + 1792 + 4 * C.lane);
        const f32x4 gg = *(const f32x4*)(IN_(C, 20) + (size_t)l * 256 + 4 * C.lane);
#pragma unroll 4
        for (int q = 0; q < 16; ++q) {
            const int i = C.wave + 8 * q; const v2u pv = pvv[q];
            f32x4 g; g.x = fgelu(bflo(pv.x)); g.y = fgelu(bfhi(pv.x)); g.z = fgelu(bflo(pv.y)); g.w = fgelu(bfhi(pv.y));
            float s1 = (g.x + g.y) + (g.z + g.w), s2 = (g.x * g.x + g.y * g.y) + (g.z * g.z + g.w * g.w);
            wave_sum2(s1, s2);
            const float mean = s1 * (1.0f / 256.0f);
            const float var = fmaxf(s2 * (1.0f / 256.0f) - mean * mean, 0.f);
            const float rs = __builtin_amdgcn_rsqf(var + EPS);
            g = g - mean;
            g = g * rs * gg;
            LAS bf16* o = vt + (4 * C.lane) * VTS + i;
            o[0] = (bf16)f2bf(g.x); o[VTS] = (bf16)f2bf(g.y); o[2 * VTS] = (bf16)f2bf(g.z); o[3 * VTS] = (bf16)f2bf(g.w);
        }
    }
    __syncthreads();
    bf16x8 Av[4][4];
#pragma unroll
    for (int ct = 0; ct < 4; ++ct)
#pragma unroll
        for (int ks = 0; ks < 4; ++ks) Av[ct][ks] = *(const LAS bf16x8*)(vt + (h * 64 + 16 * ct + fr) * VTS + 32 * ks + 8 * fq);
    const float* BS = IN_(C, 22) + (size_t)(l * 4 + h) * 128;
#pragma unroll
    for (int qq = 0; qq < 4; ++qq) {
        const int qt = qh * 4 + qq, q = 16 * qt + fr;
        const float bias = BS[q];
        const size_t row = (size_t)(row0 + q);
#pragma unroll
        for (int ct = 0; ct < 4; ++ct) {
            f32x4 acc = {0.f, 0.f, 0.f, 0.f};
#pragma unroll
            for (int ks = 0; ks < 4; ++ks) acc = MFMA16(Av[ct][ks], Bqa[qq][ks], acc);
            const int c0 = h * 64 + 16 * ct + 4 * fq;
            const v2u pu = *(const v2u*)(P + row * PROJ + 1536 + c0);
            v2u o; o.x = pk2(fgelu(bflo(pu.x)) * (acc[0] + bias), fgelu(bfhi(pu.x)) * (acc[1] + bias)); o.y = pk2(fgelu(bflo(pu.y)) * (acc[2] + bias), fgelu(bfhi(pu.y)) * (acc[3] + bias));
            *(v2u*)(Y + row * DM + 768 + c0) = o;
        }
    }
    __syncthreads();
}

__device__ __forceinline__ void phase_mixers(const Ctx& C, int l, int sel) {
    if (C.G >= 2 * NCHUNK - 16) {
        if (C.bx < NCHUNK) { if (sel != 2) { mixer_a(C, l, C.bx); mixer_c(C, l, C.bx); } }
        else if (sel != 1) { const int nb = C.G - NCHUNK;
            for (int u = C.bx - NCHUNK; u < 2 * NCHUNK; u += nb) {
                if (u < NCHUNK) mixer_d(C, l, u); else mixer_b(C, l, u - NCHUNK); } }
    } else {
        for (int u = C.bx; u < 4 * NCHUNK; u += C.G) {
            if (u < NCHUNK) mixer_a(C, l, u); else if (u < 2 * NCHUNK) mixer_d(C, l, u - NCHUNK); else if (u < 3 * NCHUNK) mixer_b(C, l, u - 2 * NCHUNK); else mixer_c(C, l, u - 3 * NCHUNK); }
    }
}

__device__ __forceinline__ void phase_fixup(const Ctx& C, int l) {
    LAS float* cr = (LAS float*)C.lds;
    const bf16* P = (const bf16*)(C.ws + WS_P); bf16* Y = (bf16*)(C.ws + WS_Y);
    for (int u = C.bx; u < 2 * NCHUNK; u += C.G) {
        const int chunk = u >> 1, hf = u & 1;
        const bf16* H0 = (const bf16*)(C.ws + WS_HS); const bf16* H1 = H0 + (size_t)NTOK * 256; const bf16* A0 = H0 + (size_t)2 * NTOK * 256; const bf16* A1 = H0 + (size_t)3 * NTOK * 256;
        v2u hv[8][5];
#pragma unroll
        for (int q = 0; q < 8; ++q) { const int idx = C.tid + 512 * q, i = idx >> 6, c4 = (idx & 63) * 4; const size_t row = (size_t)chunk * 128 + hf * 64 + i;
            hv[q][0] = *(const v2u*)(H0 + row * 256 + c4); hv[q][1] = *(const v2u*)(H1 + row * 256 + c4); hv[q][2] = *(const v2u*)(A0 + row * 256 + c4); hv[q][3] = *(const v2u*)(A1 + row * 256 + c4);
            hv[q][4] = *(const v2u*)(P + row * PROJ + 256 + c4); }
        {
            const int c = C.tid & 255, d = C.wave >> 2;
            const bool isctx = chunk < 8; const int b = isctx ? (chunk >> 1) : ((chunk - 8) >> 5), k = isctx ? (chunk & 1) : ((chunk - 8) & 31);
            const int n = isctx ? (d ? 1 - k : k) : (d ? 2 + 31 - k : 2 + k);
            const float* AG = (const float*)(C.ws + WS_AGG);
            float av[33], bv[33];
#pragma unroll
            for (int q = 0; q < 33; ++q) {
                const int cid = (q < 2) ? (b * 2 + (d ? 1 - q : q)) : (8 + b * 32 + (d ? 31 - (q - 2) : (q - 2)));
                const float* ag = AG + ((size_t)(cid * 2 + d) * 2) * 256 + c;
                av[q] = (q < n) ? ag[0] : 1.0f; bv[q] = (q < n) ? ag[256] : 0.0f;
            }
            float carry = 0.f;
#pragma unroll
            for (int q = 0; q < 33; ++q) carry = av[q] * carry + bv[q];
            cr[d * 256 + c] = carry;
        }
        __syncthreads();
#pragma unroll
        for (int q = 0; q < 8; ++q) {
            const int idx = C.tid + 512 * q, i = idx >> 6, c4 = (idx & 63) * 4; const size_t row = (size_t)chunk * 128 + hf * 64 + i;
            const v2u h0 = hv[q][0], h1 = hv[q][1], a0 = hv[q][2], a1 = hv[q][3], ag = hv[q][4];
            const f32x4 cf = *(const LAS f32x4*)(cr + c4), cb = *(const LAS f32x4*)(cr + 256 + c4);
            const float y0 = (bflo(h0.x) + bflo(a0.x) * cf.x + bflo(h1.x) + bflo(a1.x) * cb.x) * fgelu(bflo(ag.x));
            const float y1 = (bfhi(h0.x) + bfhi(a0.x) * cf.y + bfhi(h1.x) + bfhi(a1.x) * cb.y) * fgelu(bfhi(ag.x));
            const float y2 = (bflo(h0.y) + bflo(a0.y) * cf.z + bflo(h1.y) + bflo(a1.y) * cb.z) * fgelu(bflo(ag.y));
            const float y3 = (bfhi(h0.y) + bfhi(a0.y) * cf.w + bfhi(h1.y) + bfhi(a1.y) * cb.w) * fgelu(bfhi(ag.y));
            v2u o; o.x = pk2(y0, y1); o.y = pk2(y2, y3);
            *(v2u*)(Y + row * DM + c4) = o;
        }
        __syncthreads();
    }
}

__device__ __forceinline__ unsigned okey(float x) { const int u = __builtin_bit_cast(int, x); return (unsigned)(u ^ ((u >> 31) | (int)0x80000000)); }
__device__ __forceinline__ unsigned med3u(unsigned a, unsigned b, unsigned c) { unsigned r; asm("v_med3_u32 %0, %1, %2, %3" : "=v"(r) : "v"(a), "v"(b), "v"(c)); return r; }
#define TK_INS(L, xx) do { const unsigned x_ = (xx); _Pragma("unroll") for (int k_ = 15; k_ >= 1; --k_) L[k_] = med3u(L[k_ - 1], L[k_], x_); L[0] = L[0] > x_ ? L[0] : x_; } while (0)

__device__ __forceinline__ void phase_topk(const Ctx& C, int row_lo) {
    LAS unsigned* tl = (LAS unsigned*)C.lds;
    const int NGW = C.G * 8, u0 = (row_lo >> 6) * 8, nun = (NTOK >> 6) * 8 - u0;
    for (int j = 0; ; ++j) {
        int unit;
        if ((j + 1) * NGW <= nun) unit = u0 + j * NGW + C.vcu * 8 + C.wave;
        else { const int rem = nun - j * NGW; if (rem <= 0) break;
               const int q = C.wave * C.G + C.bx; if (q >= rem) break; unit = u0 + j * NGW + q; }
        const int tb = unit >> 3, h = unit & 7; const int row = tb * 64 + C.lane;
        const float* s = ((float*)(C.ws + WS_SC)) + ((size_t)unit * 256) * 64 + C.lane;
#pragma unroll 1
        for (int side = 0; side < 2; ++side) {
            unsigned L[16];
#pragma unroll
            for (int k = 0; k < 16; ++k) L[k] = 0u;
            const float* ss = s + (size_t)(side * 128) * 64;
            float va[32], vb[32];
#pragma unroll
            for (int q = 0; q < 32; ++q) va[q] = ss[(size_t)q * 64];
#pragma unroll
            for (int nb = 0; nb < 128; nb += 64) {
#pragma unroll
                for (int q = 0; q < 32; ++q) vb[q] = ss[(size_t)(nb + 32 + q) * 64];
#pragma unroll
                for (int q = 0; q < 32; ++q) TK_INS(L, (okey(va[q]) & ~127u) | (unsigned)(127 - (nb + q)));
                if (nb + 64 < 128) {
#pragma unroll
                    for (int q = 0; q < 32; ++q) va[q] = ss[(size_t)(nb + 64 + q) * 64];
                }
#pragma unroll
                for (int q = 0; q < 32; ++q) TK_INS(L, (okey(vb[q]) & ~127u) | (unsigned)(127 - (nb + 32 + q)));
            }
            float vals[16];
#pragma unroll
            for (int k = 0; k < 16; ++k) vals[k] = ss[(size_t)(127 - (int)(L[k] & 127u)) * 64];
#pragma unroll
            for (int k = 0; k < 16; ++k) {
                tl[(side * 32 + k) * 512 + C.tid] = 127u - (L[k] & 127u); tl[(side * 32 + 16 + k) * 512 + C.tid] = __builtin_bit_cast(unsigned, vals[k]);
            }
        }
        float v1[16], v2[16];
#pragma unroll
        for (int k = 0; k < 16; ++k) { v1[k] = __builtin_bit_cast(float, tl[(16 + k) * 512 + C.tid]); v2[k] = __builtin_bit_cast(float, tl[(48 + k) * 512 + C.tid]); }
        unsigned M[16];
#pragma unroll
        for (int k = 0; k < 16; ++k) M[k] = 0u;
#pragma unroll
        for (int a = 0; a < 16; ++a)
#pragma unroll
            for (int b = 0; b < 16; ++b)
                if ((a + 1) * (b + 1) <= 16) { const float sm = v1[a] + v2[b]; TK_INS(M, (okey(sm) & ~255u) | (unsigned)(255 - (a * 16 + b))); }
        float sums[16]; int ex[16]; float mx = -3.0e38f;
#pragma unroll
        for (int k = 0; k < 16; ++k) {
            const int f = 255 - (int)(M[k] & 255u), a = f >> 4, b = f & 15;
            const int i1 = (int)tl[a * 512 + C.tid], i2 = (int)tl[(32 + b) * 512 + C.tid];
            const float va = __builtin_bit_cast(float, tl[(16 + a) * 512 + C.tid]), vb = __builtin_bit_cast(float, tl[(48 + b) * 512 + C.tid]);
            sums[k] = va + vb; ex[k] = i1 * 128 + i2; mx = fmaxf(mx, sums[k]);
        }
        float den = 0.f;
#pragma unroll
        for (int k = 0; k < 16; ++k) { sums[k] = expf(sums[k] - mx); den += sums[k]; }
        const float inv = 1.0f / den;
        v4i* pe = (v4i*)(((int*)(C.ws + WS_PE)) + (size_t)row * NPICK + h * 16); f32x4* pc = (f32x4*)(((float*)(C.ws + WS_PC)) + (size_t)row * NPICK + h * 16);
#pragma unroll
        for (int q = 0; q < 4; ++q) { v4i e4; e4.x = ex[4 * q]; e4.y = ex[4 * q + 1]; e4.z = ex[4 * q + 2]; e4.w = ex[4 * q + 3]; pe[q] = e4;
            f32x4 c4; c4.x = sums[4 * q] * inv; c4.y = sums[4 * q + 1] * inv; c4.z = sums[4 * q + 2] * inv; c4.w = sums[4 * q + 3] * inv; pc[q] = c4; }
    }
}

__device__ __forceinline__ int red16_add(int x) {
    x += __builtin_amdgcn_update_dpp(0, x, 0xB1, 0xf, 0xf, true);
    x += __builtin_amdgcn_update_dpp(0, x, 0x4E, 0xf, 0xf, true);
    x += __builtin_amdgcn_update_dpp(0, x, 0x141, 0xf, 0xf, true);
    x += __builtin_amdgcn_update_dpp(0, x, 0x140, 0xf, 0xf, true);
    return x;
}
__device__ __forceinline__ float red16_max(float x) {
    x = fmaxf(x, __builtin_bit_cast(float, __builtin_amdgcn_update_dpp(0, __builtin_bit_cast(int, x), 0xB1, 0xf, 0xf, true)));
    x = fmaxf(x, __builtin_bit_cast(float, __builtin_amdgcn_update_dpp(0, __builtin_bit_cast(int, x), 0x4E, 0xf, 0xf, true)));
    x = fmaxf(x, __builtin_bit_cast(float, __builtin_amdgcn_update_dpp(0, __builtin_bit_cast(int, x), 0x141, 0xf, 0xf, true)));
    x = fmaxf(x, __builtin_bit_cast(float, __builtin_amdgcn_update_dpp(0, __builtin_bit_cast(int, x), 0x140, 0xf, 0xf, true)));
    return x;
}
#define UB0(w) ((float)((w) & 0xffu))
#define UB1(w) ((float)(((w) >> 8) & 0xffu))
#define UB2(w) ((float)(((w) >> 16) & 0xffu))
#define UB3(w) ((float)((w) >> 24))
struct UBuf { v4u u[4]; };
struct VBuf { v4u v[4]; };
__device__ __forceinline__ void u_issue(UBuf& B, int k, int g, int i16, int e_lo, int e_hi, const unsigned char* UQ) {
    const int p = 4 * k + g;
    const int e = __builtin_amdgcn_ds_bpermute((p & 63) << 2, (k < 16) ? e_lo : e_hi);
    const unsigned char* ur = UQ + (size_t)e * DM + 16 * i16;
#pragma unroll
    for (int c = 0; c < 4; ++c) B.u[c] = *(const v4u*)(ur + 256 * c);
}
__device__ __forceinline__ void u_compute(const UBuf& B, int k, int i16, const int (&fq)[16], int& d_lo, int& d_hi) {
    int acc = 0;
#pragma unroll
    for (int c = 0; c < 4; ++c) {
        acc = __builtin_amdgcn_sdot4((int)B.u[c].x, fq[4 * c + 0], acc, false); acc = __builtin_amdgcn_sdot4((int)B.u[c].y, fq[4 * c + 1], acc, false);
        acc = __builtin_amdgcn_sdot4((int)B.u[c].z, fq[4 * c + 2], acc, false); acc = __builtin_amdgcn_sdot4((int)B.u[c].w, fq[4 * c + 3], acc, false);
    }
    acc = red16_add(acc);
    if (k < 16) d_lo = (i16 == (k & 15)) ? acc : d_lo; else d_hi = (i16 == (k & 15)) ? acc : d_hi;
}
__device__ __forceinline__ void v_issue(VBuf& B, int k, int lane, int e_lo, int e_hi, const unsigned char* VQ) {
    const int ev = (k < 16) ? e_lo : e_hi;
#pragma unroll
    for (int q = 0; q < 4; ++q) { const int eq = __builtin_amdgcn_readlane(ev, (4 * k + q) & 63); B.v[q] = *((const v4u*)(VQ + (size_t)eq * DM) + lane); }
}
__device__ __forceinline__ void v_compute(const VBuf& B, int k, int pk_lo, int pk_hi, int (&acc)[16]) {
    const int cq4 = __builtin_amdgcn_readlane((k < 16) ? pk_lo : pk_hi, (4 * k) & 63);
    const unsigned a[4] = {B.v[0].x, B.v[0].y, B.v[0].z, B.v[0].w}, b[4] = {B.v[1].x, B.v[1].y, B.v[1].z, B.v[1].w},
                   c[4] = {B.v[2].x, B.v[2].y, B.v[2].z, B.v[2].w}, d[4] = {B.v[3].x, B.v[3].y, B.v[3].z, B.v[3].w};
#pragma unroll
    for (int w = 0; w < 4; ++w) {
        const unsigned ab_lo = __builtin_amdgcn_perm(b[w], a[w], 0x05010400u), ab_hi = __builtin_amdgcn_perm(b[w], a[w], 0x07030602u);
        const unsigned cd_lo = __builtin_amdgcn_perm(d[w], c[w], 0x05010400u), cd_hi = __builtin_amdgcn_perm(d[w], c[w], 0x07030602u);
        const unsigned t0 = __builtin_amdgcn_perm(cd_lo, ab_lo, 0x05040100u), t1 = __builtin_amdgcn_perm(cd_lo, ab_lo, 0x07060302u);
        const unsigned t2 = __builtin_amdgcn_perm(cd_hi, ab_hi, 0x05040100u), t3 = __builtin_amdgcn_perm(cd_hi, ab_hi, 0x07060302u);
        acc[4 * w + 0] = __builtin_amdgcn_sdot4((int)t0, cq4, acc[4 * w + 0], false); acc[4 * w + 1] = __builtin_amdgcn_sdot4((int)t1, cq4, acc[4 * w + 1], false);
        acc[4 * w + 2] = __builtin_amdgcn_sdot4((int)t2, cq4, acc[4 * w + 2], false); acc[4 * w + 3] = __builtin_amdgcn_sdot4((int)t3, cq4, acc[4 * w + 3], false);
    }
}
__device__ __forceinline__ void phase_gather(const Ctx& C, int l, bf16* Zt, bool fuse_next, int row_lo) {
    const int gw = C.vcu * 8 + C.wave, NGW = C.G * 8;
    const unsigned char* UQ = C.ws + WS_UQ + (size_t)l * NEXP * DM; const unsigned char* VQ = C.ws + WS_VQ + (size_t)l * NEXP * DM;
    const float* US = (const float*)(C.ws + WS_US) + (size_t)l * NEXP; const float* VS = (const float*)(C.ws + WS_VS) + (size_t)l * NEXP;
    const int g = C.lane >> 4, i16 = C.lane & 15;
    const int nrows_all = NTOK - row_lo, nfull = nrows_all / NGW, nrem = nrows_all - nfull * NGW, xq = C.wave * C.G + C.bx;
    const int nmine = nfull + (xq < nrem ? 1 : 0);
#define G_CONV_ITERS ((2 * NEXP + 4 * NGW - 1) / (4 * NGW))
#define G_ROW(k) (((k) < nfull) ? (row_lo + (k) * NGW + gw) : (((k) < nmine) ? (row_lo + nfull * NGW + xq) : NTOK))
    v4u nfq[4]; float nfs = 0.f; int ne_lo = 0, ne_hi = 0; float nc_lo = 0.f, nc_hi = 0.f;
#define U_PREFETCH(r) do { if ((r) < NTOK) { const unsigned char* fq_ = C.ws + WS_FQ + (size_t)(r) * DM + 16 * i16; \
        _Pragma("unroll") for (int c = 0; c < 4; ++c) nfq[c] = *(const v4u*)(fq_ + 256 * c); nfs = ((const float*)(C.ws + WS_FS))[(r)]; \
        const int* pe_ = ((int*)(C.ws + WS_PE)) + (size_t)(r) * NPICK; const float* pc_ = ((float*)(C.ws + WS_PC)) + (size_t)(r) * NPICK; \
        ne_lo = pe_[C.lane]; ne_hi = pe_[64 + C.lane]; nc_lo = pc_[C.lane]; nc_hi = pc_[64 + C.lane]; } } while (0)
#ifdef PROBE_GSEL
    if (fuse_next || PROBE_GSEL == 1)
#endif
    U_PREFETCH(G_ROW(0));
#ifdef PROBE_GSEL
    if (fuse_next || PROBE_GSEL == 1)
#endif
    for (int kr = 0; kr < nmine; ++kr) {
        const int row = G_ROW(kr);
        int fq[16]; const float fs = nfs;
        const int e_lo = ne_lo, e_hi = ne_hi; const float c_lo = nc_lo, c_hi = nc_hi;
#pragma unroll
        for (int c = 0; c < 4; ++c) { fq[4 * c] = (int)nfq[c].x; fq[4 * c + 1] = (int)nfq[c].y; fq[4 * c + 2] = (int)nfq[c].z; fq[4 * c + 3] = (int)nfq[c].w; }
        U_PREFETCH(G_ROW(kr + 1));
        const int pp = 4 * i16 + g;
        const int ep_lo = __builtin_amdgcn_ds_bpermute(pp << 2, e_lo), ep_hi = __builtin_amdgcn_ds_bpermute(pp << 2, e_hi);
        const float cp_lo = __builtin_bit_cast(float, __builtin_amdgcn_ds_bpermute(pp << 2, __builtin_bit_cast(int, c_lo))), cp_hi = __builtin_bit_cast(float, __builtin_amdgcn_ds_bpermute(pp << 2, __builtin_bit_cast(int, c_hi)));
        const float us_lo = US[ep_lo], us_hi = US[ep_hi], vs_lo = VS[ep_lo], vs_hi = VS[ep_hi];
        int d_lo = 0, d_hi = 0;
        UBuf A, B;
        u_issue(A, 0, g, i16, e_lo, e_hi, UQ);
#pragma unroll 1
        for (int k = 0; k < 32; k += 2) {
            u_issue(B, k + 1, g, i16, e_lo, e_hi, UQ);
            u_compute(A, k, i16, fq, d_lo, d_hi);
            if (k + 2 < 32) u_issue(A, k + 2, g, i16, e_lo, e_hi, UQ);
            u_compute(B, k + 1, i16, fq, d_lo, d_hi);
        }
        float* cor = ((float*)(C.ws + WS_CO)) + (size_t)row * NPICK;
        cor[pp] = gelu_t((float)d_lo * (fs * us_lo)) * (cp_lo * vs_lo);
        cor[64 + pp] = gelu_t((float)d_hi * (fs * us_hi)) * (cp_hi * vs_hi);
    }
#define V_PREFETCH(r) do { if ((r) < NTOK) { const int* pe_ = ((int*)(C.ws + WS_PE)) + (size_t)(r) * NPICK; const float* co_ = ((float*)(C.ws + WS_CO)) + (size_t)(r) * NPICK; \
        ne_lo = pe_[C.lane]; ne_hi = pe_[64 + C.lane]; nc_lo = co_[C.lane]; nc_hi = co_[64 + C.lane]; } } while (0)
    V_PREFETCH(G_ROW(0));
#ifdef PROBE_GSEL
    if (fuse_next || PROBE_GSEL == 2)
#endif
    for (int kr = 0; kr < nmine; ++kr) {
        const int row = G_ROW(kr);
        const int e_lo = ne_lo, e_hi = ne_hi;
        const float co_lo = nc_lo, co_hi = nc_hi;
        V_PREFETCH(G_ROW(kr + 1));
        if (fuse_next && l < DEPTH - 1 && !(kr & 1)) convert_tables(C, l + 1, kr >> 1, (kr >> 1) + 1);
        float cs; int pk_lo, pk_hi;
        {
            float am = fmaxf(fabsf(co_lo), fabsf(co_hi));
            am = fmaxf(am, DPPF(am, 0xB1)); am = fmaxf(am, DPPF(am, 0x4E)); am = fmaxf(am, DPPF(am, 0x141)); am = fmaxf(am, DPPF(am, 0x140));
            { const int iv = __builtin_bit_cast(int, am);
              am = fmaxf(fmaxf(__builtin_bit_cast(float, __builtin_amdgcn_readlane(iv, 0)), __builtin_bit_cast(float, __builtin_amdgcn_readlane(iv, 16))),
                         fmaxf(__builtin_bit_cast(float, __builtin_amdgcn_readlane(iv, 32)), __builtin_bit_cast(float, __builtin_amdgcn_readlane(iv, 48)))); }
            const float inv = am > 0.f ? 127.0f / am : 0.f; cs = am * (1.0f / 127.0f);
            const int sh = 8 * (C.lane & 3);
            int yl = (((int)rintf(co_lo * inv)) & 255) << sh, yh = (((int)rintf(co_hi * inv)) & 255) << sh;
            yl |= __builtin_amdgcn_update_dpp(0, yl, 0xB1, 0xf, 0xf, true); yl |= __builtin_amdgcn_update_dpp(0, yl, 0x4E, 0xf, 0xf, true);
            yh |= __builtin_amdgcn_update_dpp(0, yh, 0xB1, 0xf, 0xf, true); yh |= __builtin_amdgcn_update_dpp(0, yh, 0x4E, 0xf, 0xf, true);
            pk_lo = yl; pk_hi = yh;
        }
        int acc[16];
#pragma unroll
        for (int i = 0; i < 16; ++i) acc[i] = 0;
        const int mr = (row < NCTX) ? 4 : ((row - NCTX) >> 12);
        v4u* zp = (v4u*)(Zt + (size_t)row * DM) + 2 * C.lane;
        f32x4 zold[4], g2v[4], gpv[4], shv[4], scv[4], ppv[4];
        {
            const f32x4* g2 = (const f32x4*)(((float*)(C.ws + WS_MOD)) + ((size_t)(l * 5 + mr) * 6 + 5) * DM) + 4 * C.lane;
#pragma unroll
            for (int q = 0; q < 4; ++q) g2v[q] = g2[q];
            { const v4u za = zp[0], zb = zp[1];
              zold[0] = (f32x4){bflo(za.x), bfhi(za.x), bflo(za.y), bfhi(za.y)}; zold[1] = (f32x4){bflo(za.z), bfhi(za.z), bflo(za.w), bfhi(za.w)};
              zold[2] = (f32x4){bflo(zb.x), bfhi(zb.x), bflo(zb.y), bfhi(zb.y)}; zold[3] = (f32x4){bflo(zb.z), bfhi(zb.z), bflo(zb.w), bfhi(zb.w)}; }
            if (fuse_next) {
                if (l < DEPTH - 1) {
                    const int l1 = l + 1;
                    const f32x4* gp = (const f32x4*)(IN_(C, 6) + (size_t)l1 * DM) + 4 * C.lane;
                    const float* mb = ((float*)(C.ws + WS_MOD)) + ((size_t)(l1 * 5 + mr) * 6) * DM;
                    const f32x4* shp = (const f32x4*)mb + 4 * C.lane; const f32x4* scp = (const f32x4*)(mb + DM) + 4 * C.lane;
                    const int t = (row - NCTX) & 4095, seg = C.lane >> 4, p = (seg < 2) ? (t >> 6) : (t & 63);
                    const f32x4* pp = (const f32x4*)(((float*)(C.ws + WS_POS)) + (size_t)p * 512 + (seg & 1) * 256 + 16 * (C.lane & 15));
#pragma unroll
                    for (int q = 0; q < 4; ++q) { gpv[q] = gp[q]; shv[q] = shp[q]; scv[q] = scp[q]; ppv[q] = pp[q]; }
                } else {
                    const f32x4* gp = (const f32x4*)IN_(C, 28) + 4 * C.lane;
#pragma unroll
                    for (int q = 0; q < 4; ++q) gpv[q] = gp[q];
                }
            }
        }
        VBuf A, B;
        v_issue(A, 0, C.lane, e_lo, e_hi, VQ);
#pragma unroll 1
        for (int k = 0; k < 32; k += 2) {
            v_issue(B, k + 1, C.lane, e_lo, e_hi, VQ);
            v_compute(A, k, pk_lo, pk_hi, acc);
            if (k + 2 < 32) v_issue(A, k + 2, C.lane, e_lo, e_hi, VQ);
            v_compute(B, k + 1, pk_lo, pk_hi, acc);
        }
        float out[16];
#pragma unroll
        for (int i = 0; i < 16; ++i) out[i] = (float)acc[i] * cs;
        f32x4 zn[4]; float ss = 0.f;
#pragma unroll
        for (int q = 0; q < 4; ++q) { const f32x4 gg = g2v[q]; f32x4 z = zold[q];
            z.x += gg.x * out[4 * q]; z.y += gg.y * out[4 * q + 1]; z.z += gg.z * out[4 * q + 2]; z.w += gg.w * out[4 * q + 3];
            zn[q] = z; ss += (z.x * z.x + z.y * z.y) + (z.z * z.z + z.w * z.w); }
        if (l < DEPTH - 1 || !fuse_next) {
            v4u za, zb; za.x = pk2(zn[0].x, zn[0].y); za.y = pk2(zn[0].z, zn[0].w); za.z = pk2(zn[1].x, zn[1].y); za.w = pk2(zn[1].z, zn[1].w);
            zb.x = pk2(zn[2].x, zn[2].y); zb.y = pk2(zn[2].z, zn[2].w); zb.z = pk2(zn[3].x, zn[3].y); zb.w = pk2(zn[3].z, zn[3].w);
            zp[0] = za; zp[1] = zb;
        }
        if (fuse_next) {
            const float rs = __builtin_amdgcn_rsqf(wave_sum(ss) * (1.0f / DM) + EPS);
            if (l < DEPTH - 1) {
                unsigned w[8];
#pragma unroll
                for (int q = 0; q < 4; ++q) {
                    f32x4 o = (zn[q] * rs * gpv[q]) * (scv[q] + 1.0f) + shv[q];
                    if (row >= NCTX) o = o + ppv[q];
                    w[2 * q] = pk2(o.x, o.y); w[2 * q + 1] = pk2(o.z, o.w);
                }
                v4u* op = (v4u*)(((bf16*)(C.ws + WS_XN)) + (size_t)row * DM) + 2 * C.lane;
                v4u w0; w0.x = w[0]; w0.y = w[1]; w0.z = w[2]; w0.w = w[3]; v4u w1; w1.x = w[4]; w1.y = w[5]; w1.z = w[6]; w1.w = w[7];
                op[0] = w0; op[1] = w1;
            } else if (row >= NCTX) {
                f32x4* op = (f32x4*)(C.out + (size_t)(row - NCTX) * DM) + 4 * C.lane;
#pragma unroll
                for (int q = 0; q < 4; ++q) op[q] = zn[q] * rs * gpv[q];
            }
        }
    }
    if (fuse_next && l < DEPTH - 1) convert_tables(C, l + 1, (nmine + 1) >> 1, 64);
}

struct CtxEpiP { bf16* P; __device__ __forceinline__ void operator()(const f32x4 (&acc)[2][2], int m0, int n0, int fr, int fq) const {
#pragma unroll
    for (int mt = 0; mt < 2; ++mt)
#pragma unroll
        for (int nt = 0; nt < 2; ++nt) { const f32x4 v = acc[mt][nt]; v2u w; w.x = pk2(v[0], v[1]); w.y = pk2(v[2], v[3]);
            *(v2u*)(P + (size_t)(m0 + 16 * mt + fr) * PROJ + n0 + 16 * nt + 4 * fq) = w; } } };
struct CtxEpiResid { bf16* Z; const float* gate; __device__ __forceinline__ void operator()(const f32x4 (&acc)[2][2], int m0, int n0, int fr, int fq) const {
    v2u zv[2][2];
#pragma unroll
    for (int mt = 0; mt < 2; ++mt)
#pragma unroll
        for (int nt = 0; nt < 2; ++nt) zv[mt][nt] = *(const v2u*)(Z + (size_t)(m0 + 16 * mt + fr) * DM + n0 + 16 * nt + 4 * fq);
#pragma unroll
    for (int mt = 0; mt < 2; ++mt)
#pragma unroll
        for (int nt = 0; nt < 2; ++nt) { const f32x4 g = *(const f32x4*)(gate + n0 + 16 * nt + 4 * fq); const v2u z = zv[mt][nt]; const f32x4 a = g * acc[mt][nt];
            v2u w; w.x = pk2(bflo(z.x) + a[0], bfhi(z.x) + a[1]); w.y = pk2(bflo(z.y) + a[2], bfhi(z.y) + a[3]);
            *(v2u*)(Z + (size_t)(m0 + 16 * mt + fr) * DM + n0 + 16 * nt + 4 * fq) = w; } } };
struct CtxEpiScoreT { float* S; __device__ __forceinline__ void operator()(const f32x4 (&acc)[2][2], int m0, int n0, int fr, int fq) const {
#pragma unroll
    for (int mt = 0; mt < 2; ++mt)
#pragma unroll
        for (int nt = 0; nt < 2; ++nt) { const int row = m0 + 16 * mt + fr, col = n0 + 16 * nt + 4 * fq, head = col >> 8, cn = col & 255; const f32x4 v = acc[mt][nt];
            float* bp = S + ((size_t)((row >> 6) * 8 + head) * 256 + cn) * 64 + (row & 63);
            bp[0] = v[0]; bp[64] = v[1]; bp[128] = v[2]; bp[192] = v[3]; } } };

template <class Epi>
__device__ __forceinline__ void ctx_gemm(const Ctx& C, const bf16* A, const bf16* Bt, int M, int N, const Epi& E) {
    constexpr int AST = 1032;
    LAS bf16* As = (LAS bf16*)C.lds;
    const int ntn = N >> 8, ntiles = (M >> 5) * ntn, fr = C.lane & 15, fq = C.lane >> 4;
    for (int t = C.bx; t < ntiles; t += C.G) {
        const int tm = t / ntn, tn = t - tm * ntn, m0 = tm * 32, n0 = tn * 256 + 32 * C.wave;
        const bf16* bp = Bt + (size_t)(n0 + fr) * 1024 + 8 * fq;
        bf16x8 B0[8][2], B1[8][2];
#define CG_LOAD(BUF, ch) do { _Pragma("unroll") for (int ks = 0; ks < 8; ++ks) _Pragma("unroll") for (int nt = 0; nt < 2; ++nt) \
            BUF[ks][nt] = *(const bf16x8*)(bp + (size_t)(16 * nt) * 1024 + 32 * (8 * (ch) + ks)); } while (0)
#define CG_COMP(BUF, ch) do { _Pragma("unroll") for (int ks = 0; ks < 8; ++ks) { const LAS bf16* ap = As + fr * AST + 32 * (8 * (ch) + ks) + 8 * fq; \
            const bf16x8 a0 = *(const LAS bf16x8*)ap, a1 = *(const LAS bf16x8*)(ap + 16 * AST); \
            _Pragma("unroll") for (int nt = 0; nt < 2; ++nt) { acc[0][nt] = MFMA16(BUF[ks][nt], a0, acc[0][nt]); acc[1][nt] = MFMA16(BUF[ks][nt], a1, acc[1][nt]); } } } while (0)
        CG_LOAD(B0, 0);
        {
            v4u tmp[8];
#pragma unroll
            for (int q = 0; q < 8; ++q) { const int idx = C.tid + 512 * q, r = idx >> 7, c8 = (idx & 127) * 8; tmp[q] = *(const v4u*)(A + (size_t)(m0 + r) * 1024 + c8); }
#pragma unroll
            for (int q = 0; q < 8; ++q) { const int idx = C.tid + 512 * q, r = idx >> 7, c8 = (idx & 127) * 8; *(LAS v4u*)(As + r * AST + c8) = tmp[q]; }
        }
        __syncthreads();
        f32x4 acc[2][2];
#pragma unroll
        for (int mt = 0; mt < 2; ++mt)
#pragma unroll
            for (int nt = 0; nt < 2; ++nt) acc[mt][nt] = (f32x4){0.f, 0.f, 0.f, 0.f};
        CG_LOAD(B1, 1); CG_COMP(B0, 0);
        CG_LOAD(B0, 2); CG_COMP(B1, 1);
        CG_LOAD(B1, 3); CG_COMP(B0, 2);
        CG_COMP(B1, 3);
#undef CG_LOAD
#undef CG_COMP
        E(acc, m0, n0, fr, fq);
        __syncthreads();
    }
}

#ifndef PROBE_PHASE
#define PROBE_PHASE -1
#define PROBE_REP 0
#endif
#ifndef PGA
#define PGA true
#endif
#ifndef PGS
#define PGS true
#endif
#ifndef PROBE_P0MASK
#define PROBE_P0MASK 15
#endif
#ifndef PROBE_MIXSEL
#define PROBE_MIXSEL 0
#endif
struct Args { const float* in[29]; float* out; unsigned char* ws; int ph_lo, ph_hi; };
__global__ void __launch_bounds__(512, 2) mk_fwd(Args args) {
    extern __shared__ __attribute__((aligned(16))) unsigned char lds_raw[];
    {
        LAS unsigned char* l0 = (LAS unsigned char*)lds_raw;
        for (int u = threadIdx.x; u < (LDS_BYTES - LDSCTL_OFF) / 4; u += 512) ((LAS unsigned*)(l0 + LDSCTL_OFF))[u] = 0u;
        __syncthreads();
    }
    const int lo = args.ph_lo, hi = args.ph_hi;
    XcdBarrier bar; bar.bar = (unsigned*)(args.ws + WS_CTL) + CW_BAR; bar.x = 0; bar.st = nullptr;
    if (hi - lo > 1) bar = xcd_barrier_post((unsigned*)(args.ws + WS_CTL) + CW_BAR, (volatile LAS unsigned*)((LAS unsigned char*)lds_raw + MISC_OFF) + 8);

#if PROBE_REP > 0
    int ph = lo, rep = 0;
#else
    int ph = lo; constexpr int rep = 0;
#endif
    while (ph < hi) {
        int tid = threadIdx.x; asm volatile("" : "+v"(tid));
        int bx = blockIdx.x; asm volatile("" : "+s"(bx));
        const AS4 unsigned char* kp = (const AS4 unsigned char*)__builtin_amdgcn_kernarg_segment_ptr(); asm volatile("" : "+s"(kp));
        Ctx C;
        unsigned ldsoff = 0; asm volatile("" : "+s"(ldsoff));
        C.lds = (LAS unsigned char*)lds_raw + ldsoff;
        C.tid = tid; C.lane = tid & 63; C.wave = __builtin_amdgcn_readfirstlane(tid >> 6);
        C.G = gridDim.x; C.bx = bx; C.vcu = (C.G % 8 == 0) ? (bx % 8) * (C.G / 8) + bx / 8 : bx;
        C.kp = kp; C.out = *(float* const AS4*)(kp + 232); C.ws = *(unsigned char* const AS4*)(kp + 240);
        if (ph == 0) { const int m1 = (C.bx & 1) ? 12 : 3; phase_p0a(C, m1); phase_p0a(C, 15 ^ m1); if (PROBE_PHASE == 100) { xcd_barrier(bar); phase_p0a(C, PROBE_P0MASK & m1); phase_p0a(C, PROBE_P0MASK & (15 ^ m1)); } }
        else if (ph == 1) { phase_p0b(C); if (PROBE_PHASE == 200) { for (int q = 0; q < 32; ++q) xcd_barrier(bar); } }
        else if (ph == 2) phase_rows<0>(C, 0, 0);
        else {
            const int l = (ph - 3) / 11, st = (ph - 3) % 11;
            const int s = (st < 2) ? 1 : (st < 4) ? st : (st < 6) ? 4 : (st == 6) ? 5 : (st < 9) ? 6 : st - 2;
            const bool tail = (st == 1 || st == 5 || st == 8);
            bf16* Zt = (rep > 0) ? (bf16*)(C.ws + WS_SC) : (bf16*)(C.ws + WS_Z);
            if (s == 1 && !tail) { pg8::Gemm g{((bf16*)(C.ws + WS_XN)) + (size_t)NCTX * DM, ((bf16*)(C.ws + WS_WIN)) + (size_t)l * 2048 * 1024, NLAT, 2048, 1024}; pg8::StaticOrder S; S.init(NLAT, 2048, C.G, C.bx);
                pg8::EpiBf16 E{((bf16*)(C.ws + WS_P)) + (size_t)NCTX * PROJ, PROJ}; pg8::gemm_phase<pg8::EpiBf16, pg8::StaticOrder, PGA, PGS>(C.lds, g, S, E, C.tid); }
            else if (s == 1) {
                CtxEpiP EC{(bf16*)(C.ws + WS_P)}; ctx_gemm(C, (const bf16*)(C.ws + WS_XN), ((const bf16*)(C.ws + WS_WIN)) + (size_t)l * 2048 * 1024, NCTX, (l == DEPTH - 1) ? 256 : 2048, EC); }
            else if (s == 2) phase_mixers(C, l, rep > 0 ? PROBE_MIXSEL : 0);
            else if (s == 3) phase_fixup(C, l);
            else if (s == 4 && !tail) { const int r0 = NCTX;
                pg8::Gemm g{((bf16*)(C.ws + WS_Y)) + (size_t)r0 * DM, ((bf16*)(C.ws + WS_WOUT)) + (size_t)l * 1024 * 1024, NTOK - r0, 1024, 1024}; pg8::StaticOrder S; S.init(NTOK - r0, 1024, C.G, C.bx);
                pg8::EpiResid E{Zt + (size_t)r0 * DM, DM, ((float*)(C.ws + WS_MOD)) + ((size_t)(l * 5) * 6 + 2) * DM, 6 * DM, r0 / 256}; pg8::gemm_phase<pg8::EpiResid, pg8::StaticOrder, PGA, PGS>(C.lds, g, S, E, C.tid); }
            else if (s == 4) { if (l < DEPTH - 1) { CtxEpiResid EC{Zt, ((float*)(C.ws + WS_MOD)) + ((size_t)(l * 5 + 4) * 6 + 2) * DM}; ctx_gemm(C, (const bf16*)(C.ws + WS_Y), ((const bf16*)(C.ws + WS_WOUT)) + (size_t)l * 1024 * 1024, NCTX, 1024, EC); } }
            else if (s == 5) phase_rows<1>(C, l, (l == DEPTH - 1) ? NCTX : 0);
            else if (s == 6 && !tail) { const int r0 = NCTX;
                pg8::Gemm g{((bf16*)(C.ws + WS_XN)) + (size_t)r0 * DM, ((bf16*)(C.ws + WS_WCMB)) + (size_t)l * 2048 * 1024, NTOK - r0, 2048, 1024}; pg8::StaticOrder S; S.init(NTOK - r0, 2048, C.G, C.bx);
                pg8::EpiScoreT E{((float*)(C.ws + WS_SC)), r0}; pg8::gemm_phase<pg8::EpiScoreT, pg8::StaticOrder, PGA, PGS>(C.lds, g, S, E, C.tid); }
            else if (s == 6) { if (l < DEPTH - 1) { CtxEpiScoreT EC{(float*)(C.ws + WS_SC)}; ctx_gemm(C, (const bf16*)(C.ws + WS_XN), ((const bf16*)(C.ws + WS_WCMB)) + (size_t)l * 2048 * 1024, NCTX, 2048, EC); } }
            else if (s == 7) phase_topk(C, (l == DEPTH - 1) ? NCTX : 0);
            else phase_gather(C, l, Zt, rep == 0, (l == DEPTH - 1) ? NCTX : 0);
        }
        bool need_bar = true;
#if PROBE_REP > 0
        { const int st_ = (ph >= 3) ? (ph - 3) % 11 : -1;
          const int s_ = (st_ < 0) ? -1 : (st_ < 2) ? 1 : (st_ < 4) ? st_ : (st_ < 6) ? 4 : (st_ == 6) ? 5 : (st_ < 9) ? 6 : st_ - 2;
          const bool main_gemm = (st_ == 0 || st_ == 4 || st_ == 7);
          if (PROBE_PHASE == 11 && st_ == 1 && rep < PROBE_REP) ++rep;
          else if (PROBE_PHASE == 11) { ++ph; rep = 0; if (main_gemm) need_bar = false; }
          else if (s_ == PROBE_PHASE && rep < PROBE_REP && !main_gemm && st_ != 1 && st_ != 5 && st_ != 8) ++rep;
          else if (s_ == PROBE_PHASE && rep < PROBE_REP && (st_ == 1 || st_ == 5 || st_ == 8)) { ++rep; --ph; }
          else { ++ph; rep = (main_gemm ? rep : 0); if (main_gemm) need_bar = false; } }
#else
        { const int st_ = (ph >= 3) ? (ph - 3) % 11 : -1; need_bar = !(st_ == 0 || st_ == 4 || st_ == 7); ++ph; }
#endif
        if (ph < hi && need_bar) xcd_barrier(bar);
    }
}

extern "C" void kernel_launch(void* const* d_in, const int* in_sizes, int n_in, void* d_out, int out_size, void* d_ws, size_t ws_size, hipStream_t stream) {
    static int grid = 0;
    if (grid == 0) {
        if (n_in != 29 || out_size != NLAT * DM || ws_size < WS_END) { fprintf(stderr, "kernel_launch: unexpected shapes (n_in %d, out %d, ws %zu)\n", n_in, out_size, ws_size); grid = -1; return; }
        int dev = 0, cus = 0, per_cu = 0;
        if (hipGetDevice(&dev) != hipSuccess || hipDeviceGetAttribute(&cus, hipDeviceAttributeMultiprocessorCount, dev) != hipSuccess) { grid = -1; return; }
        if (hipFuncSetAttribute((const void*)mk_fwd, hipFuncAttributeMaxDynamicSharedMemorySize, LDS_BYTES) != hipSuccess) { fprintf(stderr, "kernel_launch: hipFuncSetAttribute failed\n"); grid = -1; return; }
        if (hipOccupancyMaxActiveBlocksPerMultiprocessor(&per_cu, (const void*)mk_fwd, 512, LDS_BYTES) != hipSuccess || per_cu < 1) { fprintf(stderr, "kernel_launch: occupancy query says %d blocks per CU\n", per_cu); (void)hipGetLastError(); grid = -1; return; }
        grid = cus;
    }
    if (grid < 0) return;
    if (hipMemsetAsync((char*)d_ws + WS_CTL, 0, CTL_ZERO_BYTES, stream) != hipSuccess) return;
    Args a{};
    for (int i = 0; i < 29; ++i) a.in[i] = (const float*)d_in[i];
    a.out = (float*)d_out; a.ws = (unsigned char*)d_ws;
#if MK_SINGLE
    a.ph_lo = 0; a.ph_hi = NPH;
    void* kargs[] = {&a};
    hipError_t le = hipLaunchCooperativeKernel((const void*)mk_fwd, dim3(grid), dim3(512), kargs, LDS_BYTES, stream);
    if (le != hipSuccess) fprintf(stderr, "kernel_launch: cooperative launch failed: %s (grid %d)\n", hipGetErrorName(le), grid);
#else
    for (int ph = 0; ph < NPH; ++ph) {
        a.ph_lo = ph; a.ph_hi = ph + 1;
        hipLaunchKernelGGL(mk_fwd, dim3(grid), dim3(512), LDS_BYTES, stream, a);
    }
#endif
}
```

```cpp
#include <hip/hip_runtime.h>
#include <cstdio>
#include <cstdint>

#ifndef MK_SINGLE
#define MK_SINGLE 1
#endif

namespace pg8 {
#define PG8_LAS __attribute__((address_space(3)))
typedef unsigned short bf16_t;
typedef short bf16x8 __attribute__((ext_vector_type(8)));
typedef float f32x4 __attribute__((ext_vector_type(4)));
typedef unsigned u32x4 __attribute__((ext_vector_type(4)));
constexpr int BM = 256, BK = 64, HALF = 128, HTB = HALF * BK * 2  , STAGE_BYTES = 8 * HTB, NXCD = 8, WGM = 8;

__host__ __device__ __forceinline__ int lds_byte(int r, int c) { const int st = (r >> 4) * 2 + (c >> 5), rr = r & 15, cc = c & 31, ob = rr * 64 + cc * 2; return st * 1024 + (ob ^ (((ob >> 9) & 1) << 5)); }
__host__ __device__ __forceinline__ void stage_rc(int b, int& R, int& C) { const int st = b / 1024, sb = b % 1024, swz = sb ^ (((sb >> 9) & 1) << 5); R = (st >> 1) * 16 + swz / 64; C = (st & 1) * 32 + (swz % 64) / 2; }
__host__ __device__ __forceinline__ int perm32(int rho) { const int n = rho >> 4, i = rho & 15; return 8 * (i >> 2) + 4 * n + (i & 3); }

struct Unit { int pm, pn; };
struct Gemm { const bf16_t* A; const bf16_t* Bt; int M, N, K; };

struct StaticOrder {
    int nM, nN, nwg, G, c;
    __host__ __device__ void init(int M, int N, int G_, int c_) { nM = M / BM; nN = N / BM; nwg = nM * nN; G = G_; c = c_; }
    __host__ __device__ bool next(int i, Unit& u) const {
        const long L = (long)i * G + c; if (L >= nwg) return false;
        int wgid = (int)L; { const int q = nwg / NXCD, r = nwg % NXCD, xcd = wgid % NXCD, off = wgid / NXCD; wgid = (xcd < r ? xcd * (q + 1) : r * (q + 1) + (xcd - r) * q) + off; }
        const int nig = WGM * nN, gid = wgid / nig, fm = gid * WGM, gsz = (nM - fm) < WGM ? (nM - fm) : WGM;
        u.pm = fm + ((wgid % nig) % gsz); u.pn = (wgid % nig) / gsz; return true;
    }
    __device__ __forceinline__ void a_ready(const Unit&) const {}
    __device__ __forceinline__ void done(const Unit&) const {}
};

__device__ __forceinline__ unsigned cvt_pk_bf16(float lo, float hi) { unsigned r; asm volatile("v_cvt_pk_bf16_f32 %0, %1, %2" : "=v"(r) : "v"(lo), "v"(hi)); return r; }

struct EpiBf16 {
    static constexpr bool PERM = true, AFTER_DRAIN = false;
    bf16_t* O; int ldc;
    __device__ __forceinline__ void operator()(const f32x4 (&acc)[2][2][4][2], const Unit& u, int wr, int wc, int fr, int fq) const {
        const int row0 = u.pm * BM + wr * 64 + fr; const int col0 = u.pn * BM + wc * 32 + 8 * fq;
#pragma unroll
        for (int ai = 0; ai < 2; ++ai)
#pragma unroll
            for (int m = 0; m < 4; ++m) { bf16_t* rowp = O + (size_t)(row0 + ai * HALF + m * 16) * ldc + col0;
#pragma unroll
                for (int bj = 0; bj < 2; ++bj) { const f32x4 v0 = acc[ai][bj][m][0], v1 = acc[ai][bj][m][1];
                    u32x4 w; w.x = cvt_pk_bf16(v0[0], v0[1]); w.y = cvt_pk_bf16(v0[2], v0[3]); w.z = cvt_pk_bf16(v1[0], v1[1]); w.w = cvt_pk_bf16(v1[2], v1[3]);
                    *(u32x4*)(rowp + bj * HALF) = w; } }
    }
};
struct EpiF32 {
    static constexpr bool PERM = false, AFTER_DRAIN = false;
    float* C; int ldc;
    __device__ __forceinline__ void operator()(const f32x4 (&acc)[2][2][4][2], const Unit& u, int wr, int wc, int fr, int fq) const {
        const int row0 = u.pm * BM + wr * 64 + fr, col0 = u.pn * BM + wc * 32 + 4 * fq;
#pragma unroll
        for (int ai = 0; ai < 2; ++ai)
#pragma unroll
            for (int m = 0; m < 4; ++m) { float* rowp = C + (size_t)(row0 + ai * HALF + m * 16) * ldc + col0;
#pragma unroll
                for (int bj = 0; bj < 2; ++bj)
#pragma unroll
                    for (int n = 0; n < 2; ++n) *(f32x4*)(rowp + bj * HALF + n * 16) = acc[ai][bj][m][n]; }
    }
};
struct EpiResid {
    static constexpr bool PERM = true, AFTER_DRAIN = false;
    unsigned short* Z; int ldc; const float* gate0; int gstride; int pmoff;
    __device__ __forceinline__ void operator()(const f32x4 (&acc)[2][2][4][2], const Unit& u, int wr, int wc, int fr, int fq) const {
        const int row0 = u.pm * BM + wr * 64 + fr, col0 = u.pn * BM + wc * 32 + 8 * fq;
        const int pmg = u.pm + pmoff; const int mr = (pmg < 4) ? 4 : ((pmg - 4) >> 4);
        const float* gp = gate0 + (size_t)mr * gstride + col0;
        f32x4 gv[2][2];
#pragma unroll
        for (int bj = 0; bj < 2; ++bj)
#pragma unroll
            for (int n = 0; n < 2; ++n) gv[bj][n] = *(const f32x4*)(gp + bj * HALF + n * 4);
#pragma unroll
        for (int ai = 0; ai < 2; ++ai) {
            u32x4 zv[4][2];
#pragma unroll
            for (int m = 0; m < 4; ++m)
#pragma unroll
                for (int bj = 0; bj < 2; ++bj) zv[m][bj] = *(const u32x4*)(Z + (size_t)(row0 + ai * HALF + m * 16) * ldc + col0 + bj * HALF);
#pragma unroll
            for (int m = 0; m < 4; ++m)
#pragma unroll
                for (int bj = 0; bj < 2; ++bj) { const u32x4 z = zv[m][bj]; const f32x4 a0 = acc[ai][bj][m][0] * gv[bj][0], a1 = acc[ai][bj][m][1] * gv[bj][1];
                    u32x4 w;
                    w.x = cvt_pk_bf16(__builtin_bit_cast(float, z.x << 16) + a0[0], __builtin_bit_cast(float, z.x & 0xffff0000u) + a0[1]);
                    w.y = cvt_pk_bf16(__builtin_bit_cast(float, z.y << 16) + a0[2], __builtin_bit_cast(float, z.y & 0xffff0000u) + a0[3]);
                    w.z = cvt_pk_bf16(__builtin_bit_cast(float, z.z << 16) + a1[0], __builtin_bit_cast(float, z.z & 0xffff0000u) + a1[1]);
                    w.w = cvt_pk_bf16(__builtin_bit_cast(float, z.w << 16) + a1[2], __builtin_bit_cast(float, z.w & 0xffff0000u) + a1[3]);
                    *(u32x4*)(Z + (size_t)(row0 + ai * HALF + m * 16) * ldc + col0 + bj * HALF) = w; }
        }
    }
};

__device__ __forceinline__ unsigned score_key(float x, int n) { const int u = __builtin_bit_cast(int, x); return ((unsigned)(u ^ ((u >> 31) | (int)0x80000000)) & ~127u) | (unsigned)(127 - (n & 127)); }
struct EpiScoreT {
    static constexpr bool PERM = false, AFTER_DRAIN = false;
    unsigned* S; int row_base;
    __device__ __forceinline__ void operator()(const f32x4 (&acc)[2][2][4][2], const Unit& u, int wr, int wc, int fr, int fq) const {
        int cn0 = wc * 32 + 4 * fq; asm volatile("" : "+v"(cn0));
        const int row0 = row_base + u.pm * BM + wr * 64 + fr, head = u.pn;
        const unsigned ib = (unsigned)(127 - cn0);
#pragma unroll
        for (int ai = 0; ai < 2; ++ai)
#pragma unroll
            for (int m = 0; m < 4; ++m) { const int row = row0 + ai * HALF + m * 16;
                unsigned* bp = S + ((size_t)((row >> 6) * 8 + head) * 256) * 64 + (row & 63) + (size_t)cn0 * 64;
#pragma unroll
                for (int bj = 0; bj < 2; ++bj)
#pragma unroll
                    for (int n = 0; n < 2; ++n) { const f32x4 v = acc[ai][bj][m][n]; unsigned* q = bp + (size_t)(bj * HALF + n * 16) * 64;
#pragma unroll
                        for (int e2 = 0; e2 < 4; ++e2) q[e2 * 64] = score_key(v[e2], cn0 + bj * HALF + n * 16 + e2); }
                asm volatile("" ::: "memory"); }
    }
};

template <class Epi, class Sched, bool ALIGN_EPI = false, bool SP2 = false>
__device__ __forceinline__ void gemm_phase(PG8_LAS unsigned char* lds, const Gemm g, const Sched& S, const Epi& E, const int tid) {
    const int wid = __builtin_amdgcn_readfirstlane(tid >> 6), lane = tid & 63, wr = wid >> 2, wc = wid & 3, fr = lane & 15, fq = lane >> 4;
    const int K = g.K, nt = K / BK;
    unsigned voffA[2], voffB[2];
#pragma unroll
    for (int i = 0; i < 2; ++i) { int R, C; stage_rc(tid * 16 + i * 8192, R, C); const int Rb = Epi::PERM ? ((R & ~31) + perm32(R & 31)) : R;
        voffA[i] = (unsigned)(R * K + C) * 2u; voffB[i] = (unsigned)(Rb * K + C) * 2u; }
    const size_t kstep = (size_t)(BK * 2);
    const size_t hstep = (size_t)HALF * K * 2;
    const size_t tstep = 2 * hstep;
    const unsigned ldsw = (unsigned)wid * 1024u;
    const int aoff = lds_byte(wr * 64 + fr, fq * 8), boff = lds_byte(wc * 32 + fr, fq * 8);
#define PG8_SA(b, h) (((b) * 2 + (h)) * HTB)
#define PG8_SB(b, h) ((4 + (b) * 2 + (h)) * HTB)
#define PG8_STAGE(bufoff, gbase, voff) do { _Pragma("unroll") for (int _i = 0; _i < 2; ++_i) \
        __builtin_amdgcn_global_load_lds((const unsigned*)((const char*)(gbase) + (voff)[_i]), (PG8_LAS unsigned*)(lds + (bufoff) + ldsw + _i * 8192), 16, 0, 0); } while (0)
#define PG8_LDA(dst, b, h) do { _Pragma("unroll") for (int m = 0; m < 4; ++m) _Pragma("unroll") for (int k = 0; k < 2; ++k) dst[m][k] = *(const PG8_LAS bf16x8*)(lds + PG8_SA(b, h) + aoff + m * 2048 + k * 1024); } while (0)
#define PG8_LDB(dst, b, h) do { _Pragma("unroll") for (int n = 0; n < 2; ++n) _Pragma("unroll") for (int k = 0; k < 2; ++k) dst[n][k] = *(const PG8_LAS bf16x8*)(lds + PG8_SB(b, h) + boff + n * 2048 + k * 1024); } while (0)
#define PG8_MMA(ai, bj, At, Bt) do { __builtin_amdgcn_s_setprio(1); _Pragma("unroll") for (int m = 0; m < 4; ++m) _Pragma("unroll") for (int n = 0; n < 2; ++n) _Pragma("unroll") for (int k = 0; k < 2; ++k) \
        acc[ai][bj][m][n] = __builtin_amdgcn_mfma_f32_16x16x32_bf16(Bt[n][k], At[m][k], acc[ai][bj][m][n], 0, 0, 0); __builtin_amdgcn_s_setprio(0); } while (0)
#define PG8_WAIT_V(n) asm volatile("s_waitcnt vmcnt(" #n ")" ::: "memory")
#define PG8_WAIT_L(n) asm volatile("s_waitcnt lgkmcnt(" #n ")" ::: "memory")
#define PG8_BAR __builtin_amdgcn_s_barrier()
#define PG8_SCHED __builtin_amdgcn_sched_barrier(0)
    Unit cur, nxt; int ui = 0;
    if (!S.next(0, cur)) return;
    f32x4 acc[2][2][4][2];
#pragma unroll
    for (int a = 0; a < 2; ++a)
#pragma unroll
        for (int b = 0; b < 2; ++b)
#pragma unroll
            for (int m = 0; m < 4; ++m)
#pragma unroll
                for (int n = 0; n < 2; ++n) acc[a][b][m][n] = (f32x4){0.f, 0.f, 0.f, 0.f};
    bf16x8 At[4][2], B0[2][2], B1[2][2];
    const char* cA = (const char*)g.A + (size_t)cur.pm * tstep; const char* cB = (const char*)g.Bt + (size_t)cur.pn * tstep;
    S.a_ready(cur);
    if constexpr (SP2) {
        PG8_STAGE(PG8_SB(0, 0), cB, voffB); PG8_STAGE(PG8_SB(0, 1), cB + hstep, voffB); PG8_STAGE(PG8_SA(0, 0), cA, voffA); PG8_STAGE(PG8_SA(0, 1), cA + hstep, voffA);
        if (wr == 1) PG8_BAR;
        PG8_WAIT_V(2); PG8_BAR;
        PG8_STAGE(PG8_SB(1, 0), cB + kstep, voffB); PG8_STAGE(PG8_SA(1, 0), cA + kstep, voffA); PG8_STAGE(PG8_SB(1, 1), cB + hstep + kstep, voffB);
        PG8_WAIT_V(6); PG8_BAR;
    } else {
        PG8_STAGE(PG8_SB(0, 0), cB, voffB); PG8_STAGE(PG8_SA(0, 0), cA, voffA); PG8_STAGE(PG8_SB(0, 1), cB + hstep, voffB); PG8_STAGE(PG8_SA(0, 1), cA + hstep, voffA);
        if (wr == 1) PG8_BAR;
        PG8_WAIT_V(4); PG8_BAR;
        PG8_STAGE(PG8_SB(1, 0), cB + kstep, voffB); PG8_STAGE(PG8_SA(1, 0), cA + kstep, voffA); PG8_STAGE(PG8_SB(1, 1), cB + hstep + kstep, voffB);
        PG8_WAIT_V(6); PG8_BAR;
    }
    for (;;) {
        const bool has_next = S.next(ui + 1, nxt);
        const char* nA = has_next ? (const char*)g.A + (size_t)nxt.pm * tstep : cA; const char* nB = has_next ? (const char*)g.Bt + (size_t)nxt.pn * tstep : cB;
        for (int t = 0; t < nt; t += 2) {
            const bool last = (t == nt - 2);
            const char* a1 = cA + (size_t)(t + 1) * kstep;
            const char* a2 = last ? nA : cA + (size_t)(t + 2) * kstep; const char* b2 = last ? nB : cB + (size_t)(t + 2) * kstep;
            const char* a3 = a2 + kstep; const char* b3 = b2 + kstep;
            if (last && has_next) S.a_ready(nxt);
            if constexpr (SP2) {
            PG8_LDB(B0, 0, 0); PG8_LDB(B1, 0, 1); PG8_SCHED; PG8_LDA(At, 0, 0); PG8_STAGE(PG8_SA(1, 1), a1 + hstep, voffA);
            PG8_WAIT_V(8); PG8_WAIT_L(0); PG8_BAR; PG8_MMA(0, 0, At, B0); PG8_MMA(0, 1, At, B1); PG8_BAR; PG8_SCHED;
            PG8_LDA(At, 0, 1); PG8_STAGE(PG8_SB(0, 0), b2, voffB); PG8_STAGE(PG8_SB(0, 1), b2 + hstep, voffB); PG8_STAGE(PG8_SA(0, 0), a2, voffA);
            PG8_WAIT_V(8); PG8_WAIT_L(0); PG8_BAR; PG8_MMA(1, 0, At, B0); PG8_MMA(1, 1, At, B1); PG8_BAR; PG8_SCHED;
            PG8_LDB(B0, 1, 0); PG8_LDB(B1, 1, 1); PG8_SCHED; PG8_LDA(At, 1, 0); PG8_STAGE(PG8_SA(0, 1), a2 + hstep, voffA);
            PG8_WAIT_V(8); PG8_WAIT_L(0); PG8_BAR; PG8_MMA(0, 0, At, B0); PG8_MMA(0, 1, At, B1); PG8_BAR; PG8_SCHED;
            PG8_LDA(At, 1, 1); PG8_STAGE(PG8_SB(1, 0), b3, voffB); PG8_STAGE(PG8_SB(1, 1), b3 + hstep, voffB); PG8_STAGE(PG8_SA(1, 0), a3, voffA);
            PG8_WAIT_V(8); PG8_WAIT_L(0); PG8_BAR; PG8_MMA(1, 0, At, B0); PG8_MMA(1, 1, At, B1); PG8_BAR; PG8_SCHED;
            } else {
            PG8_LDB(B0, 0, 0); PG8_SCHED; PG8_LDA(At, 0, 0); PG8_STAGE(PG8_SA(1, 1), a1 + hstep, voffA);
            PG8_WAIT_L(8); PG8_BAR; PG8_WAIT_L(0); PG8_MMA(0, 0, At, B0); PG8_BAR; PG8_SCHED;
            PG8_LDB(B1, 0, 1); PG8_STAGE(PG8_SB(0, 0), b2, voffB);
            PG8_BAR; PG8_WAIT_L(0); PG8_MMA(0, 1, At, B1); PG8_BAR;
            PG8_LDA(At, 0, 1); PG8_STAGE(PG8_SA(0, 0), a2, voffA);
            PG8_BAR; PG8_WAIT_L(0); PG8_MMA(1, 0, At, B0); PG8_BAR; PG8_SCHED;
            PG8_STAGE(PG8_SB(0, 1), b2 + hstep, voffB);
            PG8_WAIT_V(6); PG8_BAR; PG8_MMA(1, 1, At, B1); PG8_BAR;
            PG8_LDB(B0, 1, 0); PG8_SCHED; PG8_LDA(At, 1, 0); PG8_STAGE(PG8_SA(0, 1), a2 + hstep, voffA);
            PG8_WAIT_L(8); PG8_BAR; PG8_WAIT_L(0); PG8_MMA(0, 0, At, B0); PG8_BAR; PG8_SCHED;
            PG8_LDB(B1, 1, 1); PG8_STAGE(PG8_SB(1, 0), b3, voffB);
            PG8_BAR; PG8_WAIT_L(0); PG8_MMA(0, 1, At, B1); PG8_BAR;
            PG8_LDA(At, 1, 1); PG8_STAGE(PG8_SA(1, 0), a3, voffA);
            PG8_BAR; PG8_WAIT_L(0); PG8_MMA(1, 0, At, B0); PG8_BAR; PG8_SCHED;
            PG8_STAGE(PG8_SB(1, 1), b3 + hstep, voffB);
            PG8_WAIT_V(6); PG8_BAR; PG8_MMA(1, 1, At, B1); PG8_BAR;
            }
        }
        if constexpr (ALIGN_EPI) { if (wr == 0) PG8_BAR; }
        if constexpr (!Epi::AFTER_DRAIN) { E(acc, cur, wr, wc, fr, fq); S.done(cur); }
        if (!has_next) break;
#pragma unroll
        for (int a = 0; a < 2; ++a)
#pragma unroll
            for (int b = 0; b < 2; ++b)
#pragma unroll
                for (int m = 0; m < 4; ++m)
#pragma unroll
                    for (int n = 0; n < 2; ++n) acc[a][b][m][n] = (f32x4){0.f, 0.f, 0.f, 0.f};
        cur = nxt; cA = nA; cB = nB; ++ui;
        if constexpr (ALIGN_EPI) { if (wr == 1) PG8_BAR; }
    }
    PG8_WAIT_V(0);
    if constexpr (!ALIGN_EPI) { if (wr == 0) PG8_BAR; }
    PG8_BAR;
    if constexpr (Epi::AFTER_DRAIN) { E.fused(acc, cur, wr, wc, fr, fq, lds, wid, lane); S.done(cur); }
#undef PG8_SA
#undef PG8_SB
#undef PG8_STAGE
#undef PG8_LDA
#undef PG8_LDB
#undef PG8_MMA
#undef PG8_WAIT_V
#undef PG8_WAIT_L
#undef PG8_BAR
#undef PG8_SCHED
}
}

constexpr int DM = 1024, NB = 4, SEQ = 4096, DEPTH = 4, CTXL = 256;
constexpr int NCTX = NB * CTXL, NLAT = NB * SEQ, NTOK = NCTX + NLAT;
constexpr int PROJ = 2048, NEXP = 16384, NPICK = 128;
constexpr int NCHUNK = NTOK / 128;
constexpr float EPS = 1e-6f;
constexpr int NPH = 3 + 11 * DEPTH;

constexpr size_t MiB = 1u << 20;
constexpr size_t WS_CTL = 0, CTL_ZERO_BYTES = 1 * MiB;
constexpr size_t WS_MODP = 616 * MiB;
constexpr size_t WS_MOD  = 5 * MiB;
constexpr size_t WS_POS  = 6 * MiB;
constexpr size_t WS_AGG  = 7 * MiB;
constexpr size_t WS_WIN  = 8 * MiB;
constexpr size_t WS_WOUT = 24 * MiB;
constexpr size_t WS_WCMB = 32 * MiB;
constexpr size_t WS_PE   = 48 * MiB;
constexpr size_t WS_PC   = 58 * MiB;
constexpr size_t WS_Z    = 72 * MiB;
constexpr size_t WS_XN   = 140 * MiB;
constexpr size_t WS_P    = 176 * MiB;
constexpr size_t WS_Y    = 244 * MiB;
constexpr size_t WS_HS   = 280 * MiB;
constexpr size_t WS_SC   = 348 * MiB;
constexpr size_t WS_UQ   = 484 * MiB;
constexpr size_t WS_VQ   = 548 * MiB;
constexpr size_t WS_US   = 612 * MiB;
constexpr size_t WS_VS   = 613 * MiB;
constexpr size_t WS_SGW  = 614 * MiB;
constexpr size_t WS_CO   = 632 * MiB;
constexpr size_t WS_FQ   = 641 * MiB;
constexpr size_t WS_FS   = 658 * MiB;
constexpr size_t WS_END  = 659 * MiB;
constexpr int CW_BAR = 4096;

constexpr int RING_BYTES = 131072;
constexpr int LDS_BYTES = 163840;
constexpr int LDSCTL_OFF = LDS_BYTES - 1024, MISC_OFF = LDSCTL_OFF + 320;

#define LAS __attribute__((address_space(3)))
typedef unsigned short bf16;
typedef unsigned v4u __attribute__((ext_vector_type(4)));
typedef unsigned v2u __attribute__((ext_vector_type(2)));
typedef int v4i __attribute__((ext_vector_type(4)));
typedef float f32x4 __attribute__((ext_vector_type(4)));
#define LDS_WAIT() asm volatile("s_waitcnt lgkmcnt(0)" ::: "memory")

__device__ __forceinline__ unsigned f2bf(float f) { unsigned u = __builtin_bit_cast(unsigned, f); return (u + 0x7fffu + ((u >> 16) & 1u)) >> 16; }
__device__ __forceinline__ unsigned pk2(float lo, float hi) { return f2bf(lo) | (f2bf(hi) << 16); }
__device__ __forceinline__ float bf2f(unsigned short b) { return __builtin_bit_cast(float, ((unsigned)b) << 16); }
__device__ __forceinline__ float bflo(unsigned w) { return __builtin_bit_cast(float, w << 16); }
__device__ __forceinline__ float bfhi(unsigned w) { return __builtin_bit_cast(float, w & 0xffff0000u); }
__device__ __forceinline__ float gelu_t(float x) {
    const float u = 0.7978845608028654f * (x + 0.044715f * x * x * x);
    const float e = expf(2.f * u);
    const float t = 1.f - 2.f / (e + 1.f);
    return 0.5f * x * (1.f + t);
}
__device__ __forceinline__ float sigmoid_f(float x) { return 1.f / (1.f + expf(-x)); }
#define DPPF(x, ctrl) __builtin_bit_cast(float, __builtin_amdgcn_update_dpp(0, __builtin_bit_cast(int, (x)), (ctrl), 0xf, 0xf, true))
__device__ __forceinline__ float wave_sum(float v) {
    v += DPPF(v, 0xB1); v += DPPF(v, 0x4E); v += DPPF(v, 0x141); v += DPPF(v, 0x140);
    const int iv = __builtin_bit_cast(int, v);
    const float r0 = __builtin_bit_cast(float, __builtin_amdgcn_readlane(iv, 0)), r1 = __builtin_bit_cast(float, __builtin_amdgcn_readlane(iv, 16)),
                r2 = __builtin_bit_cast(float, __builtin_amdgcn_readlane(iv, 32)), r3 = __builtin_bit_cast(float, __builtin_amdgcn_readlane(iv, 48));
    return (r0 + r1) + (r2 + r3);
}

__device__ __forceinline__ void wave_sum2(float& a, float& b) {
    a += DPPF(a, 0xB1); b += DPPF(b, 0xB1); a += DPPF(a, 0x4E); b += DPPF(b, 0x4E); a += DPPF(a, 0x141); b += DPPF(b, 0x141); a += DPPF(a, 0x140); b += DPPF(b, 0x140);
    const int ia = __builtin_bit_cast(int, a), ib = __builtin_bit_cast(int, b);
    const float a0 = __builtin_bit_cast(float, __builtin_amdgcn_readlane(ia, 0)), a1 = __builtin_bit_cast(float, __builtin_amdgcn_readlane(ia, 16)),
                a2 = __builtin_bit_cast(float, __builtin_amdgcn_readlane(ia, 32)), a3 = __builtin_bit_cast(float, __builtin_amdgcn_readlane(ia, 48));
    const float b0 = __builtin_bit_cast(float, __builtin_amdgcn_readlane(ib, 0)), b1 = __builtin_bit_cast(float, __builtin_amdgcn_readlane(ib, 16)),
                b2 = __builtin_bit_cast(float, __builtin_amdgcn_readlane(ib, 32)), b3 = __builtin_bit_cast(float, __builtin_amdgcn_readlane(ib, 48));
    a = (a0 + a1) + (a2 + a3); b = (b0 + b1) + (b2 + b3);
}

#define XB_TMO      128
#define XB_XCNT(j)  (256  + 64 * (j))
#define XB_XSUB(j)  (1280 + 64 * (j))
#define XB_XGEN(j)  (2304 + 64 * (j))
#define XB_TOP      3328
#define XB_TOPGEN   3392
#define XCD_BAR_WORDS 3456
#define XB_SPIN_CAP (1u << 20)

__device__ __forceinline__ unsigned xb_ld(unsigned* p)              { return __hip_atomic_load(p, __ATOMIC_RELAXED, __HIP_MEMORY_SCOPE_AGENT); }
__device__ __forceinline__ unsigned xb_add(unsigned* p, unsigned v) { return __hip_atomic_fetch_add(p, v, __ATOMIC_RELAXED, __HIP_MEMORY_SCOPE_AGENT); }
__device__ __forceinline__ unsigned xb_xcc_id() { return (unsigned)__builtin_amdgcn_s_getreg((3 << 11) | 20) & 0xFu; }
#define XB_SPIN(cond, bar) do { unsigned _sp = 0; while (cond) { __builtin_amdgcn_s_sleep(1); \
    if ((++_sp & 255u) == 0u) { if (xb_ld(&(bar)[XB_TMO])) break; if (_sp > XB_SPIN_CAP) { atomicAdd(&(bar)[XB_TMO], 1u); break; } } } } while (0)

struct XcdBarrier {
    unsigned* bar; unsigned x;
    volatile LAS unsigned* st;
};

__device__ __forceinline__ XcdBarrier xcd_barrier_post(unsigned* bar, volatile LAS unsigned* st) {
    XcdBarrier b; b.bar = bar; b.x = xb_xcc_id(); b.st = st;
    if (threadIdx.x == 0) (void)xb_add(&bar[XB_XCNT(b.x)], 1u);
    return b;
}
__device__ __forceinline__ void xcd_barrier_complete(unsigned* bar, unsigned x, unsigned& nloc, unsigned& nx) {
    const unsigned G = gridDim.x * gridDim.y * gridDim.z;
    unsigned sum, cnt, mine, sp = 0u;
    for (;;) {
        sum = 0u; cnt = 0u; mine = 0u;
#pragma unroll
        for (unsigned j = 0; j < 16; ++j) { const unsigned c = xb_ld(&bar[XB_XCNT(j)]); sum += c; cnt += (c > 0u) ? 1u : 0u; mine = (j == x) ? c : mine; }
        if (sum == G) break;
        __builtin_amdgcn_s_sleep(1);
        if ((++sp & 255u) == 0u) { if (xb_ld(&bar[XB_TMO])) break; if (sp > XB_SPIN_CAP) { atomicAdd(&bar[XB_TMO], 1u); break; } }
    }
    nloc = mine > 0u ? mine : 1u; nx = cnt > 0u ? cnt : 1u;
}

__device__ __forceinline__ void xcd_barrier(const XcdBarrier& b) {
    asm volatile("s_waitcnt vmcnt(0)" ::: "memory");
    __syncthreads();
    if (threadIdx.x == 0) {
        unsigned* bar = b.bar;
        __builtin_amdgcn_s_waitcnt(0);
        unsigned nloc = b.st[0], nx = b.st[1];
        if (nloc == 0u) { xcd_barrier_complete(bar, b.x, nloc, nx); b.st[0] = nloc; b.st[1] = nx; }
        const unsigned old = xb_add(&bar[XB_XSUB(b.x)], 1u);
        const unsigned gen = old / nloc;
        if (old + 1u == (gen + 1u) * nloc) {
            __builtin_amdgcn_fence(__ATOMIC_RELEASE, "agent");
            asm volatile("s_waitcnt vmcnt(0)" ::: "memory");
            const unsigned og = xb_add(&bar[XB_TOP], 1u);
            const unsigned tg = og / nx;
            if (og + 1u == (tg + 1u) * nx) xb_add(&bar[XB_TOPGEN], 1u);
            else XB_SPIN(xb_ld(&bar[XB_TOPGEN]) == tg, bar);
            __builtin_amdgcn_fence(__ATOMIC_ACQUIRE, "agent");
            xb_add(&bar[XB_XGEN(b.x)], 1u);
            asm volatile("s_waitcnt vmcnt(0)" ::: "memory");
        } else {
            XB_SPIN(xb_ld(&bar[XB_XGEN(b.x)]) == gen, bar);
            __builtin_amdgcn_fence(__ATOMIC_ACQUIRE, "agent");
            asm volatile("s_waitcnt vmcnt(0)" ::: "memory");
        }
    }
    __syncthreads();
}


#define AS4 __attribute__((address_space(4)))
struct Ctx {
    LAS unsigned char* lds;
    int tid, lane, wave, vcu, G, bx;
    const AS4 unsigned char* kp;
    unsigned char* ws; float* out;
};
#define IN_(C, k) (*(const float* const AS4*)((C).kp + 8 * (k)))

typedef short bf16x8 __attribute__((ext_vector_type(8)));
#define MFMA16(a, b, c) __builtin_amdgcn_mfma_f32_16x16x32_bf16((a), (b), (c), 0, 0, 0)
__device__ __forceinline__ void p0_transpose_item(const float* W, int K, int N, bf16* WT, LAS float* scr, int item, int lane) {
    const int nblk = N / 32, kb = item / nblk, nb = item % nblk, k0 = 64 * kb, n0 = 32 * nb;
#pragma unroll 8
    for (int i = 0; i < 32; ++i) { const int kk = 2 * i + (lane >> 5); scr[kk * 33 + (lane & 31)] = W[(size_t)(k0 + kk) * N + n0 + (lane & 31)]; }
    LDS_WAIT(); asm volatile("" ::: "memory");
    const int c = lane & 7;
#pragma unroll
    for (int j = 0; j < 4; ++j) { const int n = (lane >> 3) + 8 * j; const LAS float* s = scr + (8 * c) * 33 + n;
        v4u o; o.x = pk2(s[0 * 33], s[1 * 33]); o.y = pk2(s[2 * 33], s[3 * 33]); o.z = pk2(s[4 * 33], s[5 * 33]); o.w = pk2(s[6 * 33], s[7 * 33]);
        *(v4u*)(WT + (size_t)(n0 + n) * K + k0 + 8 * c) = o; }
    LDS_WAIT(); asm volatile("" ::: "memory");
}

__device__ __forceinline__ void convert_tables(const Ctx& C, int l, int it0, int it1) {
    const int gw = C.vcu * 8 + C.wave, NGW = C.G * 8;
    for (int q0 = (it0 * NGW + gw) * 4; q0 < 2 * NEXP && q0 < (it1 * NGW) * 4; q0 += NGW * 4) {
        const bool isv = q0 >= NEXP; const int rr0 = l * NEXP + (isv ? q0 - NEXP : q0);
        const f32x4* src = (const f32x4*)((isv ? IN_(C, 27) : IN_(C, 26)) + (size_t)rr0 * DM) + C.lane;
        f32x4 v[4][4];
#pragma unroll
        for (int q = 0; q < 4; ++q)
#pragma unroll
            for (int j = 0; j < 4; ++j) v[q][j] = src[q * 256 + 64 * j];
        const int bias = 0;
#pragma unroll
        for (int q = 0; q < 4; ++q) {
            float am = 0.f;
#pragma unroll
            for (int j = 0; j < 4; ++j) am = fmaxf(am, fmaxf(fmaxf(fabsf(v[q][j].x), fabsf(v[q][j].y)), fmaxf(fabsf(v[q][j].z), fabsf(v[q][j].w))));
            am = fmaxf(am, DPPF(am, 0xB1)); am = fmaxf(am, DPPF(am, 0x4E)); am = fmaxf(am, DPPF(am, 0x141)); am = fmaxf(am, DPPF(am, 0x140));
            { const int iv = __builtin_bit_cast(int, am);
              am = fmaxf(fmaxf(__builtin_bit_cast(float, __builtin_amdgcn_readlane(iv, 0)), __builtin_bit_cast(float, __builtin_amdgcn_readlane(iv, 16))),
                         fmaxf(__builtin_bit_cast(float, __builtin_amdgcn_readlane(iv, 32)), __builtin_bit_cast(float, __builtin_amdgcn_readlane(iv, 48)))); }
            const float inv = am > 0.f ? 127.0f / am : 0.f;
            unsigned* dst = (unsigned*)(C.ws + (isv ? WS_VQ : WS_UQ) + (size_t)(rr0 + q) * DM) + C.lane;
#pragma unroll
            for (int j = 0; j < 4; ++j) {
                const int q0 = (int)rintf(v[q][j].x * inv) + bias, q1 = (int)rintf(v[q][j].y * inv) + bias, q2 = (int)rintf(v[q][j].z * inv) + bias, q3 = (int)rintf(v[q][j].w * inv) + bias;
                dst[64 * j] = (unsigned)(q0 & 255) | ((unsigned)(q1 & 255) << 8) | ((unsigned)(q2 & 255) << 16) | ((unsigned)(q3 & 255) << 24);
            }
            if (C.lane == 0) ((float*)(C.ws + (isv ? WS_VS : WS_US)))[rr0 + q] = am * (1.0f / 127.0f);
        }
    }
}

__device__ __forceinline__ void phase_p0a(const Ctx& C, int mask) {
    const int gw = C.vcu * 8 + C.wave, NGW = C.G * 8;
    const int gt = C.vcu * 512 + C.tid, NGT = C.G * 512;
    LAS float* scr = (LAS float*)(C.lds + C.wave * 16384);
    if (mask & 1) for (int it = gw; it < 4 * 1024 + 4 * 512; it += NGW) {
        if (it < 4096) { const int l = it >> 10, r = it & 1023; p0_transpose_item(IN_(C, 8) + (size_t)l * 1024 * 2048, 1024, 2048, ((bf16*)(C.ws + WS_WIN)) + (size_t)l * 2048 * 1024, scr, r, C.lane); }
        else { const int q = it - 4096, l = q >> 9, r = q & 511; p0_transpose_item(IN_(C, 9) + (size_t)l * 1024 * 1024, 1024, 1024, ((bf16*)(C.ws + WS_WOUT)) + (size_t)l * 1024 * 1024, scr, r, C.lane); }
    }
    for (int i = gt; i < 4 * 4 * 128 * 128; i += NGT) ((bf16*)(C.ws + WS_SGW))[i] = (bf16)f2bf(IN_(C, 21)[i]);
    for (int i = gt; i < 64 * 512; i += NGT) {
        const int p = i >> 9, j = i & 511, q = j & 255;
        const float omega = powf(10000.0f, -(float)q / 256.0f);
        const float ang = (float)p * omega;
        ((float*)(C.ws + WS_POS))[i] = (j < 256) ? sinf(ang) : cosf(ang);
    }
    if (mask & 2) convert_tables(C, 0, 0, 64);
    if (mask & 4) for (int it = gw; it < 4 * 32 * 24; it += NGW) {
        const int cb = it % 24, ks = (it / 24) & 31, l = it / 768;
        const int col = cb * 256 + 4 * C.lane;
        const float* w = IN_(C, 4) + ((size_t)l * 1024 + ks * 32) * 6144 + col;
        f32x4 wv[32];
#pragma unroll
        for (int k = 0; k < 32; ++k) wv[k] = *(const f32x4*)(w + (size_t)k * 6144);
        int sl[5];
        { const int kk = ks * 32 + (C.lane & 31);
#pragma unroll
          for (int r = 0; r < 5; ++r) { const float v = (r < 4) ? IN_(C, 1)[r * 1024 + kk] : IN_(C, 3)[kk]; sl[r] = __builtin_bit_cast(int, v / (1.f + expf(-v))); } }
        f32x4 a[5];
#pragma unroll
        for (int r = 0; r < 5; ++r) a[r] = (f32x4){0.f, 0.f, 0.f, 0.f};
#pragma unroll
        for (int k = 0; k < 32; ++k)
#pragma unroll
            for (int r = 0; r < 5; ++r) a[r] = a[r] + wv[k] * __builtin_bit_cast(float, __builtin_amdgcn_readlane(sl[r], k));
        float* o = ((float*)(C.ws + WS_MODP)) + (((size_t)ks * 4 + l) * 5) * 6144 + col;
#pragma unroll
        for (int r = 0; r < 5; ++r) *(f32x4*)(o + (size_t)r * 6144) = a[r];
    }
    {
        const int fr = C.lane & 15, fq = C.lane >> 4;
        if (mask & 8) for (int it = gw; it < 8192; it += NGW) {
            const int nt = it & 7, kt = (it >> 3) & 15, side = (it >> 7) & 1, h = (it >> 8) & 7, l = it >> 11;
            const float* key = (side ? IN_(C, 25) : IN_(C, 24)) + (size_t)l * 16384 + (size_t)(nt * 16 + fr) * 128 + 8 * fq;
            const float* wq = IN_(C, 23) + (size_t)l * 1024 * 2048 + (size_t)(kt * 64 + fr) * 2048 + h * 256 + side * 128 + 8 * fq;
            f32x4 kx[4][2], wx[4][4][2];
#pragma unroll
            for (int ks = 0; ks < 4; ++ks) { kx[ks][0] = *(const f32x4*)(key + 32 * ks); kx[ks][1] = *(const f32x4*)(key + 32 * ks + 4); }
#pragma unroll
            for (int ct = 0; ct < 4; ++ct)
#pragma unroll
                for (int ks = 0; ks < 4; ++ks) { const float* wp = wq + (size_t)(16 * ct) * 2048 + 32 * ks; wx[ct][ks][0] = *(const f32x4*)wp; wx[ct][ks][1] = *(const f32x4*)(wp + 4); }
            bf16x8 Bh[4], Bl[4];
#pragma unroll
            for (int ks = 0; ks < 4; ++ks) { const f32x4 x0 = kx[ks][0], x1 = kx[ks][1];
                const float xv[8] = {x0.x, x0.y, x0.z, x0.w, x1.x, x1.y, x1.z, x1.w};
#pragma unroll
                for (int e = 0; e < 8; ++e) { const unsigned hb = f2bf(xv[e]); Bh[ks][e] = (short)hb; Bl[ks][e] = (short)f2bf(xv[e] - __builtin_bit_cast(float, hb << 16)); } }
            bf16* o = (bf16*)(C.ws + WS_WCMB) + ((size_t)l * 2048 + h * 256 + side * 128 + nt * 16 + fr) * 1024 + kt * 64 + 4 * fq;
#pragma unroll
            for (int ct = 0; ct < 4; ++ct) {
                f32x4 acc = {0.f, 0.f, 0.f, 0.f};
#pragma unroll
                for (int ks = 0; ks < 4; ++ks) { const f32x4 x0 = wx[ct][ks][0], x1 = wx[ct][ks][1];
                    const float xv[8] = {x0.x, x0.y, x0.z, x0.w, x1.x, x1.y, x1.z, x1.w};
                    bf16x8 Ah, Al;
#pragma unroll
                    for (int e = 0; e < 8; ++e) { const unsigned hb = f2bf(xv[e]); Ah[e] = (short)hb; Al[e] = (short)f2bf(xv[e] - __builtin_bit_cast(float, hb << 16)); }
                    acc = MFMA16(Ah, Bh[ks], acc); acc = MFMA16(Ah, Bl[ks], acc); acc = MFMA16(Al, Bh[ks], acc); }
                v2u w; w.x = pk2(acc[0], acc[1]); w.y = pk2(acc[2], acc[3]);
                *(v2u*)(o + 16 * ct) = w;
            }
        }
    }
}

__device__ __forceinline__ void phase_p0b(const Ctx& C) {
    const int gt = C.vcu * 512 + C.tid, NGT = C.G * 512;
    for (int i = gt; i < 4 * 5 * 6144; i += NGT) {
        const int l = i / 30720, rem = i % 30720, r = rem / 6144, col = rem % 6144;
        float v = IN_(C, 5)[l * 6144 + col];
#pragma unroll 8
        for (int ks = 0; ks < 32; ++ks) v += ((float*)(C.ws + WS_MODP))[(((size_t)ks * 4 + l) * 5 + r) * 6144 + col];
        ((float*)(C.ws + WS_MOD))[i] = v;
    }
}

template <int MODE>
__device__ __forceinline__ void phase_rows(const Ctx& C, int l, int row_lo) {
    const int gw = C.vcu * 8 + C.wave, NGW = C.G * 8;
    const bool first = (MODE == 0 && l == 0);
    const int n = NTOK - row_lo, per = n / NGW, rem = n - per * NGW;
    int row = row_lo + gw * per + (gw < rem ? gw : rem);
    const int rend = row + per + (gw < rem ? 1 : 0);
#define ROW_LOAD(dst, r) do { if ((r) < rend) { if (first) { const f32x4* sp_ = (const f32x4*)((r) < NCTX ? IN_(C, 2) + (size_t)(r) * DM : IN_(C, 0) + (size_t)((r) - NCTX) * DM) + C.lane; \
            _Pragma("unroll") for (int j = 0; j < 4; ++j) dst[j] = sp_[64 * j]; } \
        else { const v2u* sp_ = (const v2u*)(((const bf16*)(C.ws + WS_Z)) + (size_t)(r) * DM) + C.lane; \
            _Pragma("unroll") for (int j = 0; j < 4; ++j) { const v2u w_ = sp_[64 * j]; dst[j] = (f32x4){bflo(w_.x), bfhi(w_.x), bflo(w_.y), bfhi(w_.y)}; } } } } while (0)
    f32x4 v[4], v1[4], v2[4];
    ROW_LOAD(v, row); ROW_LOAD(v1, row + 1);
    f32x4 gq[4], shq[4], scq[4]; int mr_cur = -1;
    if (MODE != 2) { const f32x4* gp = (const f32x4*)((MODE == 0 ? IN_(C, 6) : IN_(C, 7)) + (size_t)l * DM) + C.lane;
#pragma unroll
        for (int j = 0; j < 4; ++j) gq[j] = gp[64 * j]; }
    else { const f32x4* gp = (const f32x4*)IN_(C, 28) + C.lane;
#pragma unroll
        for (int j = 0; j < 4; ++j) gq[j] = gp[64 * j]; }
    while (row < rend) {
        ROW_LOAD(v2, row + 2);
        float ss = 0.f;
#pragma unroll
        for (int j = 0; j < 4; ++j) ss += (v[j].x * v[j].x + v[j].y * v[j].y) + (v[j].z * v[j].z + v[j].w * v[j].w);
        if (first) { v2u* zp = (v2u*)(((bf16*)(C.ws + WS_Z)) + (size_t)row * DM) + C.lane;
#pragma unroll
            for (int j = 0; j < 4; ++j) { v2u w; w.x = pk2(v[j].x, v[j].y); w.y = pk2(v[j].z, v[j].w); zp[64 * j] = w;
                v[j] = (f32x4){bflo(w.x), bfhi(w.x), bflo(w.y), bfhi(w.y)}; } }
        int mr, t; if (row < NCTX) { mr = 4; t = row & 255; } else { mr = (row - NCTX) >> 12; t = (row - NCTX) & 4095; }
        if (MODE != 2 && mr != mr_cur) { mr_cur = mr;
            const float* mb = ((float*)(C.ws + WS_MOD)) + ((size_t)(l * 5 + mr) * 6 + (MODE == 0 ? 0 : 3)) * DM;
            const f32x4* shp = (const f32x4*)mb + C.lane; const f32x4* scp = (const f32x4*)(mb + DM) + C.lane;
#pragma unroll
            for (int j = 0; j < 4; ++j) { shq[j] = shp[64 * j]; scq[j] = scp[64 * j] + 1.0f; } }
        const float rs = __builtin_amdgcn_rsqf(wave_sum(ss) * (1.0f / DM) + EPS);
        if (MODE == 2) {
            f32x4* op = (f32x4*)(C.out + (size_t)(row - NCTX) * DM) + C.lane;
#pragma unroll
            for (int j = 0; j < 4; ++j) op[64 * j] = v[j] * rs * gq[j];
        } else {
            v2u* op = (v2u*)(((bf16*)(C.ws + WS_XN)) + (size_t)row * DM) + C.lane;
            f32x4 ov[4]; float am = 0.f;
#pragma unroll
            for (int j = 0; j < 4; ++j) {
                f32x4 o = (v[j] * rs * gq[j]) * scq[j] + shq[j];
                if (MODE == 0 && row >= NCTX) {
                    const int p = (j < 2) ? (t >> 6) : (t & 63);
                    o = o + *((const f32x4*)(((float*)(C.ws + WS_POS)) + (size_t)p * 512 + (j & 1) * 256) + C.lane);
                }
                v2u w; w.x = pk2(o.x, o.y); w.y = pk2(o.z, o.w); op[64 * j] = w;
                if (MODE == 1) { ov[j] = (f32x4){bflo(w.x), bfhi(w.x), bflo(w.y), bfhi(w.y)};
                    am = fmaxf(am, fmaxf(fmaxf(fabsf(ov[j].x), fabsf(ov[j].y)), fmaxf(fabsf(ov[j].z), fabsf(ov[j].w)))); }
            }
            if (MODE == 1) {
                am = fmaxf(am, DPPF(am, 0xB1)); am = fmaxf(am, DPPF(am, 0x4E)); am = fmaxf(am, DPPF(am, 0x141)); am = fmaxf(am, DPPF(am, 0x140));
                { const int iv = __builtin_bit_cast(int, am);
                  am = fmaxf(fmaxf(__builtin_bit_cast(float, __builtin_amdgcn_readlane(iv, 0)), __builtin_bit_cast(float, __builtin_amdgcn_readlane(iv, 16))),
                             fmaxf(__builtin_bit_cast(float, __builtin_amdgcn_readlane(iv, 32)), __builtin_bit_cast(float, __builtin_amdgcn_readlane(iv, 48)))); }
                const float inv = am > 0.f ? 127.0f / am : 0.f;
                unsigned* qp = (unsigned*)(C.ws + WS_FQ + (size_t)row * DM) + C.lane;
#pragma unroll
                for (int j = 0; j < 4; ++j) { const int q0 = (int)rintf(ov[j].x * inv), q1 = (int)rintf(ov[j].y * inv), q2 = (int)rintf(ov[j].z * inv), q3 = (int)rintf(ov[j].w * inv);
                    qp[64 * j] = (unsigned)(q0 & 255) | ((unsigned)(q1 & 255) << 8) | ((unsigned)(q2 & 255) << 16) | ((unsigned)(q3 & 255) << 24); }
                if (C.lane == 0) ((float*)(C.ws + WS_FS))[row] = am * (1.0f / 127.0f);
            }
        }
#pragma unroll
        for (int j = 0; j < 4; ++j) { v[j] = v1[j]; v1[j] = v2[j]; }
        ++row;
    }
#undef ROW_LOAD
}

constexpr int XS = 264;
constexpr int VTS = 136;
__device__ __forceinline__ float fexp(float x) { return __builtin_amdgcn_exp2f(x * 1.4426950408889634f); }
__device__ __forceinline__ float fsigmoid(float x) { return __builtin_amdgcn_rcpf(1.0f + fexp(-x)); }
__device__ __forceinline__ float fgelu(float x) {
    const float x2 = x * x;
    const float e = __builtin_amdgcn_exp2f(x * (x2 * (-0.044715f * 2.302208198f) - 2.302208198f));
    return x * __builtin_amdgcn_rcpf(1.0f + e);
}
__device__ __forceinline__ float one_minus_exp(float x) {
    const float p = -x * (1.0f + x * (0.5f + x * (0.16666667f + x * (0.041666668f + x * (0.0083333338f + x * 0.0013888889f)))));
    const float q = 1.0f - fexp(x);
    return (x > -0.25f) ? p : q;
}
__device__ __forceinline__ void seq_of_row(int row0, int& seq0, int& len) { if (row0 < NCTX) { seq0 = row0 & ~255; len = 256; } else { seq0 = NCTX + ((row0 - NCTX) & ~4095); len = 4096; } }
__device__ __forceinline__ void load_bfrags(const float* W, int lane, bf16x8 (&B)[4][2]) {
    const float* w0 = W + (8 * (lane >> 4)) * 64 + (lane & 15);
#pragma unroll
    for (int ct = 0; ct < 4; ++ct)
#pragma unroll
        for (int ks = 0; ks < 2; ++ks) {
            bf16x8 b;
#pragma unroll
            for (int e = 0; e < 8; ++e) b[e] = (short)f2bf(w0[(32 * ks + e) * 64 + 16 * ct]);
            B[ct][ks] = b;
        }
}

__device__ __forceinline__ void mixer_a(const Ctx& C, int l, int chunk) {
    const int row0 = chunk * 128; int seq0, len; seq_of_row(row0, seq0, len); const int t0 = row0 - seq0;
    LAS bf16* xa = (LAS bf16*)C.lds;
    LAS float* tile = (LAS float*)(C.lds + 128 * XS * 2 + C.wave * 8192);
    const bf16* P = (const bf16*)(C.ws + WS_P);
    {
        const float* cw = IN_(C, 10) + (size_t)l * 4 * 256; const float* cbias = IN_(C, 11) + (size_t)l * 256;
        const int c4 = (C.tid & 63) * 4, i0 = (C.tid >> 6) * 16;
        v2u pv[19];
#pragma unroll
        for (int q = 0; q < 19; ++q) { const int t = t0 + i0 - 2 + q; pv[q] = (v2u){0u, 0u}; if (t >= 0 && t < len) pv[q] = *(const v2u*)(P + (size_t)(seq0 + t) * PROJ + c4); }
        f32x4 w[4];
#pragma unroll
        for (int k = 0; k < 4; ++k) w[k] = *(const f32x4*)(cw + k * 256 + c4);
        const f32x4 bias = *(const f32x4*)(cbias + c4);
#pragma unroll
        for (int i = 0; i < 16; ++i) {
            f32x4 acc = bias;
#pragma unroll
            for (int k = 0; k < 4; ++k) { const v2u x = pv[i + k]; acc.x += w[k].x * bflo(x.x); acc.y += w[k].y * bfhi(x.x); acc.z += w[k].z * bflo(x.y); acc.w += w[k].w * bfhi(x.y); }
            v2u o; o.x = pk2(acc.x, acc.y); o.y = pk2(acc.z, acc.w);
            *(LAS v2u*)(xa + (i0 + i) * XS + c4) = o;
        }
    }
    __syncthreads();
    const int d = C.wave >> 2, h = C.wave & 3, fr = C.lane & 15, fq = C.lane >> 4;
    bf16x8 Br[4][2], Bi[4][2];
    load_bfrags(IN_(C, 13) + ((size_t)(l * 2 + d) * 4 + h) * 4096, C.lane, Br);
    load_bfrags(IN_(C, 15) + ((size_t)(l * 2 + d) * 4 + h) * 4096, C.lane, Bi);
    float brv[4], biv[4], spv[4];
#pragma unroll
    for (int ct = 0; ct < 4; ++ct) { const int j = 16 * ct + fr;
        brv[ct] = IN_(C, 14)[((l * 2 + d) * 4 + h) * 64 + j]; biv[ct] = IN_(C, 16)[((l * 2 + d) * 4 + h) * 64 + j];
        const float lam = IN_(C, 12)[(l * 2 + d) * 256 + h * 64 + j]; spv[ct] = fmaxf(-lam, 0.f) + log1pf(expf(-fabsf(lam))); }
    float hst = 0.f, acum = 1.f;
    bf16* HX = (bf16*)(C.ws + WS_HS) + (size_t)d * NTOK * 256 + h * 64 + C.lane; bf16* AX = (bf16*)(C.ws + WS_HS) + (size_t)(2 + d) * NTOK * 256 + h * 64 + C.lane;
    for (int it = 0; it < 8; ++it) {
        const int rt = d ? 7 - it : it;
        const LAS bf16* ap = xa + (16 * rt + fr) * XS + h * 64 + 8 * fq;
        const bf16x8 a0 = *(const LAS bf16x8*)ap, a1 = *(const LAS bf16x8*)(ap + 32);
        f32x4 ar[4], ai[4];
#pragma unroll
        for (int ct = 0; ct < 4; ++ct) {
            ar[ct] = MFMA16(a0, Br[ct][0], ((f32x4){0.f, 0.f, 0.f, 0.f})); ar[ct] = MFMA16(a1, Br[ct][1], ar[ct]);
            ai[ct] = MFMA16(a0, Bi[ct][0], ((f32x4){0.f, 0.f, 0.f, 0.f})); ai[ct] = MFMA16(a1, Bi[ct][1], ai[ct]);
        }
#pragma unroll
        for (int ct = 0; ct < 4; ++ct)
#pragma unroll
            for (int r = 0; r < 4; ++r) {
                const int tl = 4 * fq + r, j = 16 * ct + fr;
                const float xav = bf2f(xa[(16 * rt + tl) * XS + h * 64 + j]);
                const float rg = fsigmoid(ar[ct][r] + brv[ct]), ig = fsigmoid(ai[ct][r] + biv[ct]);
                const float la = -8.0f * rg * spv[ct];
                tile[tl * 64 + j] = fexp(la);
                tile[1024 + tl * 64 + j] = __builtin_amdgcn_sqrtf(one_minus_exp(2.0f * la)) * (ig * xav);
            }
        asm volatile("s_waitcnt lgkmcnt(0)" ::: "memory");
#pragma unroll 4
        for (int s = 0; s < 16; ++s) {
            const int tl = d ? 15 - s : s;
            const float a = tile[tl * 64 + C.lane], b = tile[1024 + tl * 64 + C.lane];
            hst = a * hst + b; acum *= a;
            const size_t ro = (size_t)(row0 + 16 * rt + tl) * 256;
            HX[ro] = (bf16)f2bf(hst); AX[ro] = (bf16)f2bf(acum);
        }
        asm volatile("s_waitcnt lgkmcnt(0)" ::: "memory");
    }
    { float* ag = (float*)(C.ws + WS_AGG) + ((size_t)(chunk * 2 + d) * 2) * 256 + h * 64 + C.lane; ag[0] = acum; ag[256] = hst; }
    __syncthreads();
}

__device__ __forceinline__ void mixer_b(const Ctx& C, int l, int chunk) {
    const int row0 = chunk * 128; int seq0, len; seq_of_row(row0, seq0, len); const int t0 = row0 - seq0;
    LAS bf16* dm = (LAS bf16*)C.lds;
    LAS bf16* xs = (LAS bf16*)(C.lds + 128 * XS * 2);
    const bf16* P = (const bf16*)(C.ws + WS_P); bf16* Y = (bf16*)(C.ws + WS_Y);
    const int half = C.wave >> 2, g = C.wave & 3, fr = C.lane & 15, fq = C.lane >> 4;
    bf16x8 Bw[4][2];
    load_bfrags(IN_(C, 17) + ((size_t)(l * 4 + g)) * 4096, C.lane, Bw);
    float scv[4];
#pragma unroll
    for (int ct = 0; ct < 4; ++ct) scv[ct] = IN_(C, 18)[l * 256 + g * 64 + 16 * ct + fr];
    {
        v4u tmp[9];
#pragma unroll
        for (int q = 0; q < 9; ++q) { const int idx = C.tid + 512 * q, i = idx >> 5, c8 = (idx & 31) * 8, t = t0 - 8 + i;
            tmp[q] = (v4u){0u, 0u, 0u, 0u}; if (t >= 0 && t < len) tmp[q] = *(const v4u*)(P + (size_t)(seq0 + t) * PROJ + 512 + c8); }
#pragma unroll
        for (int q = 0; q < 9; ++q) { const int idx = C.tid + 512 * q, i = idx >> 5, c8 = (idx & 31) * 8; *(LAS v4u*)(xs + i * 256 + c8) = tmp[q]; }
    }
    __syncthreads();
    {
        const int wh = C.wave >> 2, ri = C.lane >> 4, c4 = g * 64 + (C.lane & 15) * 4, hw = 1 << g;
        const int i0 = wh * 64 + ri * 16;
        f32x4 s = {0.f, 0.f, 0.f, 0.f};
        for (int o = -hw; o < hw; ++o) { const v2u pv = *(const LAS v2u*)(xs + (i0 + 8 + o) * 256 + c4); s.x += bflo(pv.x); s.y += bfhi(pv.x); s.z += bflo(pv.y); s.w += bfhi(pv.y); }
#pragma unroll 4
        for (int it = 0; it < 16; ++it) {
            const int i = i0 + it, t = t0 + i;
            int lo = t - hw, hi = t + hw; lo = lo < 0 ? 0 : lo; hi = hi > len ? len : hi;
            const float inv = 1.0f / (float)(hi - lo);
            const v2u xv = *(const LAS v2u*)(xs + (i + 8) * 256 + c4);
            v2u o2; o2.x = pk2(s.x * inv - bflo(xv.x), s.y * inv - bfhi(xv.x)); o2.y = pk2(s.z * inv - bflo(xv.y), s.w * inv - bfhi(xv.y));
            *(LAS v2u*)(dm + i * XS + c4) = o2;
            const v2u pa = *(const LAS v2u*)(xs + (i + 8 + hw) * 256 + c4), pd = *(const LAS v2u*)(xs + (i + 8 - hw) * 256 + c4);
            s.x += bflo(pa.x) - bflo(pd.x); s.y += bfhi(pa.x) - bfhi(pd.x); s.z += bflo(pa.y) - bflo(pd.y); s.w += bfhi(pa.y) - bfhi(pd.y);
        }
    }
    __syncthreads();
#pragma unroll
    for (int q = 0; q < 4; ++q) {
        const int rt = half * 4 + q;
        const LAS bf16* ap = dm + (16 * rt + fr) * XS + g * 64 + 8 * fq;
        const bf16x8 a0 = *(const LAS bf16x8*)ap, a1 = *(const LAS bf16x8*)(ap + 32);
#pragma unroll
        for (int ct = 0; ct < 4; ++ct) {
            f32x4 acc = MFMA16(a0, Bw[ct][0], ((f32x4){0.f, 0.f, 0.f, 0.f})); acc = MFMA16(a1, Bw[ct][1], acc);
#pragma unroll
            for (int r = 0; r < 4; ++r) Y[(size_t)(row0 + 16 * rt + 4 * fq + r) * DM + 256 + g * 64 + 16 * ct + fr] = (bf16)f2bf(acc[r] * scv[ct]);
        }
    }
    __syncthreads();
}

__device__ __forceinline__ void mixer_c(const Ctx& C, int l, int chunk) {
    const int row0 = chunk * 128; int seq0, len; seq_of_row(row0, seq0, len); const int t0 = row0 - seq0;
    const float* cw = IN_(C, 19) + (size_t)l * 3 * 256;
    const bf16* P = (const bf16*)(C.ws + WS_P); bf16* Y = (bf16*)(C.ws + WS_Y);
    const int c4 = (C.tid & 63) * 4;
    f32x4 w[3];
#pragma unroll
    for (int k = 0; k < 3; ++k) w[k] = *(const f32x4*)(cw + k * 256 + c4);
#pragma unroll 1
    for (int hf = 0; hf < 2; ++hf) {
        const int i0 = (C.tid >> 6) * 16 + hf * 8;
        v2u pa[10], pb[10], pc[8];
#pragma unroll
        for (int q = 0; q < 10; ++q) { const int t = t0 + i0 - 1 + q; pa[q] = (v2u){0u, 0u}; pb[q] = (v2u){0u, 0u};
            if (t >= 0 && t < len) { const bf16* p = P + (size_t)(seq0 + t) * PROJ; pa[q] = *(const v2u*)(p + 1024 + c4); pb[q] = *(const v2u*)(p + 1280 + c4); } }
#pragma unroll
        for (int i = 0; i < 8; ++i) pc[i] = *(const v2u*)(P + (size_t)(row0 + i0 + i) * PROJ + 768 + c4);
        f32x4 pr[10];
#pragma unroll
        for (int q = 0; q < 10; ++q) { pr[q].x = bflo(pa[q].x) * bflo(pb[q].x); pr[q].y = bfhi(pa[q].x) * bfhi(pb[q].x); pr[q].z = bflo(pa[q].y) * bflo(pb[q].y); pr[q].w = bfhi(pa[q].y) * bfhi(pb[q].y); }
#pragma unroll
        for (int i = 0; i < 8; ++i) {
            const f32x4 acc = w[0] * pr[i] + w[1] * pr[i + 1] + w[2] * pr[i + 2];
            v2u o; o.x = pk2(bflo(pc[i].x) * acc.x, bfhi(pc[i].x) * acc.y); o.y = pk2(bflo(pc[i].y) * acc.z, bfhi(pc[i].y) * acc.w);
            *(v2u*)(Y + (size_t)(row0 + i0 + i) * DM + 512 + c4) = o;
        }
    }
}

__device__ __forceinline__ void mixer_d(const Ctx& C, int l, int chunk) {
    const int row0 = chunk * 128;
    LAS bf16* vt = (LAS bf16*)C.lds;
    const bf16* P = (const bf16*)(C.ws + WS_P); bf16* Y = (bf16*)(C.ws + WS_Y);
    const int qh = C.wave >> 2, h = C.wave & 3, fr = C.lane & 15, fq = C.lane >> 4;
    const bf16* WSb = (const bf16*)(C.ws + WS_SGW) + ((size_t)(l * 4 + h) * 128) * 128;
    bf16x8 Bqa[4][4];
#pragma unroll
    for (int qq = 0; qq < 4; ++qq)
#pragma unroll
        for (int ks = 0; ks < 4; ++ks) Bqa[qq][ks] = *(const bf16x8*)(WSb + (size_t)(16 * (qh * 4 + qq) + fr) * 128 + 32 * ks + 8 * fq);
    {
        v2u pvv[16];
#pragma unroll
        for (int q = 0; q < 16; ++q) pvv[q] = *(const v2u*)(P + (size_t)(row0 + C.wave + 8 * q) * PROJ + 1792 + 4 * C.lane);
        const f32x4 gg = *(const f32x4*)(IN_(C, 20) + (size_t)l * 256 + 4 * C.lane);
#pragma unroll 4
        for (int q = 0; q < 16; ++q) {
            const int i = C.wave + 8 * q; const v2u pv = pvv[q];
            f32x4 g; g.x = fgelu(bflo(pv.x)); g.y = fgelu(bfhi(pv.x)); g.z = fgelu(bflo(pv.y)); g.w = fgelu(bfhi(pv.y));
            float s1 = (g.x + g.y) + (g.z + g.w), s2 = (g.x * g.x + g.y * g.y) + (g.z * g.z + g.w * g.w);
            wave_sum2(s1, s2);
            const float mean = s1 * (1.0f / 256.0f);
            const float var = fmaxf(s2 * (1.0f / 256.0f) - mean * mean, 0.f);
            const float rs = __builtin_amdgcn_rsqf(var + EPS);
            g = g - mean;
            g = g * rs * gg;
            LAS bf16* o = vt + (4 * C.lane) * VTS + i;
            o[0] = (bf16)f2bf(g.x); o[VTS] = (bf16)f2bf(g.y); o[2 * VTS] = (bf16)f2bf(g.z); o[3 * VTS] = (bf16)f2bf(g.w);
        }
    }
    __syncthreads();
    bf16x8 Av[4][4];
#pragma unroll
    for (int ct = 0; ct < 4; ++ct)
#pragma unroll
        for (int ks = 0; ks < 4; ++ks) Av[ct][ks] = *(const LAS bf16x8*)(vt + (h * 64 + 16 * ct + fr) * VTS + 32 * ks + 8 * fq);
    const float* BS = IN_(C, 22) + (size_t)(l * 4 + h) * 128;
#pragma unroll
    for (int qq = 0; qq < 4; ++qq) {
        const int qt = qh * 4 + qq, q = 16 * qt + fr;
        const float bias = BS[q];
        const size_t row = (size_t)(row0 + q);
#pragma unroll
        for (int ct = 0; ct < 4; ++ct) {
            f32x4 acc = {0.f, 0.f, 0.f, 0.f};
#pragma unroll
            for (int ks = 0; ks < 4; ++ks) acc = MFMA16(Av[ct][ks], Bqa[qq][ks], acc);
            const int c0 = h * 64 + 16 * ct + 4 * fq;
            const v2u pu = *(const v2u*)(P + row * PROJ + 1536 + c0);
            v2u o; o.x = pk2(fgelu(bflo(pu.x)) * (acc[0] + bias), fgelu(bfhi(pu.x)) * (acc[1] + bias)); o.y = pk2(fgelu(bflo(pu.y)) * (acc[2] + bias), fgelu(bfhi(pu.y)) * (acc[3] + bias));
            *(v2u*)(Y + row * DM + 768 + c0) = o;
        }
    }
    __syncthreads();
}

__device__ __forceinline__ void phase_mixers(const Ctx& C, int l, int sel) {
    if (C.G >= 2 * NCHUNK - 16) {
        if (C.bx < NCHUNK) { if (sel != 2) { mixer_a(C, l, C.bx); mixer_c(C, l, C.bx); } }
        else if (sel != 1) { const int nb = C.G - NCHUNK;
            for (int u = C.bx - NCHUNK; u < 2 * NCHUNK; u += nb) {
                if (u < NCHUNK) mixer_d(C, l, u); else mixer_b(C, l, u - NCHUNK); } }
    } else {
        for (int u = C.bx; u < 4 * NCHUNK; u += C.G) {
            if (u < NCHUNK) mixer_a(C, l, u); else if (u < 2 * NCHUNK) mixer_d(C, l, u - NCHUNK); else if (u < 3 * NCHUNK) mixer_b(C, l, u - 2 * NCHUNK); else mixer_c(C, l, u - 3 * NCHUNK); }
    }
}

__device__ __forceinline__ void phase_fixup(const Ctx& C, int l) {
    LAS float* cr = (LAS float*)C.lds;
    const bf16* P = (const bf16*)(C.ws + WS_P); bf16* Y = (bf16*)(C.ws + WS_Y);
    for (int u = C.bx; u < 2 * NCHUNK; u += C.G) {
        const int chunk = u >> 1, hf = u & 1;
        const bf16* H0 = (const bf16*)(C.ws + WS_HS); const bf16* H1 = H0 + (size_t)NTOK * 256; const bf16* A0 = H0 + (size_t)2 * NTOK * 256; const bf16* A1 = H0 + (size_t)3 * NTOK * 256;
        v2u hv[8][5];
#pragma unroll
        for (int q = 0; q < 8; ++q) { const int idx = C.tid + 512 * q, i = idx >> 6, c4 = (idx & 63) * 4; const size_t row = (size_t)chunk * 128 + hf * 64 + i;
            hv[q][0] = *(const v2u*)(H0 + row * 256 + c4); hv[q][1] = *(const v2u*)(H1 + row * 256 + c4); hv[q][2] = *(const v2u*)(A0 + row * 256 + c4); hv[q][3] = *(const v2u*)(A1 + row * 256 + c4);
            hv[q][4] = *(const v2u*)(P + row * PROJ + 256 + c4); }
        {
            const int c = C.tid & 255, d = C.wave >> 2;
            const bool isctx = chunk < 8; const int b = isctx ? (chunk >> 1) : ((chunk - 8) >> 5), k = isctx ? (chunk & 1) : ((chunk - 8) & 31);
            const int n = isctx ? (d ? 1 - k : k) : (d ? 2 + 31 - k : 2 + k);
            const float* AG = (const float*)(C.ws + WS_AGG);
            float av[33], bv[33];
#pragma unroll
            for (int q = 0; q < 33; ++q) {
                const int cid = (q < 2) ? (b * 2 + (d ? 1 - q : q)) : (8 + b * 32 + (d ? 31 - (q - 2) : (q - 2)));
                const float* ag = AG + ((size_t)(cid * 2 + d) * 2) * 256 + c;
                av[q] = (q < n) ? ag[0] : 1.0f; bv[q] = (q < n) ? ag[256] : 0.0f;
            }
            float carry = 0.f;
#pragma unroll
            for (int q = 0; q < 33; ++q) carry = av[q] * carry + bv[q];
            cr[d * 256 + c] = carry;
        }
        __syncthreads();
#pragma unroll
        for (int q = 0; q < 8; ++q) {
            const int idx = C.tid + 512 * q, i = idx >> 6, c4 = (idx & 63) * 4; const size_t row = (size_t)chunk * 128 + hf * 64 + i;
            const v2u h0 = hv[q][0], h1 = hv[q][1], a0 = hv[q][2], a1 = hv[q][3], ag = hv[q][4];
            const f32x4 cf = *(const LAS f32x4*)(cr + c4), cb = *(const LAS f32x4*)(cr + 256 + c4);
            const float y0 = (bflo(h0.x) + bflo(a0.x) * cf.x + bflo(h1.x) + bflo(a1.x) * cb.x) * fgelu(bflo(ag.x));
            const float y1 = (bfhi(h0.x) + bfhi(a0.x) * cf.y + bfhi(h1.x) + bfhi(a1.x) * cb.y) * fgelu(bfhi(ag.x));
            const float y2 = (bflo(h0.y) + bflo(a0.y) * cf.z + bflo(h1.y) + bflo(a1.y) * cb.z) * fgelu(bflo(ag.y));
            const float y3 = (bfhi(h0.y) + bfhi(a0.y) * cf.w + bfhi(h1.y) + bfhi(a1.y) * cb.w) * fgelu(bfhi(ag.y));
            v2u o; o.x = pk2(y0, y1); o.y = pk2(y2, y3);
            *(v2u*)(Y + row * DM + c4) = o;
        }
        __syncthreads();
    }
}

__device__ __forceinline__ unsigned okey(float x) { const int u = __builtin_bit_cast(int, x); return (unsigned)(u ^ ((u >> 31) | (int)0x80000000)); }
__device__ __forceinline__ unsigned med3u(unsigned a, unsigned b, unsigned c) { unsigned r; asm("v_med3_u32 %0, %1, %2, %3" : "=v"(r) : "v"(a), "v"(b), "v"(c)); return r; }
#define TK_INS(L, xx) do { const unsigned x_ = (xx); _Pragma("unroll") for (int k_ = 15; k_ >= 1; --k_) L[k_] = med3u(L[k_ - 1], L[k_], x_); L[0] = L[0] > x_ ? L[0] : x_; } while (0)

__device__ __forceinline__ void phase_topk(const Ctx& C, int row_lo) {
    LAS unsigned* tl = (LAS unsigned*)C.lds;
    const int NGW = C.G * 8, u0 = (row_lo >> 6) * 8, nun = (NTOK >> 6) * 8 - u0;
    for (int j = 0; ; ++j) {
        int unit;
        if ((j + 1) * NGW <= nun) unit = u0 + j * NGW + C.vcu * 8 + C.wave;
        else { const int rem = nun - j * NGW; if (rem <= 0) break;
               const int q = C.wave * C.G + C.bx; if (q >= rem) break; unit = u0 + j * NGW + q; }
        const int tb = unit >> 3, h = unit & 7; const int row = tb * 64 + C.lane;
        const unsigned* s = ((const unsigned*)(C.ws + WS_SC)) + ((size_t)unit * 256) * 64 + C.lane;
#pragma unroll 1
        for (int side = 0; side < 2; ++side) {
            unsigned L[16];
#pragma unroll
            for (int k = 0; k < 16; ++k) L[k] = 0u;
            const unsigned* ss = s + (size_t)(side * 128) * 64;
            unsigned va[32], vb[32];
#pragma unroll
            for (int q = 0; q < 32; ++q) va[q] = ss[(size_t)q * 64];
#pragma unroll
            for (int nb = 0; nb < 128; nb += 64) {
#pragma unroll
                for (int q = 0; q < 32; ++q) vb[q] = ss[(size_t)(nb + 32 + q) * 64];
#pragma unroll
                for (int q = 0; q < 32; ++q) TK_INS(L, va[q]);
                if (nb + 64 < 128) {
#pragma unroll
                    for (int q = 0; q < 32; ++q) va[q] = ss[(size_t)(nb + 64 + q) * 64];
                }
#pragma unroll
                for (int q = 0; q < 32; ++q) TK_INS(L, vb[q]);
            }
#pragma unroll
            for (int k = 0; k < 16; ++k) {
                const unsigned kk = L[k] & ~127u; const unsigned ub = (kk & 0x80000000u) ? (kk ^ 0x80000000u) : ~kk;
                tl[(side * 32 + k) * 512 + C.tid] = 127u - (L[k] & 127u); tl[(side * 32 + 16 + k) * 512 + C.tid] = ub;
            }
        }
        float v1[16], v2[16];
#pragma unroll
        for (int k = 0; k < 16; ++k) { v1[k] = __builtin_bit_cast(float, tl[(16 + k) * 512 + C.tid]); v2[k] = __builtin_bit_cast(float, tl[(48 + k) * 512 + C.tid]); }
        unsigned M[16];
#pragma unroll
        for (int k = 0; k < 16; ++k) M[k] = 0u;
#pragma unroll
        for (int a = 0; a < 16; ++a)
#pragma unroll
            for (int b = 0; b < 16; ++b)
                if ((a + 1) * (b + 1) <= 16) { const float sm = v1[a] + v2[b]; TK_INS(M, (okey(sm) & ~255u) | (unsigned)(255 - (a * 16 + b))); }
        float sums[16]; int ex[16]; float mx = -3.0e38f;
#pragma unroll
        for (int k = 0; k < 16; ++k) {
            const int f = 255 - (int)(M[k] & 255u), a = f >> 4, b = f & 15;
            const int i1 = (int)tl[a * 512 + C.tid], i2 = (int)tl[(32 + b) * 512 + C.tid];
            const float va = __builtin_bit_cast(float, tl[(16 + a) * 512 + C.tid]), vb = __builtin_bit_cast(float, tl[(48 + b) * 512 + C.tid]);
            sums[k] = va + vb; ex[k] = i1 * 128 + i2; mx = fmaxf(mx, sums[k]);
        }
        float den = 0.f;
#pragma unroll
        for (int k = 0; k < 16; ++k) { sums[k] = expf(sums[k] - mx); den += sums[k]; }
        const float inv = 1.0f / den;
        v4i* pe = (v4i*)(((int*)(C.ws + WS_PE)) + (size_t)row * NPICK + h * 16); f32x4* pc = (f32x4*)(((float*)(C.ws + WS_PC)) + (size_t)row * NPICK + h * 16);
#pragma unroll
        for (int q = 0; q < 4; ++q) { v4i e4; e4.x = ex[4 * q]; e4.y = ex[4 * q + 1]; e4.z = ex[4 * q + 2]; e4.w = ex[4 * q + 3]; pe[q] = e4;
            f32x4 c4; c4.x = sums[4 * q] * inv; c4.y = sums[4 * q + 1] * inv; c4.z = sums[4 * q + 2] * inv; c4.w = sums[4 * q + 3] * inv; pc[q] = c4; }
    }
}

__device__ __forceinline__ int red16_add(int x) {
    x += __builtin_amdgcn_update_dpp(0, x, 0xB1, 0xf, 0xf, true);
    x += __builtin_amdgcn_update_dpp(0, x, 0x4E, 0xf, 0xf, true);
    x += __builtin_amdgcn_update_dpp(0, x, 0x141, 0xf, 0xf, true);
    x += __builtin_amdgcn_update_dpp(0, x, 0x140, 0xf, 0xf, true);
    return x;
}
__device__ __forceinline__ float red16_max(float x) {
    x = fmaxf(x, __builtin_bit_cast(float, __builtin_amdgcn_update_dpp(0, __builtin_bit_cast(int, x), 0xB1, 0xf, 0xf, true)));
    x = fmaxf(x, __builtin_bit_cast(float, __builtin_amdgcn_update_dpp(0, __builtin_bit_cast(int, x), 0x4E, 0xf, 0xf, true)));
    x = fmaxf(x, __builtin_bit_cast(float, __builtin_amdgcn_update_dpp(0, __builtin_bit_cast(int, x), 0x141, 0xf, 0xf, true)));
    x = fmaxf(x, __builtin_bit_cast(float, __builtin_amdgcn_update_dpp(0, __builtin_bit_cast(int, x), 0x140, 0xf, 0xf, true)));
    return x;
}
#define UB0(w) ((float)((w) & 0xffu))
#define UB1(w) ((float)(((w) >> 8) & 0xffu))
#define UB2(w) ((float)(((w) >> 16) & 0xffu))
#define UB3(w) ((float)((w) >> 24))
struct UBuf { v4u u[4]; };
struct VBuf { v4u v[4]; };
__device__ __forceinline__ void u_issue(UBuf& B, int k, int g, int i16, int e_lo, int e_hi, const unsigned char* UQ) {
    const int p = 4 * k + g;
    const int e = __builtin_amdgcn_ds_bpermute((p & 63) << 2, (k < 16) ? e_lo : e_hi);
    const unsigned char* ur = UQ + (size_t)e * DM + 16 * i16;
#pragma unroll
    for (int c = 0; c < 4; ++c) B.u[c] = *(const v4u*)(ur + 256 * c);
}
__device__ __forceinline__ void u_compute(const UBuf& B, int k, int i16, const int (&fq)[16], int& d_lo, int& d_hi) {
    int acc = 0;
#pragma unroll
    for (int c = 0; c < 4; ++c) {
        acc = __builtin_amdgcn_sdot4((int)B.u[c].x, fq[4 * c + 0], acc, false); acc = __builtin_amdgcn_sdot4((int)B.u[c].y, fq[4 * c + 1], acc, false);
        acc = __builtin_amdgcn_sdot4((int)B.u[c].z, fq[4 * c + 2], acc, false); acc = __builtin_amdgcn_sdot4((int)B.u[c].w, fq[4 * c + 3], acc, false);
    }
    acc = red16_add(acc);
    if (k < 16) d_lo = (i16 == (k & 15)) ? acc : d_lo; else d_hi = (i16 == (k & 15)) ? acc : d_hi;
}
__device__ __forceinline__ void v_issue(VBuf& B, int k, int lane, int e_lo, int e_hi, const unsigned char* VQ) {
    const int ev = (k < 16) ? e_lo : e_hi;
#pragma unroll
    for (int q = 0; q < 4; ++q) { const int eq = __builtin_amdgcn_readlane(ev, (4 * k + q) & 63); B.v[q] = *((const v4u*)(VQ + (size_t)eq * DM) + lane); }
}
__device__ __forceinline__ void v_compute(const VBuf& B, int k, int pk_lo, int pk_hi, int (&acc)[16]) {
    const int cq4 = __builtin_amdgcn_readlane((k < 16) ? pk_lo : pk_hi, (4 * k) & 63);
    const unsigned a[4] = {B.v[0].x, B.v[0].y, B.v[0].z, B.v[0].w}, b[4] = {B.v[1].x, B.v[1].y, B.v[1].z, B.v[1].w},
                   c[4] = {B.v[2].x, B.v[2].y, B.v[2].z, B.v[2].w}, d[4] = {B.v[3].x, B.v[3].y, B.v[3].z, B.v[3].w};
#pragma unroll
    for (int w = 0; w < 4; ++w) {
        const unsigned ab_lo = __builtin_amdgcn_perm(b[w], a[w], 0x05010400u), ab_hi = __builtin_amdgcn_perm(b[w], a[w], 0x07030602u);
        const unsigned cd_lo = __builtin_amdgcn_perm(d[w], c[w], 0x05010400u), cd_hi = __builtin_amdgcn_perm(d[w], c[w], 0x07030602u);
        const unsigned t0 = __builtin_amdgcn_perm(cd_lo, ab_lo, 0x05040100u), t1 = __builtin_amdgcn_perm(cd_lo, ab_lo, 0x07060302u);
        const unsigned t2 = __builtin_amdgcn_perm(cd_hi, ab_hi, 0x05040100u), t3 = __builtin_amdgcn_perm(cd_hi, ab_hi, 0x07060302u);
        acc[4 * w + 0] = __builtin_amdgcn_sdot4((int)t0, cq4, acc[4 * w + 0], false); acc[4 * w + 1] = __builtin_amdgcn_sdot4((int)t1, cq4, acc[4 * w + 1], false);
        acc[4 * w + 2] = __builtin_amdgcn_sdot4((int)t2, cq4, acc[4 * w + 2], false); acc[4 * w + 3] = __builtin_amdgcn_sdot4((int)t3, cq4, acc[4 * w + 3], false);
    }
}
__device__ __forceinline__ void phase_gather(const Ctx& C, int l, bf16* Zt, bool fuse_next, int row_lo) {
    const int gw = C.vcu * 8 + C.wave, NGW = C.G * 8;
    const unsigned char* UQ = C.ws + WS_UQ + (size_t)l * NEXP * DM; const unsigned char* VQ = C.ws + WS_VQ + (size_t)l * NEXP * DM;
    const float* US = (const float*)(C.ws + WS_US) + (size_t)l * NEXP; const float* VS = (const float*)(C.ws + WS_VS) + (size_t)l * NEXP;
    const int g = C.lane >> 4, i16 = C.lane & 15;
    const int nrows_all = NTOK - row_lo, nfull = nrows_all / NGW, nrem = nrows_all - nfull * NGW, xq = C.wave * C.G + C.bx;
    const int nmine = nfull + (xq < nrem ? 1 : 0);
#define G_CONV_ITERS ((2 * NEXP + 4 * NGW - 1) / (4 * NGW))
#define G_ROW(k) (((k) < nfull) ? (row_lo + (k) * NGW + gw) : (((k) < nmine) ? (row_lo + nfull * NGW + xq) : NTOK))
    v4u nfq[4]; float nfs = 0.f; int ne_lo = 0, ne_hi = 0; float nc_lo = 0.f, nc_hi = 0.f;
#define U_PREFETCH(r) do { if ((r) < NTOK) { const unsigned char* fq_ = C.ws + WS_FQ + (size_t)(r) * DM + 16 * i16; \
        _Pragma("unroll") for (int c = 0; c < 4; ++c) nfq[c] = *(const v4u*)(fq_ + 256 * c); nfs = ((const float*)(C.ws + WS_FS))[(r)]; \
        const int* pe_ = ((int*)(C.ws + WS_PE)) + (size_t)(r) * NPICK; const float* pc_ = ((float*)(C.ws + WS_PC)) + (size_t)(r) * NPICK; \
        ne_lo = pe_[C.lane]; ne_hi = pe_[64 + C.lane]; nc_lo = pc_[C.lane]; nc_hi = pc_[64 + C.lane]; } } while (0)
#ifdef PROBE_GSEL
    if (fuse_next || PROBE_GSEL == 1)
#endif
    U_PREFETCH(G_ROW(0));
#ifdef PROBE_GSEL
    if (fuse_next || PROBE_GSEL == 1)
#endif
    for (int kr = 0; kr < nmine; ++kr) {
        const int row = G_ROW(kr);
        int fq[16]; const float fs = nfs;
        const int e_lo = ne_lo, e_hi = ne_hi; const float c_lo = nc_lo, c_hi = nc_hi;
#pragma unroll
        for (int c = 0; c < 4; ++c) { fq[4 * c] = (int)nfq[c].x; fq[4 * c + 1] = (int)nfq[c].y; fq[4 * c + 2] = (int)nfq[c].z; fq[4 * c + 3] = (int)nfq[c].w; }
        U_PREFETCH(G_ROW(kr + 1));
        const int pp = 4 * i16 + g;
        const int ep_lo = __builtin_amdgcn_ds_bpermute(pp << 2, e_lo), ep_hi = __builtin_amdgcn_ds_bpermute(pp << 2, e_hi);
        const float cp_lo = __builtin_bit_cast(float, __builtin_amdgcn_ds_bpermute(pp << 2, __builtin_bit_cast(int, c_lo))), cp_hi = __builtin_bit_cast(float, __builtin_amdgcn_ds_bpermute(pp << 2, __builtin_bit_cast(int, c_hi)));
        const float us_lo = US[ep_lo], us_hi = US[ep_hi], vs_lo = VS[ep_lo], vs_hi = VS[ep_hi];
        int d_lo = 0, d_hi = 0;
        UBuf A, B;
        u_issue(A, 0, g, i16, e_lo, e_hi, UQ);
#pragma unroll 1
        for (int k = 0; k < 32; k += 2) {
            u_issue(B, k + 1, g, i16, e_lo, e_hi, UQ);
            u_compute(A, k, i16, fq, d_lo, d_hi);
            if (k + 2 < 32) u_issue(A, k + 2, g, i16, e_lo, e_hi, UQ);
            u_compute(B, k + 1, i16, fq, d_lo, d_hi);
        }
        float* cor = ((float*)(C.ws + WS_CO)) + (size_t)row * NPICK;
        cor[pp] = gelu_t((float)d_lo * (fs * us_lo)) * (cp_lo * vs_lo);
        cor[64 + pp] = gelu_t((float)d_hi * (fs * us_hi)) * (cp_hi * vs_hi);
    }
#define V_PREFETCH(r) do { if ((r) < NTOK) { const int* pe_ = ((int*)(C.ws + WS_PE)) + (size_t)(r) * NPICK; const float* co_ = ((float*)(C.ws + WS_CO)) + (size_t)(r) * NPICK; \
        ne_lo = pe_[C.lane]; ne_hi = pe_[64 + C.lane]; nc_lo = co_[C.lane]; nc_hi = co_[64 + C.lane]; } } while (0)
    V_PREFETCH(G_ROW(0));
#ifdef PROBE_GSEL
    if (fuse_next || PROBE_GSEL == 2)
#endif
    for (int kr = 0; kr < nmine; ++kr) {
        const int row = G_ROW(kr);
        const int e_lo = ne_lo, e_hi = ne_hi;
        const float co_lo = nc_lo, co_hi = nc_hi;
        V_PREFETCH(G_ROW(kr + 1));
        if (fuse_next && l < DEPTH - 1 && !(kr & 1)) convert_tables(C, l + 1, kr >> 1, (kr >> 1) + 1);
        float cs; int pk_lo, pk_hi;
        {
            float am = fmaxf(fabsf(co_lo), fabsf(co_hi));
            am = fmaxf(am, DPPF(am, 0xB1)); am = fmaxf(am, DPPF(am, 0x4E)); am = fmaxf(am, DPPF(am, 0x141)); am = fmaxf(am, DPPF(am, 0x140));
            { const int iv = __builtin_bit_cast(int, am);
              am = fmaxf(fmaxf(__builtin_bit_cast(float, __builtin_amdgcn_readlane(iv, 0)), __builtin_bit_cast(float, __builtin_amdgcn_readlane(iv, 16))),
                         fmaxf(__builtin_bit_cast(float, __builtin_amdgcn_readlane(iv, 32)), __builtin_bit_cast(float, __builtin_amdgcn_readlane(iv, 48)))); }
            const float inv = am > 0.f ? 127.0f / am : 0.f; cs = am * (1.0f / 127.0f);
            const int sh = 8 * (C.lane & 3);
            int yl = (((int)rintf(co_lo * inv)) & 255) << sh, yh = (((int)rintf(co_hi * inv)) & 255) << sh;
            yl |= __builtin_amdgcn_update_dpp(0, yl, 0xB1, 0xf, 0xf, true); yl |= __builtin_amdgcn_update_dpp(0, yl, 0x4E, 0xf, 0xf, true);
            yh |= __builtin_amdgcn_update_dpp(0, yh, 0xB1, 0xf, 0xf, true); yh |= __builtin_amdgcn_update_dpp(0, yh, 0x4E, 0xf, 0xf, true);
            pk_lo = yl; pk_hi = yh;
        }
        int acc[16];
#pragma unroll
        for (int i = 0; i < 16; ++i) acc[i] = 0;
        const int mr = (row < NCTX) ? 4 : ((row - NCTX) >> 12);
        v4u* zp = (v4u*)(Zt + (size_t)row * DM) + 2 * C.lane;
        f32x4 zold[4], g2v[4], gpv[4], shv[4], scv[4], ppv[4];
        {
            const f32x4* g2 = (const f32x4*)(((float*)(C.ws + WS_MOD)) + ((size_t)(l * 5 + mr) * 6 + 5) * DM) + 4 * C.lane;
#pragma unroll
            for (int q = 0; q < 4; ++q) g2v[q] = g2[q];
            { const v4u za = zp[0], zb = zp[1];
              zold[0] = (f32x4){bflo(za.x), bfhi(za.x), bflo(za.y), bfhi(za.y)}; zold[1] = (f32x4){bflo(za.z), bfhi(za.z), bflo(za.w), bfhi(za.w)};
              zold[2] = (f32x4){bflo(zb.x), bfhi(zb.x), bflo(zb.y), bfhi(zb.y)}; zold[3] = (f32x4){bflo(zb.z), bfhi(zb.z), bflo(zb.w), bfhi(zb.w)}; }
            if (fuse_next) {
                if (l < DEPTH - 1) {
                    const int l1 = l + 1;
                    const f32x4* gp = (const f32x4*)(IN_(C, 6) + (size_t)l1 * DM) + 4 * C.lane;
                    const float* mb = ((float*)(C.ws + WS_MOD)) + ((size_t)(l1 * 5 + mr) * 6) * DM;
                    const f32x4* shp = (const f32x4*)mb + 4 * C.lane; const f32x4* scp = (const f32x4*)(mb + DM) + 4 * C.lane;
                    const int t = (row - NCTX) & 4095, seg = C.lane >> 4, p = (seg < 2) ? (t >> 6) : (t & 63);
                    const f32x4* pp = (const f32x4*)(((float*)(C.ws + WS_POS)) + (size_t)p * 512 + (seg & 1) * 256 + 16 * (C.lane & 15));
#pragma unroll
                    for (int q = 0; q < 4; ++q) { gpv[q] = gp[q]; shv[q] = shp[q]; scv[q] = scp[q]; ppv[q] = pp[q]; }
                } else {
                    const f32x4* gp = (const f32x4*)IN_(C, 28) + 4 * C.lane;
#pragma unroll
                    for (int q = 0; q < 4; ++q) gpv[q] = gp[q];
                }
            }
        }
        VBuf A, B;
        v_issue(A, 0, C.lane, e_lo, e_hi, VQ);
#pragma unroll 1
        for (int k = 0; k < 32; k += 2) {
            v_issue(B, k + 1, C.lane, e_lo, e_hi, VQ);
            v_compute(A, k, pk_lo, pk_hi, acc);
            if (k + 2 < 32) v_issue(A, k + 2, C.lane, e_lo, e_hi, VQ);
            v_compute(B, k + 1, pk_lo, pk_hi, acc);
        }
        float out[16];
#pragma unroll
        for (int i = 0; i < 16; ++i) out[i] = (float)acc[i] * cs;
        f32x4 zn[4]; float ss = 0.f;
#pragma unroll
        for (int q = 0; q < 4; ++q) { const f32x4 gg = g2v[q]; f32x4 z = zold[q];
            z.x += gg.x * out[4 * q]; z.y += gg.y * out[4 * q + 1]; z.z += gg.z * out[4 * q + 2]; z.w += gg.w * out[4 * q + 3];
            zn[q] = z; ss += (z.x * z.x + z.y * z.y) + (z.z * z.z + z.w * z.w); }
        if (l < DEPTH - 1 || !fuse_next) {
            v4u za, zb; za.x = pk2(zn[0].x, zn[0].y); za.y = pk2(zn[0].z, zn[0].w); za.z = pk2(zn[1].x, zn[1].y); za.w = pk2(zn[1].z, zn[1].w);
            zb.x = pk2(zn[2].x, zn[2].y); zb.y = pk2(zn[2].z, zn[2].w); zb.z = pk2(zn[3].x, zn[3].y); zb.w = pk2(zn[3].z, zn[3].w);
            zp[0] = za; zp[1] = zb;
        }
        if (fuse_next) {
            const float rs = __builtin_amdgcn_rsqf(wave_sum(ss) * (1.0f / DM) + EPS);
            if (l < DEPTH - 1) {
                unsigned w[8];
#pragma unroll
                for (int q = 0; q < 4; ++q) {
                    f32x4 o = (zn[q] * rs * gpv[q]) * (scv[q] + 1.0f) + shv[q];
                    if (row >= NCTX) o = o + ppv[q];
                    w[2 * q] = pk2(o.x, o.y); w[2 * q + 1] = pk2(o.z, o.w);
                }
                v4u* op = (v4u*)(((bf16*)(C.ws + WS_XN)) + (size_t)row * DM) + 2 * C.lane;
                v4u w0; w0.x = w[0]; w0.y = w[1]; w0.z = w[2]; w0.w = w[3]; v4u w1; w1.x = w[4]; w1.y = w[5]; w1.z = w[6]; w1.w = w[7];
                op[0] = w0; op[1] = w1;
            } else if (row >= NCTX) {
                f32x4* op = (f32x4*)(C.out + (size_t)(row - NCTX) * DM) + 4 * C.lane;
#pragma unroll
                for (int q = 0; q < 4; ++q) op[q] = zn[q] * rs * gpv[q];
            }
        }
    }
    if (fuse_next && l < DEPTH - 1) convert_tables(C, l + 1, (nmine + 1) >> 1, 64);
}

struct CtxEpiP { bf16* P; __device__ __forceinline__ void operator()(const f32x4 (&acc)[2][2], int m0, int n0, int fr, int fq) const {
#pragma unroll
    for (int mt = 0; mt < 2; ++mt)
#pragma unroll
        for (int nt = 0; nt < 2; ++nt) { const f32x4 v = acc[mt][nt]; v2u w; w.x = pk2(v[0], v[1]); w.y = pk2(v[2], v[3]);
            *(v2u*)(P + (size_t)(m0 + 16 * mt + fr) * PROJ + n0 + 16 * nt + 4 * fq) = w; } } };
struct CtxEpiResid { bf16* Z; const float* gate; __device__ __forceinline__ void operator()(const f32x4 (&acc)[2][2], int m0, int n0, int fr, int fq) const {
    v2u zv[2][2];
#pragma unroll
    for (int mt = 0; mt < 2; ++mt)
#pragma unroll
        for (int nt = 0; nt < 2; ++nt) zv[mt][nt] = *(const v2u*)(Z + (size_t)(m0 + 16 * mt + fr) * DM + n0 + 16 * nt + 4 * fq);
#pragma unroll
    for (int mt = 0; mt < 2; ++mt)
#pragma unroll
        for (int nt = 0; nt < 2; ++nt) { const f32x4 g = *(const f32x4*)(gate + n0 + 16 * nt + 4 * fq); const v2u z = zv[mt][nt]; const f32x4 a = g * acc[mt][nt];
            v2u w; w.x = pk2(bflo(z.x) + a[0], bfhi(z.x) + a[1]); w.y = pk2(bflo(z.y) + a[2], bfhi(z.y) + a[3]);
            *(v2u*)(Z + (size_t)(m0 + 16 * mt + fr) * DM + n0 + 16 * nt + 4 * fq) = w; } } };
struct CtxEpiScoreT { unsigned* S; __device__ __forceinline__ void operator()(const f32x4 (&acc)[2][2], int m0, int n0, int fr, int fq) const {
#pragma unroll
    for (int mt = 0; mt < 2; ++mt)
#pragma unroll
        for (int nt = 0; nt < 2; ++nt) { const int row = m0 + 16 * mt + fr, col = n0 + 16 * nt + 4 * fq, head = col >> 8, cn = col & 255; const f32x4 v = acc[mt][nt];
            unsigned* bp = S + ((size_t)((row >> 6) * 8 + head) * 256 + cn) * 64 + (row & 63);
            bp[0] = pg8::score_key(v[0], cn); bp[64] = pg8::score_key(v[1], cn + 1); bp[128] = pg8::score_key(v[2], cn + 2); bp[192] = pg8::score_key(v[3], cn + 3); } } };

template <class Epi>
__device__ __forceinline__ void ctx_gemm(const Ctx& C, const bf16* A, const bf16* Bt, int M, int N, const Epi& E) {
    constexpr int AST = 1032;
    LAS bf16* As = (LAS bf16*)C.lds;
    const int ntn = N >> 8, ntiles = (M >> 5) * ntn, fr = C.lane & 15, fq = C.lane >> 4;
    for (int t = C.bx; t < ntiles; t += C.G) {
        const int tm = t / ntn, tn = t - tm * ntn, m0 = tm * 32, n0 = tn * 256 + 32 * C.wave;
        const bf16* bp = Bt + (size_t)(n0 + fr) * 1024 + 8 * fq;
        bf16x8 B0[8][2], B1[8][2];
#define CG_LOAD(BUF, ch) do { _Pragma("unroll") for (int ks = 0; ks < 8; ++ks) _Pragma("unroll") for (int nt = 0; nt < 2; ++nt) \
            BUF[ks][nt] = *(const bf16x8*)(bp + (size_t)(16 * nt) * 1024 + 32 * (8 * (ch) + ks)); } while (0)
#define CG_COMP(BUF, ch) do { _Pragma("unroll") for (int ks = 0; ks < 8; ++ks) { const LAS bf16* ap = As + fr * AST + 32 * (8 * (ch) + ks) + 8 * fq; \
            const bf16x8 a0 = *(const LAS bf16x8*)ap, a1 = *(const LAS bf16x8*)(ap + 16 * AST); \
            _Pragma("unroll") for (int nt = 0; nt < 2; ++nt) { acc[0][nt] = MFMA16(BUF[ks][nt], a0, acc[0][nt]); acc[1][nt] = MFMA16(BUF[ks][nt], a1, acc[1][nt]); } } } while (0)
        CG_LOAD(B0, 0);
        {
            v4u tmp[8];
#pragma unroll
            for (int q = 0; q < 8; ++q) { const int idx = C.tid + 512 * q, r = idx >> 7, c8 = (idx & 127) * 8; tmp[q] = *(const v4u*)(A + (size_t)(m0 + r) * 1024 + c8); }
#pragma unroll
            for (int q = 0; q < 8; ++q) { const int idx = C.tid + 512 * q, r = idx >> 7, c8 = (idx & 127) * 8; *(LAS v4u*)(As + r * AST + c8) = tmp[q]; }
        }
        __syncthreads();
        f32x4 acc[2][2];
#pragma unroll
        for (int mt = 0; mt < 2; ++mt)
#pragma unroll
            for (int nt = 0; nt < 2; ++nt) acc[mt][nt] = (f32x4){0.f, 0.f, 0.f, 0.f};
        CG_LOAD(B1, 1); CG_COMP(B0, 0);
        CG_LOAD(B0, 2); CG_COMP(B1, 1);
        CG_LOAD(B1, 3); CG_COMP(B0, 2);
        CG_COMP(B1, 3);
#undef CG_LOAD
#undef CG_COMP
        E(acc, m0, n0, fr, fq);
        __syncthreads();
    }
}

#ifndef PROBE_PHASE
#define PROBE_PHASE -1
#define PROBE_REP 0
#endif
#ifndef PGA
#define PGA true
#endif
#ifndef PGS
#define PGS true
#endif
#ifndef PROBE_P0MASK
#define PROBE_P0MASK 15
#endif
#ifndef PROBE_MIXSEL
#define PROBE_MIXSEL 0
#endif
struct Args { const float* in[29]; float* out; unsigned char* ws; int ph_lo, ph_hi; };
__global__ void __launch_bounds__(512, 2) mk_fwd(Args args) {
    extern __shared__ __attribute__((aligned(16))) unsigned char lds_raw[];
    {
        LAS unsigned char* l0 = (LAS unsigned char*)lds_raw;
        for (int u = threadIdx.x; u < (LDS_BYTES - LDSCTL_OFF) / 4; u += 512) ((LAS unsigned*)(l0 + LDSCTL_OFF))[u] = 0u;
        __syncthreads();
    }
    const int lo = args.ph_lo, hi = args.ph_hi;
    XcdBarrier bar; bar.bar = (unsigned*)(args.ws + WS_CTL) + CW_BAR; bar.x = 0; bar.st = nullptr;
    if (hi - lo > 1) bar = xcd_barrier_post((unsigned*)(args.ws + WS_CTL) + CW_BAR, (volatile LAS unsigned*)((LAS unsigned char*)lds_raw + MISC_OFF) + 8);

#if PROBE_REP > 0
    int ph = lo, rep = 0;
#else
    int ph = lo; constexpr int rep = 0;
#endif
    while (ph < hi) {
        int tid = threadIdx.x; asm volatile("" : "+v"(tid));
        int bx = blockIdx.x; asm volatile("" : "+s"(bx));
        const AS4 unsigned char* kp = (const AS4 unsigned char*)__builtin_amdgcn_kernarg_segment_ptr(); asm volatile("" : "+s"(kp));
        Ctx C;
        unsigned ldsoff = 0; asm volatile("" : "+s"(ldsoff));
        C.lds = (LAS unsigned char*)lds_raw + ldsoff;
        C.tid = tid; C.lane = tid & 63; C.wave = __builtin_amdgcn_readfirstlane(tid >> 6);
        C.G = gridDim.x; C.bx = bx; C.vcu = (C.G % 8 == 0) ? (bx % 8) * (C.G / 8) + bx / 8 : bx;
        C.kp = kp; C.out = *(float* const AS4*)(kp + 232); C.ws = *(unsigned char* const AS4*)(kp + 240);
        if (ph == 0) { const int m1 = (C.bx & 1) ? 12 : 3; phase_p0a(C, m1); phase_p0a(C, 15 ^ m1); if (PROBE_PHASE == 100) { xcd_barrier(bar); phase_p0a(C, PROBE_P0MASK & m1); phase_p0a(C, PROBE_P0MASK & (15 ^ m1)); } }
        else if (ph == 1) { phase_p0b(C); if (PROBE_PHASE == 200) { for (int q = 0; q < 32; ++q) xcd_barrier(bar); } }
        else if (ph == 2) phase_rows<0>(C, 0, 0);
        else {
            const int l = (ph - 3) / 11, st = (ph - 3) % 11;
            const int s = (st < 2) ? 1 : (st < 4) ? st : (st < 6) ? 4 : (st == 6) ? 5 : (st < 9) ? 6 : st - 2;
            const bool tail = (st == 1 || st == 5 || st == 8);
            bf16* Zt = (rep > 0) ? (bf16*)(C.ws + WS_SC) : (bf16*)(C.ws + WS_Z);
            if (s == 1 && !tail) { pg8::Gemm g{((bf16*)(C.ws + WS_XN)) + (size_t)NCTX * DM, ((bf16*)(C.ws + WS_WIN)) + (size_t)l * 2048 * 1024, NLAT, 2048, 1024}; pg8::StaticOrder S; S.init(NLAT, 2048, C.G, C.bx);
                pg8::EpiBf16 E{((bf16*)(C.ws + WS_P)) + (size_t)NCTX * PROJ, PROJ}; pg8::gemm_phase<pg8::EpiBf16, pg8::StaticOrder, PGA, PGS>(C.lds, g, S, E, C.tid); }
            else if (s == 1) {
                CtxEpiP EC{(bf16*)(C.ws + WS_P)}; ctx_gemm(C, (const bf16*)(C.ws + WS_XN), ((const bf16*)(C.ws + WS_WIN)) + (size_t)l * 2048 * 1024, NCTX, (l == DEPTH - 1) ? 256 : 2048, EC); }
            else if (s == 2) phase_mixers(C, l, rep > 0 ? PROBE_MIXSEL : 0);
            else if (s == 3) phase_fixup(C, l);
            else if (s == 4 && !tail) { const int r0 = NCTX;
                pg8::Gemm g{((bf16*)(C.ws + WS_Y)) + (size_t)r0 * DM, ((bf16*)(C.ws + WS_WOUT)) + (size_t)l * 1024 * 1024, NTOK - r0, 1024, 1024}; pg8::StaticOrder S; S.init(NTOK - r0, 1024, C.G, C.bx);
                pg8::EpiResid E{Zt + (size_t)r0 * DM, DM, ((float*)(C.ws + WS_MOD)) + ((size_t)(l * 5) * 6 + 2) * DM, 6 * DM, r0 / 256}; pg8::gemm_phase<pg8::EpiResid, pg8::StaticOrder, PGA, PGS>(C.lds, g, S, E, C.tid); }
            else if (s == 4) { if (l < DEPTH - 1) { CtxEpiResid EC{Zt, ((float*)(C.ws + WS_MOD)) + ((size_t)(l * 5 + 4) * 6 + 2) * DM}; ctx_gemm(C, (const bf16*)(C.ws + WS_Y), ((const bf16*)(C.ws + WS_WOUT)) + (size_t)l * 1024 * 1024, NCTX, 1024, EC); } }
            else if (s == 5) phase_rows<1>(C, l, (l == DEPTH - 1) ? NCTX : 0);
            else if (s == 6 && !tail) { const int r0 = NCTX;
                pg8::Gemm g{((bf16*)(C.ws + WS_XN)) + (size_t)r0 * DM, ((bf16*)(C.ws + WS_WCMB)) + (size_t)l * 2048 * 1024, NTOK - r0, 2048, 1024}; pg8::StaticOrder S; S.init(NTOK - r0, 2048, C.G, C.bx);
                pg8::EpiScoreT E{((unsigned*)(C.ws + WS_SC)), r0}; pg8::gemm_phase<pg8::EpiScoreT, pg8::StaticOrder, PGA, PGS>(C.lds, g, S, E, C.tid); }
            else if (s == 6) { if (l < DEPTH - 1) { CtxEpiScoreT EC{(unsigned*)(C.ws + WS_SC)}; ctx_gemm(C, (const bf16*)(C.ws + WS_XN), ((const bf16*)(C.ws + WS_WCMB)) + (size_t)l * 2048 * 1024, NCTX, 2048, EC); } }
            else if (s == 7) phase_topk(C, (l == DEPTH - 1) ? NCTX : 0);
            else phase_gather(C, l, Zt, rep == 0, (l == DEPTH - 1) ? NCTX : 0);
        }
        bool need_bar = true;
#if PROBE_REP > 0
        { const int st_ = (ph >= 3) ? (ph - 3) % 11 : -1;
          const int s_ = (st_ < 0) ? -1 : (st_ < 2) ? 1 : (st_ < 4) ? st_ : (st_ < 6) ? 4 : (st_ == 6) ? 5 : (st_ < 9) ? 6 : st_ - 2;
          const bool main_gemm = (st_ == 0 || st_ == 4 || st_ == 7);
          if (PROBE_PHASE == 11 && st_ == 1 && rep < PROBE_REP) ++rep;
          else if (PROBE_PHASE == 11) { ++ph; rep = 0; if (main_gemm) need_bar = false; }
          else if (s_ == PROBE_PHASE && rep < PROBE_REP && !main_gemm && st_ != 1 && st_ != 5 && st_ != 8) ++rep;
          else if (s_ == PROBE_PHASE && rep < PROBE_REP && (st_ == 1 || st_ == 5 || st_ == 8)) { ++rep; --ph; }
          else { ++ph; rep = (main_gemm ? rep : 0); if (main_gemm) need_bar = false; } }
#else
        { const int st_ = (ph >= 3) ? (ph - 3) % 11 : -1; need_bar = !(st_ == 0 || st_ == 4 || st_ == 7); ++ph; }
#endif
        if (ph < hi && need_bar) xcd_barrier(bar);
    }
}

extern "C" void kernel_launch(void* const* d_in, const int* in_sizes, int n_in, void* d_out, int out_size, void* d_ws, size_t ws_size, hipStream_t stream) {
    static int grid = 0;
    if (grid == 0) {
        if (n_in != 29 || out_size != NLAT * DM || ws_size < WS_END) { fprintf(stderr, "kernel_launch: unexpected shapes (n_in %d, out %d, ws %zu)\n", n_in, out_size, ws_size); grid = -1; return; }
        int dev = 0, cus = 0, per_cu = 0;
        if (hipGetDevice(&dev) != hipSuccess || hipDeviceGetAttribute(&cus, hipDeviceAttributeMultiprocessorCount, dev) != hipSuccess) { grid = -1; return; }
        if (hipFuncSetAttribute((const void*)mk_fwd, hipFuncAttributeMaxDynamicSharedMemorySize, LDS_BYTES) != hipSuccess) { fprintf(stderr, "kernel_launch: hipFuncSetAttribute failed\n"); grid = -1; return; }
        if (hipOccupancyMaxActiveBlocksPerMultiprocessor(&per_cu, (const void*)mk_fwd, 512, LDS_BYTES) != hipSuccess || per_cu < 1) { fprintf(stderr, "kernel_launch: occupancy query says %d blocks per CU\n", per_cu); (void)hipGetLastError(); grid = -1; return; }
        grid = cus;
    }
    if (grid < 0) return;
    if (hipMemsetAsync((char*)d_ws + WS_CTL, 0, CTL_ZERO_BYTES, stream) != hipSuccess) return;
    Args a{};
    for (int i = 0; i < 29; ++i) a.in[i] = (const float*)d_in[i];
    a.out = (float*)d_out; a.ws = (unsigned char*)d_ws;
#if MK_SINGLE
    a.ph_lo = 0; a.ph_hi = NPH;
    void* kargs[] = {&a};
    hipError_t le = hipLaunchCooperativeKernel((const void*)mk_fwd, dim3(grid), dim3(512), kargs, LDS_BYTES, stream);
    if (le != hipSuccess) fprintf(stderr, "kernel_launch: cooperative launch failed: %s (grid %d)\n", hipGetErrorName(le), grid);
#else
    for (int ph = 0; ph < NPH; ++ph) {
        a.ph_lo = ph; a.ph_hi = ph + 1;
        hipLaunchKernelGGL(mk_fwd, dim3(grid), dim3(512), LDS_BYTES, stream, a);
    }
#endif
}
```

```cpp
#include <hip/hip_runtime.h>
#include <cstdio>
#include <cstdint>

#ifndef MK_SINGLE
#define MK_SINGLE 1
#endif

namespace pg8 {
#define PG8_LAS __attribute__((address_space(3)))
typedef unsigned short bf16_t;
typedef short bf16x8 __attribute__((ext_vector_type(8)));
typedef float f32x4 __attribute__((ext_vector_type(4)));
typedef unsigned u32x4 __attribute__((ext_vector_type(4)));
constexpr int BM = 256, BK = 64, HALF = 128, HTB = HALF * BK * 2  , STAGE_BYTES = 8 * HTB, NXCD = 8, WGM = 8;

__host__ __device__ __forceinline__ int lds_byte(int r, int c) { const int st = (r >> 4) * 2 + (c >> 5), rr = r & 15, cc = c & 31, ob = rr * 64 + cc * 2; return st * 1024 + (ob ^ (((ob >> 9) & 1) << 5)); }
__host__ __device__ __forceinline__ void stage_rc(int b, int& R, int& C) { const int st = b / 1024, sb = b % 1024, swz = sb ^ (((sb >> 9) & 1) << 5); R = (st >> 1) * 16 + swz / 64; C = (st & 1) * 32 + (swz % 64) / 2; }
__host__ __device__ __forceinline__ int perm32(int rho) { const int n = rho >> 4, i = rho & 15; return 8 * (i >> 2) + 4 * n + (i & 3); }

struct Unit { int pm, pn; };
struct Gemm { const bf16_t* A; const bf16_t* Bt; int M, N, K; };

struct StaticOrder {
    int nM, nN, nwg, G, c;
    __host__ __device__ void init(int M, int N, int G_, int c_) { nM = M / BM; nN = N / BM; nwg = nM * nN; G = G_; c = c_; }
    __host__ __device__ bool next(int i, Unit& u) const {
        const long L = (long)i * G + c; if (L >= nwg) return false;
        int wgid = (int)L; { const int q = nwg / NXCD, r = nwg % NXCD, xcd = wgid % NXCD, off = wgid / NXCD; wgid = (xcd < r ? xcd * (q + 1) : r * (q + 1) + (xcd - r) * q) + off; }
        const int nig = WGM * nN, gid = wgid / nig, fm = gid * WGM, gsz = (nM - fm) < WGM ? (nM - fm) : WGM;
        u.pm = fm + ((wgid % nig) % gsz); u.pn = (wgid % nig) / gsz; return true;
    }
    __device__ __forceinline__ void a_ready(const Unit&) const {}
    __device__ __forceinline__ void done(const Unit&) const {}
};

__device__ __forceinline__ unsigned cvt_pk_bf16(float lo, float hi) { unsigned r; asm volatile("v_cvt_pk_bf16_f32 %0, %1, %2" : "=v"(r) : "v"(lo), "v"(hi)); return r; }

struct EpiBf16 {
    static constexpr bool PERM = true, AFTER_DRAIN = false;
    bf16_t* O; int ldc;
    __device__ __forceinline__ void operator()(const f32x4 (&acc)[2][2][4][2], const Unit& u, int wr, int wc, int fr, int fq) const {
        const int row0 = u.pm * BM + wr * 64 + fr; const int col0 = u.pn * BM + wc * 32 + 8 * fq;
#pragma unroll
        for (int ai = 0; ai < 2; ++ai)
#pragma unroll
            for (int m = 0; m < 4; ++m) { bf16_t* rowp = O + (size_t)(row0 + ai * HALF + m * 16) * ldc + col0;
#pragma unroll
                for (int bj = 0; bj < 2; ++bj) { const f32x4 v0 = acc[ai][bj][m][0], v1 = acc[ai][bj][m][1];
                    u32x4 w; w.x = cvt_pk_bf16(v0[0], v0[1]); w.y = cvt_pk_bf16(v0[2], v0[3]); w.z = cvt_pk_bf16(v1[0], v1[1]); w.w = cvt_pk_bf16(v1[2], v1[3]);
                    *(u32x4*)(rowp + bj * HALF) = w; } }
    }
};
struct EpiF32 {
    static constexpr bool PERM = false, AFTER_DRAIN = false;
    float* C; int ldc;
    __device__ __forceinline__ void operator()(const f32x4 (&acc)[2][2][4][2], const Unit& u, int wr, int wc, int fr, int fq) const {
        const int row0 = u.pm * BM + wr * 64 + fr, col0 = u.pn * BM + wc * 32 + 4 * fq;
#pragma unroll
        for (int ai = 0; ai < 2; ++ai)
#pragma unroll
            for (int m = 0; m < 4; ++m) { float* rowp = C + (size_t)(row0 + ai * HALF + m * 16) * ldc + col0;
#pragma unroll
                for (int bj = 0; bj < 2; ++bj)
#pragma unroll
                    for (int n = 0; n < 2; ++n) *(f32x4*)(rowp + bj * HALF + n * 16) = acc[ai][bj][m][n]; }
    }
};
struct EpiResid {
    static constexpr bool PERM = true, AFTER_DRAIN = false;
    unsigned short* Z; int ldc; const float* gate0; int gstride; int pmoff;
    __device__ __forceinline__ void operator()(const f32x4 (&acc)[2][2][4][2], const Unit& u, int wr, int wc, int fr, int fq) const {
        const int row0 = u.pm * BM + wr * 64 + fr, col0 = u.pn * BM + wc * 32 + 8 * fq;
        const int pmg = u.pm + pmoff; const int mr = (pmg < 4) ? 4 : ((pmg - 4) >> 4);
        const float* gp = gate0 + (size_t)mr * gstride + col0;
        f32x4 gv[2][2];
#pragma unroll
        for (int bj = 0; bj < 2; ++bj)
#pragma unroll
            for (int n = 0; n < 2; ++n) gv[bj][n] = *(const f32x4*)(gp + bj * HALF + n * 4);
#pragma unroll
        for (int ai = 0; ai < 2; ++ai) {
            u32x4 zv[4][2];
#pragma unroll
            for (int m = 0; m < 4; ++m)
#pragma unroll
                for (int bj = 0; bj < 2; ++bj) zv[m][bj] = *(const u32x4*)(Z + (size_t)(row0 + ai * HALF + m * 16) * ldc + col0 + bj * HALF);
#pragma unroll
            for (int m = 0; m < 4; ++m)
#pragma unroll
                for (int bj = 0; bj < 2; ++bj) { const u32x4 z = zv[m][bj]; const f32x4 a0 = acc[ai][bj][m][0] * gv[bj][0], a1 = acc[ai][bj][m][1] * gv[bj][1];
                    u32x4 w;
                    w.x = cvt_pk_bf16(__builtin_bit_cast(float, z.x << 16) + a0[0], __builtin_bit_cast(float, z.x & 0xffff0000u) + a0[1]);
                    w.y = cvt_pk_bf16(__builtin_bit_cast(float, z.y << 16) + a0[2], __builtin_bit_cast(float, z.y & 0xffff0000u) + a0[3]);
                    w.z = cvt_pk_bf16(__builtin_bit_cast(float, z.z << 16) + a1[0], __builtin_bit_cast(float, z.z & 0xffff0000u) + a1[1]);
                    w.w = cvt_pk_bf16(__builtin_bit_cast(float, z.w << 16) + a1[2], __builtin_bit_cast(float, z.w & 0xffff0000u) + a1[3]);
                    *(u32x4*)(Z + (size_t)(row0 + ai * HALF + m * 16) * ldc + col0 + bj * HALF) = w; }
        }
    }
};

__device__ __forceinline__ unsigned score_key(float x, int n) { const int u = __builtin_bit_cast(int, x); return ((unsigned)(u ^ ((u >> 31) | (int)0x80000000)) & ~127u) | (unsigned)(127 - (n & 127)); }
struct EpiScoreT {
    static constexpr bool PERM = false, AFTER_DRAIN = false;
    unsigned* S; int row_base;
    __device__ __forceinline__ void operator()(const f32x4 (&acc)[2][2][4][2], const Unit& u, int wr, int wc, int fr, int fq) const {
        int cn0 = wc * 32 + 4 * fq; asm volatile("" : "+v"(cn0));
        const int row0 = row_base + u.pm * BM + wr * 64 + fr, head = u.pn;
        const unsigned ib = (unsigned)(127 - cn0);
#pragma unroll
        for (int ai = 0; ai < 2; ++ai)
#pragma unroll
            for (int m = 0; m < 4; ++m) { const int row = row0 + ai * HALF + m * 16;
                unsigned* bp = S + ((size_t)((row >> 6) * 8 + head) * 256) * 64 + (row & 63) + (size_t)cn0 * 64;
#pragma unroll
                for (int bj = 0; bj < 2; ++bj)
#pragma unroll
                    for (int n = 0; n < 2; ++n) { const f32x4 v = acc[ai][bj][m][n]; unsigned* q = bp + (size_t)(bj * HALF + n * 16) * 64;
#pragma unroll
                        for (int e2 = 0; e2 < 4; ++e2) q[e2 * 64] = score_key(v[e2], cn0 + bj * HALF + n * 16 + e2); }
                asm volatile("" ::: "memory"); }
    }
};

template <class Epi, class Sched, bool ALIGN_EPI = false, bool SP2 = false>
__device__ __forceinline__ void gemm_phase(PG8_LAS unsigned char* lds, const Gemm g, const Sched& S, const Epi& E, const int tid) {
    const int wid = __builtin_amdgcn_readfirstlane(tid >> 6), lane = tid & 63, wr = wid >> 2, wc = wid & 3, fr = lane & 15, fq = lane >> 4;
    const int K = g.K, nt = K / BK;
    unsigned voffA[2], voffB[2];
#pragma unroll
    for (int i = 0; i < 2; ++i) { int R, C; stage_rc(tid * 16 + i * 8192, R, C); const int Rb = Epi::PERM ? ((R & ~31) + perm32(R & 31)) : R;
        voffA[i] = (unsigned)(R * K + C) * 2u; voffB[i] = (unsigned)(Rb * K + C) * 2u; }
    const size_t kstep = (size_t)(BK * 2);
    const size_t hstep = (size_t)HALF * K * 2;
    const size_t tstep = 2 * hstep;
    const unsigned ldsw = (unsigned)wid * 1024u;
    const int aoff = lds_byte(wr * 64 + fr, fq * 8), boff = lds_byte(wc * 32 + fr, fq * 8);
#define PG8_SA(b, h) (((b) * 2 + (h)) * HTB)
#define PG8_SB(b, h) ((4 + (b) * 2 + (h)) * HTB)
#define PG8_STAGE(bufoff, gbase, voff) do { _Pragma("unroll") for (int _i = 0; _i < 2; ++_i) \
        __builtin_amdgcn_global_load_lds((const unsigned*)((const char*)(gbase) + (voff)[_i]), (PG8_LAS unsigned*)(lds + (bufoff) + ldsw + _i * 8192), 16, 0, 0); } while (0)
#define PG8_LDA(dst, b, h) do { _Pragma("unroll") for (int m = 0; m < 4; ++m) _Pragma("unroll") for (int k = 0; k < 2; ++k) dst[m][k] = *(const PG8_LAS bf16x8*)(lds + PG8_SA(b, h) + aoff + m * 2048 + k * 1024); } while (0)
#define PG8_LDB(dst, b, h) do { _Pragma("unroll") for (int n = 0; n < 2; ++n) _Pragma("unroll") for (int k = 0; k < 2; ++k) dst[n][k] = *(const PG8_LAS bf16x8*)(lds + PG8_SB(b, h) + boff + n * 2048 + k * 1024); } while (0)
#define PG8_MMA(ai, bj, At, Bt) do { __builtin_amdgcn_s_setprio(1); _Pragma("unroll") for (int m = 0; m < 4; ++m) _Pragma("unroll") for (int n = 0; n < 2; ++n) _Pragma("unroll") for (int k = 0; k < 2; ++k) \
        acc[ai][bj][m][n] = __builtin_amdgcn_mfma_f32_16x16x32_bf16(Bt[n][k], At[m][k], acc[ai][bj][m][n], 0, 0, 0); __builtin_amdgcn_s_setprio(0); } while (0)
#define PG8_WAIT_V(n) asm volatile("s_waitcnt vmcnt(" #n ")" ::: "memory")
#define PG8_WAIT_L(n) asm volatile("s_waitcnt lgkmcnt(" #n ")" ::: "memory")
#define PG8_BAR __builtin_amdgcn_s_barrier()
#define PG8_SCHED __builtin_amdgcn_sched_barrier(0)
    Unit cur, nxt; int ui = 0;
    if (!S.next(0, cur)) return;
    f32x4 acc[2][2][4][2];
#pragma unroll
    for (int a = 0; a < 2; ++a)
#pragma unroll
        for (int b = 0; b < 2; ++b)
#pragma unroll
            for (int m = 0; m < 4; ++m)
#pragma unroll
                for (int n = 0; n < 2; ++n) acc[a][b][m][n] = (f32x4){0.f, 0.f, 0.f, 0.f};
    bf16x8 At[4][2], B0[2][2], B1[2][2];
    const char* cA = (const char*)g.A + (size_t)cur.pm * tstep; const char* cB = (const char*)g.Bt + (size_t)cur.pn * tstep;
    S.a_ready(cur);
    if constexpr (SP2) {
        PG8_STAGE(PG8_SB(0, 0), cB, voffB); PG8_STAGE(PG8_SB(0, 1), cB + hstep, voffB); PG8_STAGE(PG8_SA(0, 0), cA, voffA); PG8_STAGE(PG8_SA(0, 1), cA + hstep, voffA);
        if (wr == 1) PG8_BAR;
        PG8_WAIT_V(2); PG8_BAR;
        PG8_STAGE(PG8_SB(1, 0), cB + kstep, voffB); PG8_STAGE(PG8_SA(1, 0), cA + kstep, voffA); PG8_STAGE(PG8_SB(1, 1), cB + hstep + kstep, voffB);
        PG8_WAIT_V(6); PG8_BAR;
    } else {
        PG8_STAGE(PG8_SB(0, 0), cB, voffB); PG8_STAGE(PG8_SA(0, 0), cA, voffA); PG8_STAGE(PG8_SB(0, 1), cB + hstep, voffB); PG8_STAGE(PG8_SA(0, 1), cA + hstep, voffA);
        if (wr == 1) PG8_BAR;
        PG8_WAIT_V(4); PG8_BAR;
        PG8_STAGE(PG8_SB(1, 0), cB + kstep, voffB); PG8_STAGE(PG8_SA(1, 0), cA + kstep, voffA); PG8_STAGE(PG8_SB(1, 1), cB + hstep + kstep, voffB);
        PG8_WAIT_V(6); PG8_BAR;
    }
    for (;;) {
        const bool has_next = S.next(ui + 1, nxt);
        const char* nA = has_next ? (const char*)g.A + (size_t)nxt.pm * tstep : cA; const char* nB = has_next ? (const char*)g.Bt + (size_t)nxt.pn * tstep : cB;
        for (int t = 0; t < nt; t += 2) {
            const bool last = (t == nt - 2);
            const char* a1 = cA + (size_t)(t + 1) * kstep;
            const char* a2 = last ? nA : cA + (size_t)(t + 2) * kstep; const char* b2 = last ? nB : cB + (size_t)(t + 2) * kstep;
            const char* a3 = a2 + kstep; const char* b3 = b2 + kstep;
            if (last && has_next) S.a_ready(nxt);
            if constexpr (SP2) {
            PG8_LDB(B0, 0, 0); PG8_LDB(B1, 0, 1); PG8_SCHED; PG8_LDA(At, 0, 0); PG8_STAGE(PG8_SA(1, 1), a1 + hstep, voffA);
            PG8_WAIT_V(8); PG8_WAIT_L(0); PG8_BAR; PG8_MMA(0, 0, At, B0); PG8_MMA(0, 1, At, B1); PG8_BAR; PG8_SCHED;
            PG8_LDA(At, 0, 1); PG8_STAGE(PG8_SB(0, 0), b2, voffB); PG8_STAGE(PG8_SB(0, 1), b2 + hstep, voffB); PG8_STAGE(PG8_SA(0, 0), a2, voffA);
            PG8_WAIT_V(8); PG8_WAIT_L(0); PG8_BAR; PG8_MMA(1, 0, At, B0); PG8_MMA(1, 1, At, B1); PG8_BAR; PG8_SCHED;
            PG8_LDB(B0, 1, 0); PG8_LDB(B1, 1, 1); PG8_SCHED; PG8_LDA(At, 1, 0); PG8_STAGE(PG8_SA(0, 1), a2 + hstep, voffA);
            PG8_WAIT_V(8); PG8_WAIT_L(0); PG8_BAR; PG8_MMA(0, 0, At, B0); PG8_MMA(0, 1, At, B1); PG8_BAR; PG8_SCHED;
            PG8_LDA(At, 1, 1); PG8_STAGE(PG8_SB(1, 0), b3, voffB); PG8_STAGE(PG8_SB(1, 1), b3 + hstep, voffB); PG8_STAGE(PG8_SA(1, 0), a3, voffA);
            PG8_WAIT_V(8); PG8_WAIT_L(0); PG8_BAR; PG8_MMA(1, 0, At, B0); PG8_MMA(1, 1, At, B1); PG8_BAR; PG8_SCHED;
            } else {
            PG8_LDB(B0, 0, 0); PG8_SCHED; PG8_LDA(At, 0, 0); PG8_STAGE(PG8_SA(1, 1), a1 + hstep, voffA);
            PG8_WAIT_L(8); PG8_BAR; PG8_WAIT_L(0); PG8_MMA(0, 0, At, B0); PG8_BAR; PG8_SCHED;
            PG8_LDB(B1, 0, 1); PG8_STAGE(PG8_SB(0, 0), b2, voffB);
            PG8_BAR; PG8_WAIT_L(0); PG8_MMA(0, 1, At, B1); PG8_BAR;
            PG8_LDA(At, 0, 1); PG8_STAGE(PG8_SA(0, 0), a2, voffA);
            PG8_BAR; PG8_WAIT_L(0); PG8_MMA(1, 0, At, B0); PG8_BAR; PG8_SCHED;
            PG8_STAGE(PG8_SB(0, 1), b2 + hstep, voffB);
            PG8_WAIT_V(6); PG8_BAR; PG8_MMA(1, 1, At, B1); PG8_BAR;
            PG8_LDB(B0, 1, 0); PG8_SCHED; PG8_LDA(At, 1, 0); PG8_STAGE(PG8_SA(0, 1), a2 + hstep, voffA);
            PG8_WAIT_L(8); PG8_BAR; PG8_WAIT_L(0); PG8_MMA(0, 0, At, B0); PG8_BAR; PG8_SCHED;
            PG8_LDB(B1, 1, 1); PG8_STAGE(PG8_SB(1, 0), b3, voffB);
            PG8_BAR; PG8_WAIT_L(0); PG8_MMA(0, 1, At, B1); PG8_BAR;
            PG8_LDA(At, 1, 1); PG8_STAGE(PG8_SA(1, 0), a3, voffA);
            PG8_BAR; PG8_WAIT_L(0); PG8_MMA(1, 0, At, B0); PG8_BAR; PG8_SCHED;
            PG8_STAGE(PG8_SB(1, 1), b3 + hstep, voffB);
            PG8_WAIT_V(6); PG8_BAR; PG8_MMA(1, 1, At, B1); PG8_BAR;
            }
        }
        if constexpr (ALIGN_EPI) { if (wr == 0) PG8_BAR; }
        if constexpr (!Epi::AFTER_DRAIN) { E(acc, cur, wr, wc, fr, fq); S.done(cur); }
        if (!has_next) break;
#pragma unroll
        for (int a = 0; a < 2; ++a)
#pragma unroll
            for (int b = 0; b < 2; ++b)
#pragma unroll
                for (int m = 0; m < 4; ++m)
#pragma unroll
                    for (int n = 0; n < 2; ++n) acc[a][b][m][n] = (f32x4){0.f, 0.f, 0.f, 0.f};
        cur = nxt; cA = nA; cB = nB; ++ui;
        if constexpr (ALIGN_EPI) { if (wr == 1) PG8_BAR; }
    }
    PG8_WAIT_V(0);
    if constexpr (!ALIGN_EPI) { if (wr == 0) PG8_BAR; }
    PG8_BAR;
    if constexpr (Epi::AFTER_DRAIN) { E.fused(acc, cur, wr, wc, fr, fq, lds, wid, lane); S.done(cur); }
#undef PG8_SA
#undef PG8_SB
#undef PG8_STAGE
#undef PG8_LDA
#undef PG8_LDB
#undef PG8_MMA
#undef PG8_WAIT_V
#undef PG8_WAIT_L
#undef PG8_BAR
#undef PG8_SCHED
}
}

constexpr int DM = 1024, NB = 4, SEQ = 4096, DEPTH = 4, CTXL = 256;
constexpr int NCTX = NB * CTXL, NLAT = NB * SEQ, NTOK = NCTX + NLAT;
constexpr int PROJ = 2048, NEXP = 16384, NPICK = 128;
constexpr int NCHUNK = NTOK / 128;
constexpr float EPS = 1e-6f;
constexpr int NPH = 3 + 11 * DEPTH;

constexpr size_t MiB = 1u << 20;
constexpr size_t WS_CTL = 0, CTL_ZERO_BYTES = 1 * MiB;
constexpr size_t WS_MODP = 616 * MiB;
constexpr size_t WS_MOD  = 5 * MiB;
constexpr size_t WS_POS  = 6 * MiB;
constexpr size_t WS_AGG  = 7 * MiB;
constexpr size_t WS_WIN  = 8 * MiB;
constexpr size_t WS_WOUT = 24 * MiB;
constexpr size_t WS_WCMB = 32 * MiB;
constexpr size_t WS_PE   = 48 * MiB;
constexpr size_t WS_PC   = 58 * MiB;
constexpr size_t WS_Z    = 72 * MiB;
constexpr size_t WS_XN   = 140 * MiB;
constexpr size_t WS_P    = 176 * MiB;
constexpr size_t WS_Y    = 244 * MiB;
constexpr size_t WS_HS   = 280 * MiB;
constexpr size_t WS_SC   = 348 * MiB;
constexpr size_t WS_UQ   = 484 * MiB;
constexpr size_t WS_VQ   = 548 * MiB;
constexpr size_t WS_US   = 612 * MiB;
constexpr size_t WS_VS   = 613 * MiB;
constexpr size_t WS_SGW  = 614 * MiB;
constexpr size_t WS_CO   = 632 * MiB;
constexpr size_t WS_FQ   = 641 * MiB;
constexpr size_t WS_FS   = 658 * MiB;
constexpr size_t WS_END  = 659 * MiB;
constexpr int CW_BAR = 4096;

constexpr int RING_BYTES = 131072;
constexpr int LDS_BYTES = 163840;
constexpr int LDSCTL_OFF = LDS_BYTES - 1024, MISC_OFF = LDSCTL_OFF + 320;

#define LAS __attribute__((address_space(3)))
typedef unsigned short bf16;
typedef unsigned v4u __attribute__((ext_vector_type(4)));
typedef unsigned v2u __attribute__((ext_vector_type(2)));
typedef int v4i __attribute__((ext_vector_type(4)));
typedef float f32x4 __attribute__((ext_vector_type(4)));
#define LDS_WAIT() asm volatile("s_waitcnt lgkmcnt(0)" ::: "memory")

__device__ __forceinline__ unsigned f2bf(float f) { unsigned u = __builtin_bit_cast(unsigned, f); return (u + 0x7fffu + ((u >> 16) & 1u)) >> 16; }
__device__ __forceinline__ unsigned pk2(float lo, float hi) { return f2bf(lo) | (f2bf(hi) << 16); }
__device__ __forceinline__ float bf2f(unsigned short b) { return __builtin_bit_cast(float, ((unsigned)b) << 16); }
__device__ __forceinline__ float bflo(unsigned w) { return __builtin_bit_cast(float, w << 16); }
__device__ __forceinline__ float bfhi(unsigned w) { return __builtin_bit_cast(float, w & 0xffff0000u); }
__device__ __forceinline__ float gelu_t(float x) {
    const float u = 0.7978845608028654f * (x + 0.044715f * x * x * x);
    const float e = expf(2.f * u);
    const float t = 1.f - 2.f / (e + 1.f);
    return 0.5f * x * (1.f + t);
}
__device__ __forceinline__ float sigmoid_f(float x) { return 1.f / (1.f + expf(-x)); }
#define DPPF(x, ctrl) __builtin_bit_cast(float, __builtin_amdgcn_update_dpp(0, __builtin_bit_cast(int, (x)), (ctrl), 0xf, 0xf, true))
__device__ __forceinline__ float wave_sum(float v) {
    v += DPPF(v, 0xB1); v += DPPF(v, 0x4E); v += DPPF(v, 0x141); v += DPPF(v, 0x140);
    const int iv = __builtin_bit_cast(int, v);
    const float r0 = __builtin_bit_cast(float, __builtin_amdgcn_readlane(iv, 0)), r1 = __builtin_bit_cast(float, __builtin_amdgcn_readlane(iv, 16)),
                r2 = __builtin_bit_cast(float, __builtin_amdgcn_readlane(iv, 32)), r3 = __builtin_bit_cast(float, __builtin_amdgcn_readlane(iv, 48));
    return (r0 + r1) + (r2 + r3);
}

__device__ __forceinline__ void wave_sum2(float& a, float& b) {
    a += DPPF(a, 0xB1); b += DPPF(b, 0xB1); a += DPPF(a, 0x4E); b += DPPF(b, 0x4E); a += DPPF(a, 0x141); b += DPPF(b, 0x141); a += DPPF(a, 0x140); b += DPPF(b, 0x140);
    const int ia = __builtin_bit_cast(int, a), ib = __builtin_bit_cast(int, b);
    const float a0 = __builtin_bit_cast(float, __builtin_amdgcn_readlane(ia, 0)), a1 = __builtin_bit_cast(float, __builtin_amdgcn_readlane(ia, 16)),
                a2 = __builtin_bit_cast(float, __builtin_amdgcn_readlane(ia, 32)), a3 = __builtin_bit_cast(float, __builtin_amdgcn_readlane(ia, 48));
    const float b0 = __builtin_bit_cast(float, __builtin_amdgcn_readlane(ib, 0)), b1 = __builtin_bit_cast(float, __builtin_amdgcn_readlane(ib, 16)),
                b2 = __builtin_bit_cast(float, __builtin_amdgcn_readlane(ib, 32)), b3 = __builtin_bit_cast(float, __builtin_amdgcn_readlane(ib, 48));
    a = (a0 + a1) + (a2 + a3); b = (b0 + b1) + (b2 + b3);
}

#define XB_TMO      128
#define XB_XCNT(j)  (256  + 64 * (j))
#define XB_XSUB(j)  (1280 + 64 * (j))
#define XB_XGEN(j)  (2304 + 64 * (j))
#define XB_TOP      3328
#define XB_TOPGEN   3392
#define XCD_BAR_WORDS 3456
#define XB_SPIN_CAP (1u << 20)

__device__ __forceinline__ unsigned xb_ld(unsigned* p)              { return __hip_atomic_load(p, __ATOMIC_RELAXED, __HIP_MEMORY_SCOPE_AGENT); }
__device__ __forceinline__ unsigned xb_add(unsigned* p, unsigned v) { return __hip_atomic_fetch_add(p, v, __ATOMIC_RELAXED, __HIP_MEMORY_SCOPE_AGENT); }
__device__ __forceinline__ unsigned xb_xcc_id() { return (unsigned)__builtin_amdgcn_s_getreg((3 << 11) | 20) & 0xFu; }
#define XB_SPIN(cond, bar) do { unsigned _sp = 0; while (cond) { __builtin_amdgcn_s_sleep(1); \
    if ((++_sp & 255u) == 0u) { if (xb_ld(&(bar)[XB_TMO])) break; if (_sp > XB_SPIN_CAP) { atomicAdd(&(bar)[XB_TMO], 1u); break; } } } } while (0)

struct XcdBarrier {
    unsigned* bar; unsigned x;
    volatile LAS unsigned* st;
};

__device__ __forceinline__ XcdBarrier xcd_barrier_post(unsigned* bar, volatile LAS unsigned* st) {
    XcdBarrier b; b.bar = bar; b.x = xb_xcc_id(); b.st = st;
    if (threadIdx.x == 0) (void)xb_add(&bar[XB_XCNT(b.x)], 1u);
    return b;
}
__device__ __forceinline__ void xcd_barrier_complete(unsigned* bar, unsigned x, unsigned& nloc, unsigned& nx) {
    const unsigned G = gridDim.x * gridDim.y * gridDim.z;
    unsigned sum, cnt, mine, sp = 0u;
    for (;;) {
        sum = 0u; cnt = 0u; mine = 0u;
#pragma unroll
        for (unsigned j = 0; j < 16; ++j) { const unsigned c = xb_ld(&bar[XB_XCNT(j)]); sum += c; cnt += (c > 0u) ? 1u : 0u; mine = (j == x) ? c : mine; }
        if (sum == G) break;
        __builtin_amdgcn_s_sleep(1);
        if ((++sp & 255u) == 0u) { if (xb_ld(&bar[XB_TMO])) break; if (sp > XB_SPIN_CAP) { atomicAdd(&bar[XB_TMO], 1u); break; } }
    }
    nloc = mine > 0u ? mine : 1u; nx = cnt > 0u ? cnt : 1u;
}

__device__ __forceinline__ void xcd_barrier(const XcdBarrier& b) {
    asm volatile("s_waitcnt vmcnt(0)" ::: "memory");
    __syncthreads();
    if (threadIdx.x == 0) {
        unsigned* bar = b.bar;
        __builtin_amdgcn_s_waitcnt(0);
        unsigned nloc = b.st[0], nx = b.st[1];
        if (nloc == 0u) { xcd_barrier_complete(bar, b.x, nloc, nx); b.st[0] = nloc; b.st[1] = nx; }
        const unsigned old = xb_add(&bar[XB_XSUB(b.x)], 1u);
        const unsigned gen = old / nloc;
        if (old + 1u == (gen + 1u) * nloc) {
            __builtin_amdgcn_fence(__ATOMIC_RELEASE, "agent");
            asm volatile("s_waitcnt vmcnt(0)" ::: "memory");
            const unsigned og = xb_add(&bar[XB_TOP], 1u);
            const unsigned tg = og / nx;
            if (og + 1u == (tg + 1u) * nx) xb_add(&bar[XB_TOPGEN], 1u);
            else XB_SPIN(xb_ld(&bar[XB_TOPGEN]) == tg, bar);
            __builtin_amdgcn_fence(__ATOMIC_ACQUIRE, "agent");
            xb_add(&bar[XB_XGEN(b.x)], 1u);
            asm volatile("s_waitcnt vmcnt(0)" ::: "memory");
        } else {
            XB_SPIN(xb_ld(&bar[XB_XGEN(b.x)]) == gen, bar);
            __builtin_amdgcn_fence(__ATOMIC_ACQUIRE, "agent");
            asm volatile("s_waitcnt vmcnt(0)" ::: "memory");
        }
    }
    __syncthreads();
}


#define AS4 __attribute__((address_space(4)))
struct Ctx {
    LAS unsigned char* lds;
    int tid, lane, wave, vcu, G, bx;
    const AS4 unsigned char* kp;
    unsigned char* ws; float* out;
};
#define IN_(C, k) (*(const float* const AS4*)((C).kp + 8 * (k)))

typedef short bf16x8 __attribute__((ext_vector_type(8)));
#define MFMA16(a, b, c) __builtin_amdgcn_mfma_f32_16x16x32_bf16((a), (b), (c), 0, 0, 0)
__device__ __forceinline__ void p0_transpose_item(const float* W, int K, int N, bf16* WT, LAS float* scr, int item, int lane) {
    const int nblk = N / 32, kb = item / nblk, nb = item % nblk, k0 = 64 * kb, n0 = 32 * nb;
#pragma unroll 8
    for (int i = 0; i < 32; ++i) { const int kk = 2 * i + (lane >> 5); scr[kk * 33 + (lane & 31)] = W[(size_t)(k0 + kk) * N + n0 + (lane & 31)]; }
    LDS_WAIT(); asm volatile("" ::: "memory");
    const int c = lane & 7;
#pragma unroll
    for (int j = 0; j < 4; ++j) { const int n = (lane >> 3) + 8 * j; const LAS float* s = scr + (8 * c) * 33 + n;
        v4u o; o.x = pk2(s[0 * 33], s[1 * 33]); o.y = pk2(s[2 * 33], s[3 * 33]); o.z = pk2(s[4 * 33], s[5 * 33]); o.w = pk2(s[6 * 33], s[7 * 33]);
        *(v4u*)(WT + (size_t)(n0 + n) * K + k0 + 8 * c) = o; }
    LDS_WAIT(); asm volatile("" ::: "memory");
}

__device__ __forceinline__ void convert_tables(const Ctx& C, int l, int it0, int it1) {
    const int gw = C.vcu * 8 + C.wave, NGW = C.G * 8;
    for (int q0 = (it0 * NGW + gw) * 4; q0 < 2 * NEXP && q0 < (it1 * NGW) * 4; q0 += NGW * 4) {
        const bool isv = q0 >= NEXP; const int rr0 = l * NEXP + (isv ? q0 - NEXP : q0);
        const f32x4* src = (const f32x4*)((isv ? IN_(C, 27) : IN_(C, 26)) + (size_t)rr0 * DM) + C.lane;
        f32x4 v[4][4];
#pragma unroll
        for (int q = 0; q < 4; ++q)
#pragma unroll
            for (int j = 0; j < 4; ++j) v[q][j] = src[q * 256 + 64 * j];
        const int bias = 0;
#pragma unroll
        for (int q = 0; q < 4; ++q) {
            float am = 0.f;
#pragma unroll
            for (int j = 0; j < 4; ++j) am = fmaxf(am, fmaxf(fmaxf(fabsf(v[q][j].x), fabsf(v[q][j].y)), fmaxf(fabsf(v[q][j].z), fabsf(v[q][j].w))));
            am = fmaxf(am, DPPF(am, 0xB1)); am = fmaxf(am, DPPF(am, 0x4E)); am = fmaxf(am, DPPF(am, 0x141)); am = fmaxf(am, DPPF(am, 0x140));
            { const int iv = __builtin_bit_cast(int, am);
              am = fmaxf(fmaxf(__builtin_bit_cast(float, __builtin_amdgcn_readlane(iv, 0)), __builtin_bit_cast(float, __builtin_amdgcn_readlane(iv, 16))),
                         fmaxf(__builtin_bit_cast(float, __builtin_amdgcn_readlane(iv, 32)), __builtin_bit_cast(float, __builtin_amdgcn_readlane(iv, 48)))); }
            const float inv = am > 0.f ? 127.0f / am : 0.f;
            unsigned* dst = (unsigned*)(C.ws + (isv ? WS_VQ : WS_UQ) + (size_t)(rr0 + q) * DM) + C.lane;
#pragma unroll
            for (int j = 0; j < 4; ++j) {
                const int q0 = (int)rintf(v[q][j].x * inv) + bias, q1 = (int)rintf(v[q][j].y * inv) + bias, q2 = (int)rintf(v[q][j].z * inv) + bias, q3 = (int)rintf(v[q][j].w * inv) + bias;
                dst[64 * j] = (unsigned)(q0 & 255) | ((unsigned)(q1 & 255) << 8) | ((unsigned)(q2 & 255) << 16) | ((unsigned)(q3 & 255) << 24);
            }
            if (C.lane == 0) ((float*)(C.ws + (isv ? WS_VS : WS_US)))[rr0 + q] = am * (1.0f / 127.0f);
        }
    }
}

__device__ __forceinline__ void phase_p0a(const Ctx& C, int mask) {
    const int gw = C.vcu * 8 + C.wave, NGW = C.G * 8;
    const int gt = C.vcu * 512 + C.tid, NGT = C.G * 512;
    LAS float* scr = (LAS float*)(C.lds + C.wave * 16384);
    if (mask & 1) for (int it = gw; it < 4 * 1024 + 4 * 512; it += NGW) {
        if (it < 4096) { const int l = it >> 10, r = it & 1023; p0_transpose_item(IN_(C, 8) + (size_t)l * 1024 * 2048, 1024, 2048, ((bf16*)(C.ws + WS_WIN)) + (size_t)l * 2048 * 1024, scr, r, C.lane); }
        else { const int q = it - 4096, l = q >> 9, r = q & 511; p0_transpose_item(IN_(C, 9) + (size_t)l * 1024 * 1024, 1024, 1024, ((bf16*)(C.ws + WS_WOUT)) + (size_t)l * 1024 * 1024, scr, r, C.lane); }
    }
    for (int i = gt; i < 4 * 4 * 128 * 128; i += NGT) ((bf16*)(C.ws + WS_SGW))[i] = (bf16)f2bf(IN_(C, 21)[i]);
    for (int i = gt; i < 64 * 512; i += NGT) {
        const int p = i >> 9, j = i & 511, q = j & 255;
        const float omega = powf(10000.0f, -(float)q / 256.0f);
        const float ang = (float)p * omega;
        ((float*)(C.ws + WS_POS))[i] = (j < 256) ? sinf(ang) : cosf(ang);
    }
    if (mask & 2) convert_tables(C, 0, 0, 64);
    if (mask & 4) for (int it = gw; it < 4 * 32 * 24; it += NGW) {
        const int cb = it % 24, ks = (it / 24) & 31, l = it / 768;
        const int col = cb * 256 + 4 * C.lane;
        const float* w = IN_(C, 4) + ((size_t)l * 1024 + ks * 32) * 6144 + col;
        f32x4 wv[32];
#pragma unroll
        for (int k = 0; k < 32; ++k) wv[k] = *(const f32x4*)(w + (size_t)k * 6144);
        int sl[5];
        { const int kk = ks * 32 + (C.lane & 31);
#pragma unroll
          for (int r = 0; r < 5; ++r) { const float v = (r < 4) ? IN_(C, 1)[r * 1024 + kk] : IN_(C, 3)[kk]; sl[r] = __builtin_bit_cast(int, v / (1.f + expf(-v))); } }
        f32x4 a[5];
#pragma unroll
        for (int r = 0; r < 5; ++r) a[r] = (f32x4){0.f, 0.f, 0.f, 0.f};
#pragma unroll
        for (int k = 0; k < 32; ++k)
#pragma unroll
            for (int r = 0; r < 5; ++r) a[r] = a[r] + wv[k] * __builtin_bit_cast(float, __builtin_amdgcn_readlane(sl[r], k));
        float* o = ((float*)(C.ws + WS_MODP)) + (((size_t)ks * 4 + l) * 5) * 6144 + col;
#pragma unroll
        for (int r = 0; r < 5; ++r) *(f32x4*)(o + (size_t)r * 6144) = a[r];
    }
    {
        const int fr = C.lane & 15, fq = C.lane >> 4;
        if (mask & 8) for (int it = gw; it < 8192; it += NGW) {
            const int nt = it & 7, kt = (it >> 3) & 15, side = (it >> 7) & 1, h = (it >> 8) & 7, l = it >> 11;
            const float* key = (side ? IN_(C, 25) : IN_(C, 24)) + (size_t)l * 16384 + (size_t)(nt * 16 + fr) * 128 + 8 * fq;
            const float* wq = IN_(C, 23) + (size_t)l * 1024 * 2048 + (size_t)(kt * 64 + fr) * 2048 + h * 256 + side * 128 + 8 * fq;
            f32x4 kx[4][2], wx[4][4][2];
#pragma unroll
            for (int ks = 0; ks < 4; ++ks) { kx[ks][0] = *(const f32x4*)(key + 32 * ks); kx[ks][1] = *(const f32x4*)(key + 32 * ks + 4); }
#pragma unroll
            for (int ct = 0; ct < 4; ++ct)
#pragma unroll
                for (int ks = 0; ks < 4; ++ks) { const float* wp = wq + (size_t)(16 * ct) * 2048 + 32 * ks; wx[ct][ks][0] = *(const f32x4*)wp; wx[ct][ks][1] = *(const f32x4*)(wp + 4); }
            bf16x8 Bh[4], Bl[4];
#pragma unroll
            for (int ks = 0; ks < 4; ++ks) { const f32x4 x0 = kx[ks][0], x1 = kx[ks][1];
                const float xv[8] = {x0.x, x0.y, x0.z, x0.w, x1.x, x1.y, x1.z, x1.w};
#pragma unroll
                for (int e = 0; e < 8; ++e) { const unsigned hb = f2bf(xv[e]); Bh[ks][e] = (short)hb; Bl[ks][e] = (short)f2bf(xv[e] - __builtin_bit_cast(float, hb << 16)); } }
            bf16* o = (bf16*)(C.ws + WS_WCMB) + ((size_t)l * 2048 + h * 256 + side * 128 + nt * 16 + fr) * 1024 + kt * 64 + 4 * fq;
#pragma unroll
            for (int ct = 0; ct < 4; ++ct) {
                f32x4 acc = {0.f, 0.f, 0.f, 0.f};
#pragma unroll
                for (int ks = 0; ks < 4; ++ks) { const f32x4 x0 = wx[ct][ks][0], x1 = wx[ct][ks][1];
                    const float xv[8] = {x0.x, x0.y, x0.z, x0.w, x1.x, x1.y, x1.z, x1.w};
                    bf16x8 Ah, Al;
#pragma unroll
                    for (int e = 0; e < 8; ++e) { const unsigned hb = f2bf(xv[e]); Ah[e] = (short)hb; Al[e] = (short)f2bf(xv[e] - __builtin_bit_cast(float, hb << 16)); }
                    acc = MFMA16(Ah, Bh[ks], acc); acc = MFMA16(Ah, Bl[ks], acc); acc = MFMA16(Al, Bh[ks], acc); }
                v2u w; w.x = pk2(acc[0], acc[1]); w.y = pk2(acc[2], acc[3]);
                *(v2u*)(o + 16 * ct) = w;
            }
        }
    }
}

__device__ __forceinline__ void phase_p0b(const Ctx& C) {
    const int gt = C.vcu * 512 + C.tid, NGT = C.G * 512;
    for (int i = gt; i < 4 * 5 * 6144; i += NGT) {
        const int l = i / 30720, rem = i % 30720, r = rem / 6144, col = rem % 6144;
        float v = IN_(C, 5)[l * 6144 + col];
#pragma unroll 8
        for (int ks = 0; ks < 32; ++ks) v += ((float*)(C.ws + WS_MODP))[(((size_t)ks * 4 + l) * 5 + r) * 6144 + col];
        ((float*)(C.ws + WS_MOD))[i] = v;
    }
}

template <int MODE>
__device__ __forceinline__ void phase_rows(const Ctx& C, int l, int row_lo) {
    const int gw = C.vcu * 8 + C.wave, NGW = C.G * 8;
    const bool first = (MODE == 0 && l == 0);
    const int n = NTOK - row_lo, per = n / NGW, rem = n - per * NGW;
    int row = row_lo + gw * per + (gw < rem ? gw : rem);
    const int rend = row + per + (gw < rem ? 1 : 0);
#define ROW_LOAD(dst, r) do { if ((r) < rend) { if (first) { const f32x4* sp_ = (const f32x4*)((r) < NCTX ? IN_(C, 2) + (size_t)(r) * DM : IN_(C, 0) + (size_t)((r) - NCTX) * DM) + C.lane; \
            _Pragma("unroll") for (int j = 0; j < 4; ++j) dst[j] = sp_[64 * j]; } \
        else { const v2u* sp_ = (const v2u*)(((const bf16*)(C.ws + WS_Z)) + (size_t)(r) * DM) + C.lane; \
            _Pragma("unroll") for (int j = 0; j < 4; ++j) { const v2u w_ = sp_[64 * j]; dst[j] = (f32x4){bflo(w_.x), bfhi(w_.x), bflo(w_.y), bfhi(w_.y)}; } } } } while (0)
    f32x4 v[4], v1[4], v2[4];
    ROW_LOAD(v, row); ROW_LOAD(v1, row + 1);
    f32x4 gq[4], shq[4], scq[4]; int mr_cur = -1;
    if (MODE != 2) { const f32x4* gp = (const f32x4*)((MODE == 0 ? IN_(C, 6) : IN_(C, 7)) + (size_t)l * DM) + C.lane;
#pragma unroll
        for (int j = 0; j < 4; ++j) gq[j] = gp[64 * j]; }
    else { const f32x4* gp = (const f32x4*)IN_(C, 28) + C.lane;
#pragma unroll
        for (int j = 0; j < 4; ++j) gq[j] = gp[64 * j]; }
    while (row < rend) {
        ROW_LOAD(v2, row + 2);
        float ss = 0.f;
#pragma unroll
        for (int j = 0; j < 4; ++j) ss += (v[j].x * v[j].x + v[j].y * v[j].y) + (v[j].z * v[j].z + v[j].w * v[j].w);
        if (first) { v2u* zp = (v2u*)(((bf16*)(C.ws + WS_Z)) + (size_t)row * DM) + C.lane;
#pragma unroll
            for (int j = 0; j < 4; ++j) { v2u w; w.x = pk2(v[j].x, v[j].y); w.y = pk2(v[j].z, v[j].w); zp[64 * j] = w;
                v[j] = (f32x4){bflo(w.x), bfhi(w.x), bflo(w.y), bfhi(w.y)}; } }
        int mr, t; if (row < NCTX) { mr = 4; t = row & 255; } else { mr = (row - NCTX) >> 12; t = (row - NCTX) & 4095; }
        if (MODE != 2 && mr != mr_cur) { mr_cur = mr;
            const float* mb = ((float*)(C.ws + WS_MOD)) + ((size_t)(l * 5 + mr) * 6 + (MODE == 0 ? 0 : 3)) * DM;
            const f32x4* shp = (const f32x4*)mb + C.lane; const f32x4* scp = (const f32x4*)(mb + DM) + C.lane;
#pragma unroll
            for (int j = 0; j < 4; ++j) { shq[j] = shp[64 * j]; scq[j] = scp[64 * j] + 1.0f; } }
        const float rs = __builtin_amdgcn_rsqf(wave_sum(ss) * (1.0f / DM) + EPS);
        if (MODE == 2) {
            f32x4* op = (f32x4*)(C.out + (size_t)(row - NCTX) * DM) + C.lane;
#pragma unroll
            for (int j = 0; j < 4; ++j) op[64 * j] = v[j] * rs * gq[j];
        } else {
            v2u* op = (v2u*)(((bf16*)(C.ws + WS_XN)) + (size_t)row * DM) + C.lane;
            f32x4 ov[4]; float am = 0.f;
#pragma unroll
            for (int j = 0; j < 4; ++j) {
                f32x4 o = (v[j] * rs * gq[j]) * scq[j] + shq[j];
                if (MODE == 0 && row >= NCTX) {
                    const int p = (j < 2) ? (t >> 6) : (t & 63);
                    o = o + *((const f32x4*)(((float*)(C.ws + WS_POS)) + (size_t)p * 512 + (j & 1) * 256) + C.lane);
                }
                v2u w; w.x = pk2(o.x, o.y); w.y = pk2(o.z, o.w); op[64 * j] = w;
                if (MODE == 1) { ov[j] = (f32x4){bflo(w.x), bfhi(w.x), bflo(w.y), bfhi(w.y)};
                    am = fmaxf(am, fmaxf(fmaxf(fabsf(ov[j].x), fabsf(ov[j].y)), fmaxf(fabsf(ov[j].z), fabsf(ov[j].w)))); }
            }
            if (MODE == 1) {
                am = fmaxf(am, DPPF(am, 0xB1)); am = fmaxf(am, DPPF(am, 0x4E)); am = fmaxf(am, DPPF(am, 0x141)); am = fmaxf(am, DPPF(am, 0x140));
                { const int iv = __builtin_bit_cast(int, am);
                  am = fmaxf(fmaxf(__builtin_bit_cast(float, __builtin_amdgcn_readlane(iv, 0)), __builtin_bit_cast(float, __builtin_amdgcn_readlane(iv, 16))),
                             fmaxf(__builtin_bit_cast(float, __builtin_amdgcn_readlane(iv, 32)), __builtin_bit_cast(float, __builtin_amdgcn_readlane(iv, 48)))); }
                const float inv = am > 0.f ? 127.0f / am : 0.f;
                unsigned* qp = (unsigned*)(C.ws + WS_FQ + (size_t)row * DM) + C.lane;
#pragma unroll
                for (int j = 0; j < 4; ++j) { const int q0 = (int)rintf(ov[j].x * inv), q1 = (int)rintf(ov[j].y * inv), q2 = (int)rintf(ov[j].z * inv), q3 = (int)rintf(ov[j].w * inv);
                    qp[64 * j] = (unsigned)(q0 & 255) | ((unsigned)(q1 & 255) << 8) | ((unsigned)(q2 & 255) << 16) | ((unsigned)(q3 & 255) << 24); }
                if (C.lane == 0) ((float*)(C.ws + WS_FS))[row] = am * (1.0f / 127.0f);
            }
        }
#pragma unroll
        for (int j = 0; j < 4; ++j) { v[j] = v1[j]; v1[j] = v2[j]; }
        ++row;
    }
#undef ROW_LOAD
}

constexpr int XS = 264;
constexpr int VTS = 136;
__device__ __forceinline__ float fexp(float x) { return __builtin_amdgcn_exp2f(x * 1.4426950408889634f); }
__device__ __forceinline__ float fsigmoid(float x) { return __builtin_amdgcn_rcpf(1.0f + fexp(-x)); }
__device__ __forceinline__ float fgelu(float x) {
    const float x2 = x * x;
    const float e = __builtin_amdgcn_exp2f(x * (x2 * (-0.044715f * 2.302208198f) - 2.302208198f));
    return x * __builtin_amdgcn_rcpf(1.0f + e);
}
__device__ __forceinline__ float one_minus_exp(float x) {
    const float p = -x * (1.0f + x * (0.5f + x * (0.16666667f + x * (0.041666668f + x * (0.0083333338f + x * 0.0013888889f)))));
    const float q = 1.0f - fexp(x);
    return (x > -0.25f) ? p : q;
}
__device__ __forceinline__ void seq_of_row(int row0, int& seq0, int& len) { if (row0 < NCTX) { seq0 = row0 & ~255; len = 256; } else { seq0 = NCTX + ((row0 - NCTX) & ~4095); len = 4096; } }
__device__ __forceinline__ void load_bfrags(const float* W, int lane, bf16x8 (&B)[4][2]) {
    const float* w0 = W + (8 * (lane >> 4)) * 64 + (lane & 15);
#pragma unroll
    for (int ct = 0; ct < 4; ++ct)
#pragma unroll
        for (int ks = 0; ks < 2; ++ks) {
            bf16x8 b;
#pragma unroll
            for (int e = 0; e < 8; ++e) b[e] = (short)f2bf(w0[(32 * ks + e) * 64 + 16 * ct]);
            B[ct][ks] = b;
        }
}

__device__ __forceinline__ void mixer_a(const Ctx& C, int l, int chunk) {
    const int row0 = chunk * 128; int seq0, len; seq_of_row(row0, seq0, len); const int t0 = row0 - seq0;
    LAS bf16* xa = (LAS bf16*)C.lds;
    LAS float* tile = (LAS float*)(C.lds + 128 * XS * 2 + C.wave * 8192);
    const bf16* P = (const bf16*)(C.ws + WS_P);
    {
        const float* cw = IN_(C, 10) + (size_t)l * 4 * 256; const float* cbias = IN_(C, 11) + (size_t)l * 256;
        const int c4 = (C.tid & 63) * 4, i0 = (C.tid >> 6) * 16;
        v2u pv[19];
#pragma unroll
        for (int q = 0; q < 19; ++q) { const int t = t0 + i0 - 2 + q; pv[q] = (v2u){0u, 0u}; if (t >= 0 && t < len) pv[q] = *(const v2u*)(P + (size_t)(seq0 + t) * PROJ + c4); }
        f32x4 w[4];
#pragma unroll
        for (int k = 0; k < 4; ++k) w[k] = *(const f32x4*)(cw + k * 256 + c4);
        const f32x4 bias = *(const f32x4*)(cbias + c4);
#pragma unroll
        for (int i = 0; i < 16; ++i) {
            f32x4 acc = bias;
#pragma unroll
            for (int k = 0; k < 4; ++k) { const v2u x = pv[i + k]; acc.x += w[k].x * bflo(x.x); acc.y += w[k].y * bfhi(x.x); acc.z += w[k].z * bflo(x.y); acc.w += w[k].w * bfhi(x.y); }
            v2u o; o.x = pk2(acc.x, acc.y); o.y = pk2(acc.z, acc.w);
            *(LAS v2u*)(xa + (i0 + i) * XS + c4) = o;
        }
    }
    __syncthreads();
    const int d = C.wave >> 2, h = C.wave & 3, fr = C.lane & 15, fq = C.lane >> 4;
    bf16x8 Br[4][2], Bi[4][2];
    load_bfrags(IN_(C, 13) + ((size_t)(l * 2 + d) * 4 + h) * 4096, C.lane, Br);
    load_bfrags(IN_(C, 15) + ((size_t)(l * 2 + d) * 4 + h) * 4096, C.lane, Bi);
    float brv[4], biv[4], spv[4];
#pragma unroll
    for (int ct = 0; ct < 4; ++ct) { const int j = 16 * ct + fr;
        brv[ct] = IN_(C, 14)[((l * 2 + d) * 4 + h) * 64 + j]; biv[ct] = IN_(C, 16)[((l * 2 + d) * 4 + h) * 64 + j];
        const float lam = IN_(C, 12)[(l * 2 + d) * 256 + h * 64 + j]; spv[ct] = fmaxf(-lam, 0.f) + log1pf(expf(-fabsf(lam))); }
    float hst = 0.f, acum = 1.f;
    bf16* HX = (bf16*)(C.ws + WS_HS) + (size_t)d * NTOK * 256 + h * 64 + C.lane; bf16* AX = (bf16*)(C.ws + WS_HS) + (size_t)(2 + d) * NTOK * 256 + h * 64 + C.lane;
    for (int it = 0; it < 8; ++it) {
        const int rt = d ? 7 - it : it;
        const LAS bf16* ap = xa + (16 * rt + fr) * XS + h * 64 + 8 * fq;
        const bf16x8 a0 = *(const LAS bf16x8*)ap, a1 = *(const LAS bf16x8*)(ap + 32);
        f32x4 ar[4], ai[4];
#pragma unroll
        for (int ct = 0; ct < 4; ++ct) {
            ar[ct] = MFMA16(a0, Br[ct][0], ((f32x4){0.f, 0.f, 0.f, 0.f})); ar[ct] = MFMA16(a1, Br[ct][1], ar[ct]);
            ai[ct] = MFMA16(a0, Bi[ct][0], ((f32x4){0.f, 0.f, 0.f, 0.f})); ai[ct] = MFMA16(a1, Bi[ct][1], ai[ct]);
        }
#pragma unroll
        for (int ct = 0; ct < 4; ++ct)
#pragma unroll
            for (int r = 0; r < 4; ++r) {
                const int tl = 4 * fq + r, j = 16 * ct + fr;
                const float xav = bf2f(xa[(16 * rt + tl) * XS + h * 64 + j]);
                const float rg = fsigmoid(ar[ct][r] + brv[ct]), ig = fsigmoid(ai[ct][r] + biv[ct]);
                const float la = -8.0f * rg * spv[ct];
                tile[tl * 64 + j] = fexp(la);
                tile[1024 + tl * 64 + j] = __builtin_amdgcn_sqrtf(one_minus_exp(2.0f * la)) * (ig * xav);
            }
        asm volatile("s_waitcnt lgkmcnt(0)" ::: "memory");
#pragma unroll 4
        for (int s = 0; s < 16; ++s) {
            const int tl = d ? 15 - s : s;
            const float a = tile[tl * 64 + C.lane], b = tile[1024 + tl * 64 + C.lane];
            hst = a * hst + b; acum *= a;
            const size_t ro = (size_t)(row0 + 16 * rt + tl) * 256;
            HX[ro] = (bf16)f2bf(hst); AX[ro] = (bf16)f2bf(acum);
        }
        asm volatile("s_waitcnt lgkmcnt(0)" ::: "memory");
    }
    { float* ag = (float*)(C.ws + WS_AGG) + ((size_t)(chunk * 2 + d) * 2) * 256 + h * 64 + C.lane; ag[0] = acum; ag[256] = hst; }
    __syncthreads();
}

__device__ __forceinline__ void mixer_b(const Ctx& C, int l, int chunk) {
    const int row0 = chunk * 128; int seq0, len; seq_of_row(row0, seq0, len); const int t0 = row0 - seq0;
    LAS bf16* dm = (LAS bf16*)C.lds;
    LAS bf16* xs = (LAS bf16*)(C.lds + 128 * XS * 2);
    const bf16* P = (const bf16*)(C.ws + WS_P); bf16* Y = (bf16*)(C.ws + WS_Y);
    const int half = C.wave >> 2, g = C.wave & 3, fr = C.lane & 15, fq = C.lane >> 4;
    bf16x8 Bw[4][2];
    load_bfrags(IN_(C, 17) + ((size_t)(l * 4 + g)) * 4096, C.lane, Bw);
    float scv[4];
#pragma unroll
    for (int ct = 0; ct < 4; ++ct) scv[ct] = IN_(C, 18)[l * 256 + g * 64 + 16 * ct + fr];
    {
        v4u tmp[9];
#pragma unroll
        for (int q = 0; q < 9; ++q) { const int idx = C.tid + 512 * q, i = idx >> 5, c8 = (idx & 31) * 8, t = t0 - 8 + i;
            tmp[q] = (v4u){0u, 0u, 0u, 0u}; if (t >= 0 && t < len) tmp[q] = *(const v4u*)(P + (size_t)(seq0 + t) * PROJ + 512 + c8); }
#pragma unroll
        for (int q = 0; q < 9; ++q) { const int idx = C.tid + 512 * q, i = idx >> 5, c8 = (idx & 31) * 8; *(LAS v4u*)(xs + i * 256 + c8) = tmp[q]; }
    }
    __syncthreads();
    {
        const int wh = C.wave >> 2, ri = C.lane >> 4, c4 = g * 64 + (C.lane & 15) * 4, hw = 1 << g;
        const int i0 = wh * 64 + ri * 16;
        f32x4 s = {0.f, 0.f, 0.f, 0.f};
        for (int o = -hw; o < hw; ++o) { const v2u pv = *(const LAS v2u*)(xs + (i0 + 8 + o) * 256 + c4); s.x += bflo(pv.x); s.y += bfhi(pv.x); s.z += bflo(pv.y); s.w += bfhi(pv.y); }
#pragma unroll 4
        for (int it = 0; it < 16; ++it) {
            const int i = i0 + it, t = t0 + i;
            int lo = t - hw, hi = t + hw; lo = lo < 0 ? 0 : lo; hi = hi > len ? len : hi;
            const float inv = 1.0f / (float)(hi - lo);
            const v2u xv = *(const LAS v2u*)(xs + (i + 8) * 256 + c4);
            v2u o2; o2.x = pk2(s.x * inv - bflo(xv.x), s.y * inv - bfhi(xv.x)); o2.y = pk2(s.z * inv - bflo(xv.y), s.w * inv - bfhi(xv.y));
            *(LAS v2u*)(dm + i * XS + c4) = o2;
            const v2u pa = *(const LAS v2u*)(xs + (i + 8 + hw) * 256 + c4), pd = *(const LAS v2u*)(xs + (i + 8 - hw) * 256 + c4);
            s.x += bflo(pa.x) - bflo(pd.x); s.y += bfhi(pa.x) - bfhi(pd.x); s.z += bflo(pa.y) - bflo(pd.y); s.w += bfhi(pa.y) - bfhi(pd.y);
        }
    }
    __syncthreads();
#pragma unroll
    for (int q = 0; q < 4; ++q) {
        const int rt = half * 4 + q;
        const LAS bf16* ap = dm + (16 * rt + fr) * XS + g * 64 + 8 * fq;
        const bf16x8 a0 = *(const LAS bf16x8*)ap, a1 = *(const LAS bf16x8*)(ap + 32);
#pragma unroll
        for (int ct = 0; ct < 4; ++ct) {
            f32x4 acc = MFMA16(a0, Bw[ct][0], ((f32x4){0.f, 0.f, 0.f, 0.f})); acc = MFMA16(a1, Bw[ct][1], acc);
#pragma unroll
            for (int r = 0; r < 4; ++r) Y[(size_t)(row0 + 16 * rt + 4 * fq + r) * DM + 256 + g * 64 + 16 * ct + fr] = (bf16)f2bf(acc[r] * scv[ct]);
        }
    }
    __syncthreads();
}

__device__ __forceinline__ void mixer_c(const Ctx& C, int l, int chunk) {
    const int row0 = chunk * 128; int seq0, len; seq_of_row(row0, seq0, len); const int t0 = row0 - seq0;
    const float* cw = IN_(C, 19) + (size_t)l * 3 * 256;
    const bf16* P = (const bf16*)(C.ws + WS_P); bf16* Y = (bf16*)(C.ws + WS_Y);
    const int c4 = (C.tid & 63) * 4;
    f32x4 w[3];
#pragma unroll
    for (int k = 0; k < 3; ++k) w[k] = *(const f32x4*)(cw + k * 256 + c4);
#pragma unroll 1
    for (int hf = 0; hf < 2; ++hf) {
        const int i0 = (C.tid >> 6) * 16 + hf * 8;
        v2u pa[10], pb[10], pc[8];
#pragma unroll
        for (int q = 0; q < 10; ++q) { const int t = t0 + i0 - 1 + q; pa[q] = (v2u){0u, 0u}; pb[q] = (v2u){0u, 0u};
            if (t >= 0 && t < len) { const bf16* p = P + (size_t)(seq0 + t) * PROJ; pa[q] = *(const v2u*)(p + 1024 + c4); pb[q] = *(const v2u*)(p + 1280 + c4); } }
#pragma unroll
        for (int i = 0; i < 8; ++i) pc[i] = *(const v2u*)(P + (size_t)(row0 + i0 + i) * PROJ + 768 + c4);
        f32x4 pr[10];
#pragma unroll
        for (int q = 0; q < 10; ++q) { pr[q].x = bflo(pa[q].x) * bflo(pb[q].x); pr[q].y = bfhi(pa[q].x) * bfhi(pb[q].x); pr[q].z = bflo(pa[q].y) * bflo(pb[q].y); pr[q].w = bfhi(pa[q].y) * bfhi(pb[q].y); }
#pragma unroll
        for (int i = 0; i < 8; ++i) {
            const f32x4 acc = w[0] * pr[i] + w[1] * pr[i + 1] + w[2] * pr[i + 2];
            v2u o; o.x = pk2(bflo(pc[i].x) * acc.x, bfhi(pc[i].x) * acc.y); o.y = pk2(bflo(pc[i].y) * acc.z, bfhi(pc[i].y) * acc.w);
            *(v2u*)(Y + (size_t)(row0 + i0 + i) * DM + 512 + c4) = o;
        }
    }
}

__device__ __forceinline__ void mixer_d(const Ctx& C, int l, int chunk) {
    const int row0 = chunk * 128;
    LAS bf16* vt = (LAS bf16*)C.lds;
    const bf16* P = (const bf16*)(C.ws + WS_P); bf16* Y = (bf16*)(C.ws + WS_Y);
    const int qh = C.wave >> 2, h = C.wave & 3, fr = C.lane & 15, fq = C.lane >> 4;
    const bf16* WSb = (const bf16*)(C.ws + WS_SGW) + ((size_t)(l * 4 + h) * 128) * 128;
    bf16x8 Bqa[4][4];
#pragma unroll
    for (int qq = 0; qq < 4; ++qq)
#pragma unroll
        for (int ks = 0; ks < 4; ++ks) Bqa[qq][ks] = *(const bf16x8*)(WSb + (size_t)(16 * (qh * 4 + qq) + fr) * 128 + 32 * ks + 8 * fq);
    {
        v2u pvv[16];
#pragma unroll
        for (int q = 0; q < 16; ++q) pvv[q] = *(const v2u*)(P + (size_t)(row0 + C.wave + 8 * q) * PROJ + 1792 + 4 * C.lane);
        const f32x4 gg = *(const f32x4*)(IN_(C, 20) + (size_t)l * 256 + 4 * C.lane);
#pragma unroll 4
        for (int q = 0; q < 16; ++q) {
            const int i = C.wave + 8 * q; const v2u pv = pvv[q];
            f32x4 g; g.x = fgelu(bflo(pv.x)); g.y = fgelu(bfhi(pv.x)); g.z = fgelu(bflo(pv.y)); g.w = fgelu(bfhi(pv.y));
            float s1 = (g.x + g.y) + (g.z + g.w), s2 = (g.x * g.x + g.y * g.y) + (g.z * g.z + g.w * g.w);
            wave_sum2(s1, s2);
            const float mean = s1 * (1.0f / 256.0f);
            const float var = fmaxf(s2 * (1.0f / 256.0f) - mean * mean, 0.f);
            const float rs = __builtin_amdgcn_rsqf(var + EPS);
            g = g - mean;
            g = g * rs * gg;
            LAS bf16* o = vt + (4 * C.lane) * VTS + i;
            o[0] = (bf16)f2bf(g.x); o[VTS] = (bf16)f2bf(g.y); o[2 * VTS] = (bf16)f2bf(g.z); o[3 * VTS] = (bf16)f2bf(g.w);
        }
    }
    __syncthreads();
    bf16x8 Av[4][4];
#pragma unroll
    for (int ct = 0; ct < 4; ++ct)
#pragma unroll
        for (int ks = 0; ks < 4; ++ks) Av[ct][ks] = *(const LAS bf16x8*)(vt + (h * 64 + 16 * ct + fr) * VTS + 32 * ks + 8 * fq);
    const float* BS = IN_(C, 22) + (size_t)(l * 4 + h) * 128;
#pragma unroll
    for (int qq = 0; qq < 4; ++qq) {
        const int qt = qh * 4 + qq, q = 16 * qt + fr;
        const float bias = BS[q];
        const size_t row = (size_t)(row0 + q);
#pragma unroll
        for (int ct = 0; ct < 4; ++ct) {
            f32x4 acc = {0.f, 0.f, 0.f, 0.f};
#pragma unroll
            for (int ks = 0; ks < 4; ++ks) acc = MFMA16(Av[ct][ks], Bqa[qq][ks], acc);
            const int c0 = h * 64 + 16 * ct + 4 * fq;
            const v2u pu = *(const v2u*)(P + row * PROJ + 1536 + c0);
            v2u o; o.x = pk2(fgelu(bflo(pu.x)) * (acc[0] + bias), fgelu(bfhi(pu.x)) * (acc[1] + bias)); o.y = pk2(fgelu(bflo(pu.y)) * (acc[2] + bias), fgelu(bfhi(pu.y)) * (acc[3] + bias));
            *(v2u*)(Y + row * DM + 768 + c0) = o;
        }
    }
    __syncthreads();
}

__device__ __forceinline__ void phase_mixers(const Ctx& C, int l, int sel) {
    if (C.G >= 2 * NCHUNK - 16) {
        if (C.bx < NCHUNK) { if (sel != 2) { mixer_a(C, l, C.bx); mixer_c(C, l, C.bx); } }
        else if (sel != 1) { const int nb = C.G - NCHUNK;
            for (int u = C.bx - NCHUNK; u < 2 * NCHUNK; u += nb) {
                if (u < NCHUNK) mixer_d(C, l, u); else mixer_b(C, l, u - NCHUNK); } }
    } else {
        for (int u = C.bx; u < 4 * NCHUNK; u += C.G) {
            if (u < NCHUNK) mixer_a(C, l, u); else if (u < 2 * NCHUNK) mixer_d(C, l, u - NCHUNK); else if (u < 3 * NCHUNK) mixer_b(C, l, u - 2 * NCHUNK); else mixer_c(C, l, u - 3 * NCHUNK); }
    }
}

__device__ __forceinline__ void phase_fixup(const Ctx& C, int l) {
    LAS float* cr = (LAS float*)C.lds;
    const bf16* P = (const bf16*)(C.ws + WS_P); bf16* Y = (bf16*)(C.ws + WS_Y);
    for (int u = C.bx; u < 2 * NCHUNK; u += C.G) {
        const int chunk = u >> 1, hf = u & 1;
        const bf16* H0 = (const bf16*)(C.ws + WS_HS); const bf16* H1 = H0 + (size_t)NTOK * 256; const bf16* A0 = H0 + (size_t)2 * NTOK * 256; const bf16* A1 = H0 + (size_t)3 * NTOK * 256;
        v2u hv[8][5];
#pragma unroll
        for (int q = 0; q < 8; ++q) { const int idx = C.tid + 512 * q, i = idx >> 6, c4 = (idx & 63) * 4; const size_t row = (size_t)chunk * 128 + hf * 64 + i;
            hv[q][0] = *(const v2u*)(H0 + row * 256 + c4); hv[q][1] = *(const v2u*)(H1 + row * 256 + c4); hv[q][2] = *(const v2u*)(A0 + row * 256 + c4); hv[q][3] = *(const v2u*)(A1 + row * 256 + c4);
            hv[q][4] = *(const v2u*)(P + row * PROJ + 256 + c4); }
        {
            const int c = C.tid & 255, d = C.wave >> 2;
            const bool isctx = chunk < 8; const int b = isctx ? (chunk >> 1) : ((chunk - 8) >> 5), k = isctx ? (chunk & 1) : ((chunk - 8) & 31);
            const int n = isctx ? (d ? 1 - k : k) : (d ? 2 + 31 - k : 2 + k);
            const float* AG = (const float*)(C.ws + WS_AGG);
            float av[33], bv[33];
#pragma unroll
            for (int q = 0; q < 33; ++q) {
                const int cid = (q < 2) ? (b * 2 + (d ? 1 - q : q)) : (8 + b * 32 + (d ? 31 - (q - 2) : (q - 2)));
                const float* ag = AG + ((size_t)(cid * 2 + d) * 2) * 256 + c;
                av[q] = (q < n) ? ag[0] : 1.0f; bv[q] = (q < n) ? ag[256] : 0.0f;
            }
            float carry = 0.f;
#pragma unroll
            for (int q = 0; q < 33; ++q) carry = av[q] * carry + bv[q];
            cr[d * 256 + c] = carry;
        }
        __syncthreads();
#pragma unroll
        for (int q = 0; q < 8; ++q) {
            const int idx = C.tid + 512 * q, i = idx >> 6, c4 = (idx & 63) * 4; const size_t row = (size_t)chunk * 128 + hf * 64 + i;
            const v2u h0 = hv[q][0], h1 = hv[q][1], a0 = hv[q][2], a1 = hv[q][3], ag = hv[q][4];
            const f32x4 cf = *(const LAS f32x4*)(cr + c4), cb = *(const LAS f32x4*)(cr + 256 + c4);
            const float y0 = (bflo(h0.x) + bflo(a0.x) * cf.x + bflo(h1.x) + bflo(a1.x) * cb.x) * fgelu(bflo(ag.x));
            const float y1 = (bfhi(h0.x) + bfhi(a0.x) * cf.y + bfhi(h1.x) + bfhi(a1.x) * cb.y) * fgelu(bfhi(ag.x));
            const float y2 = (bflo(h0.y) + bflo(a0.y) * cf.z + bflo(h1.y) + bflo(a1.y) * cb.z) * fgelu(bflo(ag.y));
            const float y3 = (bfhi(h0.y) + bfhi(a0.y) * cf.w + bfhi(h1.y) + bfhi(a1.y) * cb.w) * fgelu(bfhi(ag.y));
            v2u o; o.x = pk2(y0, y1); o.y = pk2(y2, y3);
            *(v2u*)(Y + row * DM + c4) = o;
        }
        __syncthreads();
    }
}

__device__ __forceinline__ unsigned okey(float x) { const int u = __builtin_bit_cast(int, x); return (unsigned)(u ^ ((u >> 31) | (int)0x80000000)); }
__device__ __forceinline__ unsigned med3u(unsigned a, unsigned b, unsigned c) { unsigned r; asm("v_med3_u32 %0, %1, %2, %3" : "=v"(r) : "v"(a), "v"(b), "v"(c)); return r; }
#define TK_INS(L, xx) do { const unsigned x_ = (xx); _Pragma("unroll") for (int k_ = 15; k_ >= 1; --k_) L[k_] = med3u(L[k_ - 1], L[k_], x_); L[0] = L[0] > x_ ? L[0] : x_; } while (0)

__device__ __forceinline__ void phase_topk(const Ctx& C, int row_lo) {
    LAS unsigned* tl = (LAS unsigned*)C.lds;
    const int NGW = C.G * 8, u0 = (row_lo >> 6) * 8, nun = (NTOK >> 6) * 8 - u0;
    for (int j = 0; ; ++j) {
        int unit;
        if ((j + 1) * NGW <= nun) unit = u0 + j * NGW + C.vcu * 8 + C.wave;
        else { const int rem = nun - j * NGW; if (rem <= 0) break;
               const int q = C.wave * C.G + C.bx; if (q >= rem) break; unit = u0 + j * NGW + q; }
        const int tb = unit >> 3, h = unit & 7; const int row = tb * 64 + C.lane;
        const unsigned* s = ((const unsigned*)(C.ws + WS_SC)) + ((size_t)unit * 256) * 64 + C.lane;
#pragma unroll 1
        for (int side = 0; side < 2; ++side) {
            unsigned L[16];
#pragma unroll
            for (int k = 0; k < 16; ++k) L[k] = 0u;
            const unsigned* ss = s + (size_t)(side * 128) * 64;
            unsigned va[32], vb[32];
#pragma unroll
            for (int q = 0; q < 32; ++q) va[q] = ss[(size_t)q * 64];
#pragma unroll
            for (int nb = 0; nb < 128; nb += 64) {
#pragma unroll
                for (int q = 0; q < 32; ++q) vb[q] = ss[(size_t)(nb + 32 + q) * 64];
#pragma unroll
                for (int q = 0; q < 32; ++q) TK_INS(L, va[q]);
                if (nb + 64 < 128) {
#pragma unroll
                    for (int q = 0; q < 32; ++q) va[q] = ss[(size_t)(nb + 64 + q) * 64];
                }
#pragma unroll
                for (int q = 0; q < 32; ++q) TK_INS(L, vb[q]);
            }
#pragma unroll
            for (int k = 0; k < 16; ++k) {
                const unsigned kk = L[k] & ~127u; const unsigned ub = (kk & 0x80000000u) ? (kk ^ 0x80000000u) : ~kk;
                tl[(side * 32 + k) * 512 + C.tid] = 127u - (L[k] & 127u); tl[(side * 32 + 16 + k) * 512 + C.tid] = ub;
            }
        }
        float v1[16], v2[16];
#pragma unroll
        for (int k = 0; k < 16; ++k) { v1[k] = __builtin_bit_cast(float, tl[(16 + k) * 512 + C.tid]); v2[k] = __builtin_bit_cast(float, tl[(48 + k) * 512 + C.tid]); }
        unsigned M[16];
#pragma unroll
        for (int k = 0; k < 16; ++k) M[k] = 0u;
#pragma unroll
        for (int a = 0; a < 16; ++a)
#pragma unroll
            for (int b = 0; b < 16; ++b)
                if ((a + 1) * (b + 1) <= 16) { const float sm = v1[a] + v2[b]; TK_INS(M, (okey(sm) & ~255u) | (unsigned)(255 - (a * 16 + b))); }
        float sums[16]; int ex[16]; float mx = -3.0e38f;
#pragma unroll
        for (int k = 0; k < 16; ++k) {
            const int f = 255 - (int)(M[k] & 255u), a = f >> 4, b = f & 15;
            const int i1 = (int)tl[a * 512 + C.tid], i2 = (int)tl[(32 + b) * 512 + C.tid];
            const float va = __builtin_bit_cast(float, tl[(16 + a) * 512 + C.tid]), vb = __builtin_bit_cast(float, tl[(48 + b) * 512 + C.tid]);
            sums[k] = va + vb; ex[k] = i1 * 128 + i2; mx = fmaxf(mx, sums[k]);
        }
        float den = 0.f;
#pragma unroll
        for (int k = 0; k < 16; ++k) { sums[k] = expf(sums[k] - mx); den += sums[k]; }
        const float inv = 1.0f / den;
        v4i* pe = (v4i*)(((int*)(C.ws + WS_PE)) + (size_t)row * NPICK + h * 16); f32x4* pc = (f32x4*)(((float*)(C.ws + WS_PC)) + (size_t)row * NPICK + h * 16);
#pragma unroll
        for (int q = 0; q < 4; ++q) { v4i e4; e4.x = ex[4 * q]; e4.y = ex[4 * q + 1]; e4.z = ex[4 * q + 2]; e4.w = ex[4 * q + 3]; pe[q] = e4;
            f32x4 c4; c4.x = sums[4 * q] * inv; c4.y = sums[4 * q + 1] * inv; c4.z = sums[4 * q + 2] * inv; c4.w = sums[4 * q + 3] * inv; pc[q] = c4; }
    }
}

__device__ __forceinline__ int red16_add(int x) {
    x += __builtin_amdgcn_update_dpp(0, x, 0xB1, 0xf, 0xf, true);
    x += __builtin_amdgcn_update_dpp(0, x, 0x4E, 0xf, 0xf, true);
    x += __builtin_amdgcn_update_dpp(0, x, 0x141, 0xf, 0xf, true);
    x += __builtin_amdgcn_update_dpp(0, x, 0x140, 0xf, 0xf, true);
    return x;
}
__device__ __forceinline__ float red16_max(float x) {
    x = fmaxf(x, __builtin_bit_cast(float, __builtin_amdgcn_update_dpp(0, __builtin_bit_cast(int, x), 0xB1, 0xf, 0xf, true)));
    x = fmaxf(x, __builtin_bit_cast(float, __builtin_amdgcn_update_dpp(0, __builtin_bit_cast(int, x), 0x4E, 0xf, 0xf, true)));
    x = fmaxf(x, __builtin_bit_cast(float, __builtin_amdgcn_update_dpp(0, __builtin_bit_cast(int, x), 0x141, 0xf, 0xf, true)));
    x = fmaxf(x, __builtin_bit_cast(float, __builtin_amdgcn_update_dpp(0, __builtin_bit_cast(int, x), 0x140, 0xf, 0xf, true)));
    return x;
}
#define UB0(w) ((float)((w) & 0xffu))
#define UB1(w) ((float)(((w) >> 8) & 0xffu))
#define UB2(w) ((float)(((w) >> 16) & 0xffu))
#define UB3(w) ((float)((w) >> 24))
struct UBuf { v4u u[4]; };
struct VBuf { v4u v[4]; };
__device__ __forceinline__ void u_issue(UBuf& B, int k, int g, int i16, int e_lo, int e_hi, const unsigned char* UQ) {
    const int p = 4 * k + g;
    const int e = __builtin_amdgcn_ds_bpermute((p & 63) << 2, (k < 16) ? e_lo : e_hi);
    const unsigned char* ur = UQ + (size_t)e * DM + 16 * i16;
#pragma unroll
    for (int c = 0; c < 4; ++c) B.u[c] = *(const v4u*)(ur + 256 * c);
}
__device__ __forceinline__ void u_compute(const UBuf& B, int k, int i16, const int (&fq)[16], int& d_lo, int& d_hi) {
    int acc = 0;
#pragma unroll
    for (int c = 0; c < 4; ++c) {
        acc = __builtin_amdgcn_sdot4((int)B.u[c].x, fq[4 * c + 0], acc, false); acc = __builtin_amdgcn_sdot4((int)B.u[c].y, fq[4 * c + 1], acc, false);
        acc = __builtin_amdgcn_sdot4((int)B.u[c].z, fq[4 * c + 2], acc, false); acc = __builtin_amdgcn_sdot4((int)B.u[c].w, fq[4 * c + 3], acc, false);
    }
    acc = red16_add(acc);
    if (k < 16) d_lo = (i16 == (k & 15)) ? acc : d_lo; else d_hi = (i16 == (k & 15)) ? acc : d_hi;
}
__device__ __forceinline__ void v_issue(VBuf& B, int k, int lane, int e_lo, int e_hi, const unsigned char* VQ) {
    const int ev = (k < 16) ? e_lo : e_hi;
#pragma unroll
    for (int q = 0; q < 4; ++q) { const int eq = __builtin_amdgcn_readlane(ev, (4 * k + q) & 63); B.v[q] = *((const v4u*)(VQ + (size_t)eq * DM) + lane); }
}
__device__ __forceinline__ void v_compute(const VBuf& B, int k, int pk_lo, int pk_hi, int (&acc)[16]) {
    const int cq4 = __builtin_amdgcn_readlane((k < 16) ? pk_lo : pk_hi, (4 * k) & 63);
    const unsigned a[4] = {B.v[0].x, B.v[0].y, B.v[0].z, B.v[0].w}, b[4] = {B.v[1].x, B.v[1].y, B.v[1].z, B.v[1].w},
                   c[4] = {B.v[2].x, B.v[2].y, B.v[2].z, B.v[2].w}, d[4] = {B.v[3].x, B.v[3].y, B.v[3].z, B.v[3].w};
#pragma unroll
    for (int w = 0; w < 4; ++w) {
        const unsigned ab_lo = __builtin_amdgcn_perm(b[w], a[w], 0x05010400u), ab_hi = __builtin_amdgcn_perm(b[w], a[w], 0x07030602u);
        const unsigned cd_lo = __builtin_amdgcn_perm(d[w], c[w], 0x05010400u), cd_hi = __builtin_amdgcn_perm(d[w], c[w], 0x07030602u);
        const unsigned t0 = __builtin_amdgcn_perm(cd_lo, ab_lo, 0x05040100u), t1 = __builtin_amdgcn_perm(cd_lo, ab_lo, 0x07060302u);
        const unsigned t2 = __builtin_amdgcn_perm(cd_hi, ab_hi, 0x05040100u), t3 = __builtin_amdgcn_perm(cd_hi, ab_hi, 0x07060302u);
        acc[4 * w + 0] = __builtin_amdgcn_sdot4((int)t0, cq4, acc[4 * w + 0], false); acc[4 * w + 1] = __builtin_amdgcn_sdot4((int)t1, cq4, acc[4 * w + 1], false);
        acc[4 * w + 2] = __builtin_amdgcn_sdot4((int)t2, cq4, acc[4 * w + 2], false); acc[4 * w + 3] = __builtin_amdgcn_sdot4((int)t3, cq4, acc[4 * w + 3], false);
    }
}
__device__ __forceinline__ void phase_gather(const Ctx& C, int l, bf16* Zt, bool fuse_next, int row_lo) {
    const int gw = C.vcu * 8 + C.wave, NGW = C.G * 8;
    const unsigned char* UQ = C.ws + WS_UQ + (size_t)l * NEXP * DM; const unsigned char* VQ = C.ws + WS_VQ + (size_t)l * NEXP * DM;
    const float* US = (const float*)(C.ws + WS_US) + (size_t)l * NEXP; const float* VS = (const float*)(C.ws + WS_VS) + (size_t)l * NEXP;
    const int g = C.lane >> 4, i16 = C.lane & 15;
    const int nrows_all = NTOK - row_lo, nfull = nrows_all / NGW, nrem = nrows_all - nfull * NGW, xq = C.wave * C.G + C.bx;
    const int nmine = nfull + (xq < nrem ? 1 : 0);
#define G_CONV_ITERS ((2 * NEXP + 4 * NGW - 1) / (4 * NGW))
#define G_ROW(k) (((k) < nfull) ? (row_lo + (k) * NGW + gw) : (((k) < nmine) ? (row_lo + nfull * NGW + xq) : NTOK))
    v4u nfq[4]; float nfs = 0.f; int ne_lo = 0, ne_hi = 0; float nc_lo = 0.f, nc_hi = 0.f;
#define U_PREFETCH(r) do { if ((r) < NTOK) { const unsigned char* fq_ = C.ws + WS_FQ + (size_t)(r) * DM + 16 * i16; \
        _Pragma("unroll") for (int c = 0; c < 4; ++c) nfq[c] = *(const v4u*)(fq_ + 256 * c); nfs = ((const float*)(C.ws + WS_FS))[(r)]; \
        const int* pe_ = ((int*)(C.ws + WS_PE)) + (size_t)(r) * NPICK; const float* pc_ = ((float*)(C.ws + WS_PC)) + (size_t)(r) * NPICK; \
        ne_lo = pe_[C.lane]; ne_hi = pe_[64 + C.lane]; nc_lo = pc_[C.lane]; nc_hi = pc_[64 + C.lane]; } } while (0)
#ifdef PROBE_GSEL
    if (fuse_next || PROBE_GSEL == 1)
#endif
    U_PREFETCH(G_ROW(0));
#ifdef PROBE_GSEL
    if (fuse_next || PROBE_GSEL == 1)
#endif
    for (int kr = 0; kr < nmine; ++kr) {
        const int row = G_ROW(kr);
        int fq[16]; const float fs = nfs;
        const int e_lo = ne_lo, e_hi = ne_hi; const float c_lo = nc_lo, c_hi = nc_hi;
#pragma unroll
        for (int c = 0; c < 4; ++c) { fq[4 * c] = (int)nfq[c].x; fq[4 * c + 1] = (int)nfq[c].y; fq[4 * c + 2] = (int)nfq[c].z; fq[4 * c + 3] = (int)nfq[c].w; }
        U_PREFETCH(G_ROW(kr + 1));
        const int pp = 4 * i16 + g;
        const int ep_lo = __builtin_amdgcn_ds_bpermute(pp << 2, e_lo), ep_hi = __builtin_amdgcn_ds_bpermute(pp << 2, e_hi);
        const float cp_lo = __builtin_bit_cast(float, __builtin_amdgcn_ds_bpermute(pp << 2, __builtin_bit_cast(int, c_lo))), cp_hi = __builtin_bit_cast(float, __builtin_amdgcn_ds_bpermute(pp << 2, __builtin_bit_cast(int, c_hi)));
        const float us_lo = US[ep_lo], us_hi = US[ep_hi], vs_lo = VS[ep_lo], vs_hi = VS[ep_hi];
        int d_lo = 0, d_hi = 0;
        UBuf A, B;
        u_issue(A, 0, g, i16, e_lo, e_hi, UQ);
#pragma unroll
        for (int k = 0; k < 32; k += 2) {
            u_issue(B, k + 1, g, i16, e_lo, e_hi, UQ);
            u_compute(A, k, i16, fq, d_lo, d_hi);
            if (k + 2 < 32) u_issue(A, k + 2, g, i16, e_lo, e_hi, UQ);
            u_compute(B, k + 1, i16, fq, d_lo, d_hi);
        }
        float* cor = ((float*)(C.ws + WS_CO)) + (size_t)row * NPICK;
        cor[pp] = gelu_t((float)d_lo * (fs * us_lo)) * (cp_lo * vs_lo);
        cor[64 + pp] = gelu_t((float)d_hi * (fs * us_hi)) * (cp_hi * vs_hi);
    }
#define V_PREFETCH(r) do { if ((r) < NTOK) { const int* pe_ = ((int*)(C.ws + WS_PE)) + (size_t)(r) * NPICK; const float* co_ = ((float*)(C.ws + WS_CO)) + (size_t)(r) * NPICK; \
        ne_lo = pe_[C.lane]; ne_hi = pe_[64 + C.lane]; nc_lo = co_[C.lane]; nc_hi = co_[64 + C.lane]; } } while (0)
    V_PREFETCH(G_ROW(0));
#ifdef PROBE_GSEL
    if (fuse_next || PROBE_GSEL == 2)
#endif
    for (int kr = 0; kr < nmine; ++kr) {
        const int row = G_ROW(kr);
        const int e_lo = ne_lo, e_hi = ne_hi;
        const float co_lo = nc_lo, co_hi = nc_hi;
        V_PREFETCH(G_ROW(kr + 1));
        if (fuse_next && l < DEPTH - 1 && !(kr & 1)) convert_tables(C, l + 1, kr >> 1, (kr >> 1) + 1);
        float cs; int pk_lo, pk_hi;
        {
            float am = fmaxf(fabsf(co_lo), fabsf(co_hi));
            am = fmaxf(am, DPPF(am, 0xB1)); am = fmaxf(am, DPPF(am, 0x4E)); am = fmaxf(am, DPPF(am, 0x141)); am = fmaxf(am, DPPF(am, 0x140));
            { const int iv = __builtin_bit_cast(int, am);
              am = fmaxf(fmaxf(__builtin_bit_cast(float, __builtin_amdgcn_readlane(iv, 0)), __builtin_bit_cast(float, __builtin_amdgcn_readlane(iv, 16))),
                         fmaxf(__builtin_bit_cast(float, __builtin_amdgcn_readlane(iv, 32)), __builtin_bit_cast(float, __builtin_amdgcn_readlane(iv, 48)))); }
            const float inv = am > 0.f ? 127.0f / am : 0.f; cs = am * (1.0f / 127.0f);
            const int sh = 8 * (C.lane & 3);
            int yl = (((int)rintf(co_lo * inv)) & 255) << sh, yh = (((int)rintf(co_hi * inv)) & 255) << sh;
            yl |= __builtin_amdgcn_update_dpp(0, yl, 0xB1, 0xf, 0xf, true); yl |= __builtin_amdgcn_update_dpp(0, yl, 0x4E, 0xf, 0xf, true);
            yh |= __builtin_amdgcn_update_dpp(0, yh, 0xB1, 0xf, 0xf, true); yh |= __builtin_amdgcn_update_dpp(0, yh, 0x4E, 0xf, 0xf, true);
            pk_lo = yl; pk_hi = yh;
        }
        int acc[16];
#pragma unroll
        for (int i = 0; i < 16; ++i) acc[i] = 0;
        const int mr = (row < NCTX) ? 4 : ((row - NCTX) >> 12);
        v4u* zp = (v4u*)(Zt + (size_t)row * DM) + 2 * C.lane;
        f32x4 zold[4], g2v[4], gpv[4], shv[4], scv[4], ppv[4];
        {
            const f32x4* g2 = (const f32x4*)(((float*)(C.ws + WS_MOD)) + ((size_t)(l * 5 + mr) * 6 + 5) * DM) + 4 * C.lane;
#pragma unroll
            for (int q = 0; q < 4; ++q) g2v[q] = g2[q];
            { const v4u za = zp[0], zb = zp[1];
              zold[0] = (f32x4){bflo(za.x), bfhi(za.x), bflo(za.y), bfhi(za.y)}; zold[1] = (f32x4){bflo(za.z), bfhi(za.z), bflo(za.w), bfhi(za.w)};
              zold[2] = (f32x4){bflo(zb.x), bfhi(zb.x), bflo(zb.y), bfhi(zb.y)}; zold[3] = (f32x4){bflo(zb.z), bfhi(zb.z), bflo(zb.w), bfhi(zb.w)}; }
            if (fuse_next) {
                if (l < DEPTH - 1) {
                    const int l1 = l + 1;
                    const f32x4* gp = (const f32x4*)(IN_(C, 6) + (size_t)l1 * DM) + 4 * C.lane;
                    const float* mb = ((float*)(C.ws + WS_MOD)) + ((size_t)(l1 * 5 + mr) * 6) * DM;
                    const f32x4* shp = (const f32x4*)mb + 4 * C.lane; const f32x4* scp = (const f32x4*)(mb + DM) + 4 * C.lane;
                    const int t = (row - NCTX) & 4095, seg = C.lane >> 4, p = (seg < 2) ? (t >> 6) : (t & 63);
                    const f32x4* pp = (const f32x4*)(((float*)(C.ws + WS_POS)) + (size_t)p * 512 + (seg & 1) * 256 + 16 * (C.lane & 15));
#pragma unroll
                    for (int q = 0; q < 4; ++q) { gpv[q] = gp[q]; shv[q] = shp[q]; scv[q] = scp[q]; ppv[q] = pp[q]; }
                } else {
                    const f32x4* gp = (const f32x4*)IN_(C, 28) + 4 * C.lane;
#pragma unroll
                    for (int q = 0; q < 4; ++q) gpv[q] = gp[q];
                }
            }
        }
        VBuf A, B;
        v_issue(A, 0, C.lane, e_lo, e_hi, VQ);
#pragma unroll
        for (int k = 0; k < 32; k += 2) {
            v_issue(B, k + 1, C.lane, e_lo, e_hi, VQ);
            v_compute(A, k, pk_lo, pk_hi, acc);
            if (k + 2 < 32) v_issue(A, k + 2, C.lane, e_lo, e_hi, VQ);
            v_compute(B, k + 1, pk_lo, pk_hi, acc);
        }
        float out[16];
#pragma unroll
        for (int i = 0; i < 16; ++i) out[i] = (float)acc[i] * cs;
        f32x4 zn[4]; float ss = 0.f;
#pragma unroll
        for (int q = 0; q < 4; ++q) { const f32x4 gg = g2v[q]; f32x4 z = zold[q];
            z.x += gg.x * out[4 * q]; z.y += gg.y * out[4 * q + 1]; z.z += gg.z * out[4 * q + 2]; z.w += gg.w * out[4 * q + 3];
            zn[q] = z; ss += (z.x * z.x + z.y * z.y) + (z.z * z.z + z.w * z.w); }
        if (l < DEPTH - 1 || !fuse_next) {
            v4u za, zb; za.x = pk2(zn[0].x, zn[0].y); za.y = pk2(zn[0].z, zn[0].w); za.z = pk2(zn[1].x, zn[1].y); za.w = pk2(zn[1].z, zn[1].w);
            zb.x = pk2(zn[2].x, zn[2].y); zb.y = pk2(zn[2].z, zn[2].w); zb.z = pk2(zn[3].x, zn[3].y); zb.w = pk2(zn[3].z, zn[3].w);
            zp[0] = za; zp[1] = zb;
        }
        if (fuse_next) {
            const float rs = __builtin_amdgcn_rsqf(wave_sum(ss) * (1.0f / DM) + EPS);
            if (l < DEPTH - 1) {
                unsigned w[8];
#pragma unroll
                for (int q = 0; q < 4; ++q) {
                    f32x4 o = (zn[q] * rs * gpv[q]) * (scv[q] + 1.0f) + shv[q];
                    if (row >= NCTX) o = o + ppv[q];
                    w[2 * q] = pk2(o.x, o.y); w[2 * q + 1] = pk2(o.z, o.w);
                }
                v4u* op = (v4u*)(((bf16*)(C.ws + WS_XN)) + (size_t)row * DM) + 2 * C.lane;
                v4u w0; w0.x = w[0]; w0.y = w[1]; w0.z = w[2]; w0.w = w[3]; v4u w1; w1.x = w[4]; w1.y = w[5]; w1.z = w[6]; w1.w = w[7];
                op[0] = w0; op[1] = w1;
            } else if (row >= NCTX) {
                f32x4* op = (f32x4*)(C.out + (size_t)(row - NCTX) * DM) + 4 * C.lane;
#pragma unroll
                for (int q = 0; q < 4; ++q) op[q] = zn[q] * rs * gpv[q];
            }
        }
    }
    if (fuse_next && l < DEPTH - 1) convert_tables(C, l + 1, (nmine + 1) >> 1, 64);
}

struct CtxEpiP { bf16* P; __device__ __forceinline__ void operator()(const f32x4 (&acc)[2][2], int m0, int n0, int fr, int fq) const {
#pragma unroll
    for (int mt = 0; mt < 2; ++mt)
#pragma unroll
        for (int nt = 0; nt < 2; ++nt) { const f32x4 v = acc[mt][nt]; v2u w; w.x = pk2(v[0], v[1]); w.y = pk2(v[2], v[3]);
            *(v2u*)(P + (size_t)(m0 + 16 * mt + fr) * PROJ + n0 + 16 * nt + 4 * fq) = w; } } };
struct CtxEpiResid { bf16* Z; const float* gate; __device__ __forceinline__ void operator()(const f32x4 (&acc)[2][2], int m0, int n0, int fr, int fq) const {
    v2u zv[2][2];
#pragma unroll
    for (int mt = 0; mt < 2; ++mt)
#pragma unroll
        for (int nt = 0; nt < 2; ++nt) zv[mt][nt] = *(const v2u*)(Z + (size_t)(m0 + 16 * mt + fr) * DM + n0 + 16 * nt + 4 * fq);
#pragma unroll
    for (int mt = 0; mt < 2; ++mt)
#pragma unroll
        for (int nt = 0; nt < 2; ++nt) { const f32x4 g = *(const f32x4*)(gate + n0 + 16 * nt + 4 * fq); const v2u z = zv[mt][nt]; const f32x4 a = g * acc[mt][nt];
            v2u w; w.x = pk2(bflo(z.x) + a[0], bfhi(z.x) + a[1]); w.y = pk2(bflo(z.y) + a[2], bfhi(z.y) + a[3]);
            *(v2u*)(Z + (size_t)(m0 + 16 * mt + fr) * DM + n0 + 16 * nt + 4 * fq) = w; } } };
struct CtxEpiScoreT { unsigned* S; __device__ __forceinline__ void operator()(const f32x4 (&acc)[2][2], int m0, int n0, int fr, int fq) const {
#pragma unroll
    for (int mt = 0; mt < 2; ++mt)
#pragma unroll
        for (int nt = 0; nt < 2; ++nt) { const int row = m0 + 16 * mt + fr, col = n0 + 16 * nt + 4 * fq, head = col >> 8, cn = col & 255; const f32x4 v = acc[mt][nt];
            unsigned* bp = S + ((size_t)((row >> 6) * 8 + head) * 256 + cn) * 64 + (row & 63);
            bp[0] = pg8::score_key(v[0], cn); bp[64] = pg8::score_key(v[1], cn + 1); bp[128] = pg8::score_key(v[2], cn + 2); bp[192] = pg8::score_key(v[3], cn + 3); } } };

template <class Epi>
__device__ __forceinline__ void ctx_gemm(const Ctx& C, const bf16* A, const bf16* Bt, int M, int N, const Epi& E) {
    constexpr int AST = 1032;
    LAS bf16* As = (LAS bf16*)C.lds;
    const int ntn = N >> 8, ntiles = (M >> 5) * ntn, fr = C.lane & 15, fq = C.lane >> 4;
    for (int t = C.bx; t < ntiles; t += C.G) {
        const int tm = t / ntn, tn = t - tm * ntn, m0 = tm * 32, n0 = tn * 256 + 32 * C.wave;
        const bf16* bp = Bt + (size_t)(n0 + fr) * 1024 + 8 * fq;
        bf16x8 B0[8][2], B1[8][2];
#define CG_LOAD(BUF, ch) do { _Pragma("unroll") for (int ks = 0; ks < 8; ++ks) _Pragma("unroll") for (int nt = 0; nt < 2; ++nt) \
            BUF[ks][nt] = *(const bf16x8*)(bp + (size_t)(16 * nt) * 1024 + 32 * (8 * (ch) + ks)); } while (0)
#define CG_COMP(BUF, ch) do { _Pragma("unroll") for (int ks = 0; ks < 8; ++ks) { const LAS bf16* ap = As + fr * AST + 32 * (8 * (ch) + ks) + 8 * fq; \
            const bf16x8 a0 = *(const LAS bf16x8*)ap, a1 = *(const LAS bf16x8*)(ap + 16 * AST); \
            _Pragma("unroll") for (int nt = 0; nt < 2; ++nt) { acc[0][nt] = MFMA16(BUF[ks][nt], a0, acc[0][nt]); acc[1][nt] = MFMA16(BUF[ks][nt], a1, acc[1][nt]); } } } while (0)
        CG_LOAD(B0, 0);
        {
            v4u tmp[8];
#pragma unroll
            for (int q = 0; q < 8; ++q) { const int idx = C.tid + 512 * q, r = idx >> 7, c8 = (idx & 127) * 8; tmp[q] = *(const v4u*)(A + (size_t)(m0 + r) * 1024 + c8); }
#pragma unroll
            for (int q = 0; q < 8; ++q) { const int idx = C.tid + 512 * q, r = idx >> 7, c8 = (idx & 127) * 8; *(LAS v4u*)(As + r * AST + c8) = tmp[q]; }
        }
        __syncthreads();
        f32x4 acc[2][2];
#pragma unroll
        for (int mt = 0; mt < 2; ++mt)
#pragma unroll
            for (int nt = 0; nt < 2; ++nt) acc[mt][nt] = (f32x4){0.f, 0.f, 0.f, 0.f};
        CG_LOAD(B1, 1); CG_COMP(B0, 0);
        CG_LOAD(B0, 2); CG_COMP(B1, 1);
        CG_LOAD(B1, 3); CG_COMP(B0, 2);
        CG_COMP(B1, 3);
#undef CG_LOAD
#undef CG_COMP
        E(acc, m0, n0, fr, fq);
        __syncthreads();
    }
}

#ifndef PROBE_PHASE
#define PROBE_PHASE -1
#define PROBE_REP 0
#endif
#ifndef PGA
#define PGA true
#endif
#ifndef PGS
#define PGS true
#endif
#ifndef PROBE_P0MASK
#define PROBE_P0MASK 15
#endif
#ifndef PROBE_MIXSEL
#define PROBE_MIXSEL 0
#endif
struct Args { const float* in[29]; float* out; unsigned char* ws; int ph_lo, ph_hi; };
__global__ void __launch_bounds__(512, 2) mk_fwd(Args args) {
    extern __shared__ __attribute__((aligned(16))) unsigned char lds_raw[];
    {
        LAS unsigned char* l0 = (LAS unsigned char*)lds_raw;
        for (int u = threadIdx.x; u < (LDS_BYTES - LDSCTL_OFF) / 4; u += 512) ((LAS unsigned*)(l0 + LDSCTL_OFF))[u] = 0u;
        __syncthreads();
    }
    const int lo = args.ph_lo, hi = args.ph_hi;
    XcdBarrier bar; bar.bar = (unsigned*)(args.ws + WS_CTL) + CW_BAR; bar.x = 0; bar.st = nullptr;
    if (hi - lo > 1) bar = xcd_barrier_post((unsigned*)(args.ws + WS_CTL) + CW_BAR, (volatile LAS unsigned*)((LAS unsigned char*)lds_raw + MISC_OFF) + 8);

#if PROBE_REP > 0
    int ph = lo, rep = 0;
#else
    int ph = lo; constexpr int rep = 0;
#endif
    while (ph < hi) {
        int tid = threadIdx.x; asm volatile("" : "+v"(tid));
        int bx = blockIdx.x; asm volatile("" : "+s"(bx));
        const AS4 unsigned char* kp = (const AS4 unsigned char*)__builtin_amdgcn_kernarg_segment_ptr(); asm volatile("" : "+s"(kp));
        Ctx C;
        unsigned ldsoff = 0; asm volatile("" : "+s"(ldsoff));
        C.lds = (LAS unsigned char*)lds_raw + ldsoff;
        C.tid = tid; C.lane = tid & 63; C.wave = __builtin_amdgcn_readfirstlane(tid >> 6);
        C.G = gridDim.x; C.bx = bx; C.vcu = (C.G % 8 == 0) ? (bx % 8) * (C.G / 8) + bx / 8 : bx;
        C.kp = kp; C.out = *(float* const AS4*)(kp + 232); C.ws = *(unsigned char* const AS4*)(kp + 240);
        if (ph == 0) { const int m1 = (C.bx & 1) ? 12 : 3; phase_p0a(C, m1); phase_p0a(C, 15 ^ m1); if (PROBE_PHASE == 100) { xcd_barrier(bar); phase_p0a(C, PROBE_P0MASK & m1); phase_p0a(C, PROBE_P0MASK & (15 ^ m1)); } }
        else if (ph == 1) { phase_p0b(C); if (PROBE_PHASE == 200) { for (int q = 0; q < 32; ++q) xcd_barrier(bar); } }
        else if (ph == 2) phase_rows<0>(C, 0, 0);
        else {
            const int l = (ph - 3) / 11, st = (ph - 3) % 11;
            const int s = (st < 2) ? 1 : (st < 4) ? st : (st < 6) ? 4 : (st == 6) ? 5 : (st < 9) ? 6 : st - 2;
            const bool tail = (st == 1 || st == 5 || st == 8);
            bf16* Zt = (rep > 0) ? (bf16*)(C.ws + WS_SC) : (bf16*)(C.ws + WS_Z);
            if (s == 1 && !tail) { pg8::Gemm g{((bf16*)(C.ws + WS_XN)) + (size_t)NCTX * DM, ((bf16*)(C.ws + WS_WIN)) + (size_t)l * 2048 * 1024, NLAT, 2048, 1024}; pg8::StaticOrder S; S.init(NLAT, 2048, C.G, C.bx);
                pg8::EpiBf16 E{((bf16*)(C.ws + WS_P)) + (size_t)NCTX * PROJ, PROJ}; pg8::gemm_phase<pg8::EpiBf16, pg8::StaticOrder, PGA, PGS>(C.lds, g, S, E, C.tid); }
            else if (s == 1) {
                CtxEpiP EC{(bf16*)(C.ws + WS_P)}; ctx_gemm(C, (const bf16*)(C.ws + WS_XN), ((const bf16*)(C.ws + WS_WIN)) + (size_t)l * 2048 * 1024, NCTX, (l == DEPTH - 1) ? 256 : 2048, EC); }
            else if (s == 2) phase_mixers(C, l, rep > 0 ? PROBE_MIXSEL : 0);
            else if (s == 3) phase_fixup(C, l);
            else if (s == 4 && !tail) { const int r0 = NCTX;
                pg8::Gemm g{((bf16*)(C.ws + WS_Y)) + (size_t)r0 * DM, ((bf16*)(C.ws + WS_WOUT)) + (size_t)l * 1024 * 1024, NTOK - r0, 1024, 1024}; pg8::StaticOrder S; S.init(NTOK - r0, 1024, C.G, C.bx);
                pg8::EpiResid E{Zt + (size_t)r0 * DM, DM, ((float*)(C.ws + WS_MOD)) + ((size_t)(l * 5) * 6 + 2) * DM, 6 * DM, r0 / 256}; pg8::gemm_phase<pg8::EpiResid, pg8::StaticOrder, PGA, PGS>(C.lds, g, S, E, C.tid); }
            else if (s == 4) { if (l < DEPTH - 1) { CtxEpiResid EC{Zt, ((float*)(C.ws + WS_MOD)) + ((size_t)(l * 5 + 4) * 6 + 2) * DM}; ctx_gemm(C, (const bf16*)(C.ws + WS_Y), ((const bf16*)(C.ws + WS_WOUT)) + (size_t)l * 1024 * 1024, NCTX, 1024, EC); } }
            else if (s == 5) phase_rows<1>(C, l, (l == DEPTH - 1) ? NCTX : 0);
            else if (s == 6 && !tail) { const int r0 = NCTX;
                pg8::Gemm g{((bf16*)(C.ws + WS_XN)) + (size_t)r0 * DM, ((bf16*)(C.ws + WS_WCMB)) + (size_t)l * 2048 * 1024, NTOK - r0, 2048, 1024}; pg8::StaticOrder S; S.init(NTOK - r0, 2048, C.G, C.bx);
                pg8::EpiScoreT E{((unsigned*)(C.ws + WS_SC)), r0}; pg8::gemm_phase<pg8::EpiScoreT, pg8::StaticOrder, PGA, PGS>(C.lds, g, S, E, C.tid); }
            else if (s == 6) { if (l < DEPTH - 1) { CtxEpiScoreT EC{(unsigned*)(C.ws + WS_SC)}; ctx_gemm(C, (const bf16*)(C.ws + WS_XN), ((const bf16*)(C.ws + WS_WCMB)) + (size_t)l * 2048 * 1024, NCTX, 2048, EC); } }
            else if (s == 7) phase_topk(C, (l == DEPTH - 1) ? NCTX : 0);
            else phase_gather(C, l, Zt, rep == 0, (l == DEPTH - 1) ? NCTX : 0);
        }
        bool need_bar = true;
#if PROBE_REP > 0
        { const int st_ = (ph >= 3) ? (ph - 3) % 11 : -1;
          const int s_ = (st_ < 0) ? -1 : (st_ < 2) ? 1 : (st_ < 4) ? st_ : (st_ < 6) ? 4 : (st_ == 6) ? 5 : (st_ < 9) ? 6 : st_ - 2;
          const bool main_gemm = (st_ == 0 || st_ == 4 || st_ == 7);
          if (PROBE_PHASE == 11 && st_ == 1 && rep < PROBE_REP) ++rep;
          else if (PROBE_PHASE == 11) { ++ph; rep = 0; if (main_gemm) need_bar = false; }
          else if (s_ == PROBE_PHASE && rep < PROBE_REP && !main_gemm && st_ != 1 && st_ != 5 && st_ != 8) ++rep;
          else if (s_ == PROBE_PHASE && rep < PROBE_REP && (st_ == 1 || st_ == 5 || st_ == 8)) { ++rep; --ph; }
          else { ++ph; rep = (main_gemm ? rep : 0); if (main_gemm) need_bar = false; } }
#else
        { const int st_ = (ph >= 3) ? (ph - 3) % 11 : -1; need_bar = !(st_ == 0 || st_ == 4 || st_ == 7); ++ph; }
#endif
        if (ph < hi && need_bar) xcd_barrier(bar);
    }
}

extern "C" void kernel_launch(void* const* d_in, const int* in_sizes, int n_in, void* d_out, int out_size, void* d_ws, size_t ws_size, hipStream_t stream) {
    static int grid = 0;
    if (grid == 0) {
        if (n_in != 29 || out_size != NLAT * DM || ws_size < WS_END) { fprintf(stderr, "kernel_launch: unexpected shapes (n_in %d, out %d, ws %zu)\n", n_in, out_size, ws_size); grid = -1; return; }
        int dev = 0, cus = 0, per_cu = 0;
        if (hipGetDevice(&dev) != hipSuccess || hipDeviceGetAttribute(&cus, hipDeviceAttributeMultiprocessorCount, dev) != hipSuccess) { grid = -1; return; }
        if (hipFuncSetAttribute((const void*)mk_fwd, hipFuncAttributeMaxDynamicSharedMemorySize, LDS_BYTES) != hipSuccess) { fprintf(stderr, "kernel_launch: hipFuncSetAttribute failed\n"); grid = -1; return; }
        if (hipOccupancyMaxActiveBlocksPerMultiprocessor(&per_cu, (const void*)mk_fwd, 512, LDS_BYTES) != hipSuccess || per_cu < 1) { fprintf(stderr, "kernel_launch: occupancy query says %d blocks per CU\n", per_cu); (void)hipGetLastError(); grid = -1; return; }
        grid = cus;
    }
    if (grid < 0) return;
    if (hipMemsetAsync((char*)d_ws + WS_CTL, 0, CTL_ZERO_BYTES, stream) != hipSuccess) return;
    Args a{};
    for (int i = 0; i < 29; ++i) a.in[i] = (const float*)d_in[i];
    a.out = (float*)d_out; a.ws = (unsigned char*)d_ws;
#if MK_SINGLE
    a.ph_lo = 0; a.ph_hi = NPH;
    void* kargs[] = {&a};
    hipError_t le = hipLaunchCooperativeKernel((const void*)mk_fwd, dim3(grid), dim3(512), kargs, LDS_BYTES, stream);
    if (le != hipSuccess) fprintf(stderr, "kernel_launch: cooperative launch failed: %s (grid %d)\n", hipGetErrorName(le), grid);
#else
    for (int ph = 0; ph < NPH; ++ph) {
        a.ph_lo = ph; a.ph_hi = ph + 1;
        hipLaunchKernelGGL(mk_fwd, dim3(grid), dim3(512), LDS_BYTES, stream, a);
    }
#endif
}
```

```cpp
#include <hip/hip_runtime.h>
#include <cstdio>
#include <cstdint>

#ifndef MK_SINGLE
#define MK_SINGLE 1
#endif

namespace pg8 {
#define PG8_LAS __attribute__((address_space(3)))
typedef unsigned short bf16_t;
typedef short bf16x8 __attribute__((ext_vector_type(8)));
typedef float f32x4 __attribute__((ext_vector_type(4)));
typedef unsigned u32x4 __attribute__((ext_vector_type(4)));
constexpr int BM = 256, BK = 64, HALF = 128, HTB = HALF * BK * 2  , STAGE_BYTES = 8 * HTB, NXCD = 8, WGM = 8;

__host__ __device__ __forceinline__ int lds_byte(int r, int c) { const int st = (r >> 4) * 2 + (c >> 5), rr = r & 15, cc = c & 31, ob = rr * 64 + cc * 2; return st * 1024 + (ob ^ (((ob >> 9) & 1) << 5)); }
__host__ __device__ __forceinline__ void stage_rc(int b, int& R, int& C) { const int st = b / 1024, sb = b % 1024, swz = sb ^ (((sb >> 9) & 1) << 5); R = (st >> 1) * 16 + swz / 64; C = (st & 1) * 32 + (swz % 64) / 2; }
__host__ __device__ __forceinline__ int perm32(int rho) { const int n = rho >> 4, i = rho & 15; return 8 * (i >> 2) + 4 * n + (i & 3); }

struct Unit { int pm, pn; };
struct Gemm { const bf16_t* A; const bf16_t* Bt; int M, N, K; };

struct StaticOrder {
    int nM, nN, nwg, G, c;
    __host__ __device__ void init(int M, int N, int G_, int c_) { nM = M / BM; nN = N / BM; nwg = nM * nN; G = G_; c = c_; }
    __host__ __device__ bool next(int i, Unit& u) const {
        const long L = (long)i * G + c; if (L >= nwg) return false;
        int wgid = (int)L; { const int q = nwg / NXCD, r = nwg % NXCD, xcd = wgid % NXCD, off = wgid / NXCD; wgid = (xcd < r ? xcd * (q + 1) : r * (q + 1) + (xcd - r) * q) + off; }
        const int nig = WGM * nN, gid = wgid / nig, fm = gid * WGM, gsz = (nM - fm) < WGM ? (nM - fm) : WGM;
        u.pm = fm + ((wgid % nig) % gsz); u.pn = (wgid % nig) / gsz; return true;
    }
    __device__ __forceinline__ void a_ready(const Unit&) const {}
    __device__ __forceinline__ void done(const Unit&) const {}
};

__device__ __forceinline__ unsigned cvt_pk_bf16(float lo, float hi) { unsigned r; asm volatile("v_cvt_pk_bf16_f32 %0, %1, %2" : "=v"(r) : "v"(lo), "v"(hi)); return r; }

struct EpiBf16 {
    static constexpr bool PERM = true, AFTER_DRAIN = false;
    bf16_t* O; int ldc;
    __device__ __forceinline__ void operator()(const f32x4 (&acc)[2][2][4][2], const Unit& u, int wr, int wc, int fr, int fq) const {
        const int row0 = u.pm * BM + wr * 64 + fr; const int col0 = u.pn * BM + wc * 32 + 8 * fq;
#pragma unroll
        for (int ai = 0; ai < 2; ++ai)
#pragma unroll
            for (int m = 0; m < 4; ++m) { bf16_t* rowp = O + (size_t)(row0 + ai * HALF + m * 16) * ldc + col0;
#pragma unroll
                for (int bj = 0; bj < 2; ++bj) { const f32x4 v0 = acc[ai][bj][m][0], v1 = acc[ai][bj][m][1];
                    u32x4 w; w.x = cvt_pk_bf16(v0[0], v0[1]); w.y = cvt_pk_bf16(v0[2], v0[3]); w.z = cvt_pk_bf16(v1[0], v1[1]); w.w = cvt_pk_bf16(v1[2], v1[3]);
                    *(u32x4*)(rowp + bj * HALF) = w; } }
    }
};
struct EpiF32 {
    static constexpr bool PERM = false, AFTER_DRAIN = false;
    float* C; int ldc;
    __device__ __forceinline__ void operator()(const f32x4 (&acc)[2][2][4][2], const Unit& u, int wr, int wc, int fr, int fq) const {
        const int row0 = u.pm * BM + wr * 64 + fr, col0 = u.pn * BM + wc * 32 + 4 * fq;
#pragma unroll
        for (int ai = 0; ai < 2; ++ai)
#pragma unroll
            for (int m = 0; m < 4; ++m) { float* rowp = C + (size_t)(row0 + ai * HALF + m * 16) * ldc + col0;
#pragma unroll
                for (int bj = 0; bj < 2; ++bj)
#pragma unroll
                    for (int n = 0; n < 2; ++n) *(f32x4*)(rowp + bj * HALF + n * 16) = acc[ai][bj][m][n]; }
    }
};
struct EpiResid {
    static constexpr bool PERM = true, AFTER_DRAIN = false;
    unsigned short* Z; int ldc; const float* gate0; int gstride; int pmoff;
    __device__ __forceinline__ void operator()(const f32x4 (&acc)[2][2][4][2], const Unit& u, int wr, int wc, int fr, int fq) const {
        const int row0 = u.pm * BM + wr * 64 + fr, col0 = u.pn * BM + wc * 32 + 8 * fq;
        const int pmg = u.pm + pmoff; const int mr = (pmg < 4) ? 4 : ((pmg - 4) >> 4);
        const float* gp = gate0 + (size_t)mr * gstride + col0;
        f32x4 gv[2][2];
#pragma unroll
        for (int bj = 0; bj < 2; ++bj)
#pragma unroll
            for (int n = 0; n < 2; ++n) gv[bj][n] = *(const f32x4*)(gp + bj * HALF + n * 4);
#pragma unroll
        for (int ai = 0; ai < 2; ++ai) {
            u32x4 zv[4][2];
#pragma unroll
            for (int m = 0; m < 4; ++m)
#pragma unroll
                for (int bj = 0; bj < 2; ++bj) zv[m][bj] = *(const u32x4*)(Z + (size_t)(row0 + ai * HALF + m * 16) * ldc + col0 + bj * HALF);
#pragma unroll
            for (int m = 0; m < 4; ++m)
#pragma unroll
                for (int bj = 0; bj < 2; ++bj) { const u32x4 z = zv[m][bj]; const f32x4 a0 = acc[ai][bj][m][0] * gv[bj][0], a1 = acc[ai][bj][m][1] * gv[bj][1];
                    u32x4 w;
                    w.x = cvt_pk_bf16(__builtin_bit_cast(float, z.x << 16) + a0[0], __builtin_bit_cast(float, z.x & 0xffff0000u) + a0[1]);
                    w.y = cvt_pk_bf16(__builtin_bit_cast(float, z.y << 16) + a0[2], __builtin_bit_cast(float, z.y & 0xffff0000u) + a0[3]);
                    w.z = cvt_pk_bf16(__builtin_bit_cast(float, z.z << 16) + a1[0], __builtin_bit_cast(float, z.z & 0xffff0000u) + a1[1]);
                    w.w = cvt_pk_bf16(__builtin_bit_cast(float, z.w << 16) + a1[2], __builtin_bit_cast(float, z.w & 0xffff0000u) + a1[3]);
                    *(u32x4*)(Z + (size_t)(row0 + ai * HALF + m * 16) * ldc + col0 + bj * HALF) = w; }
        }
    }
};

__device__ __forceinline__ unsigned score_key(float x, int n) { const int u = __builtin_bit_cast(int, x); return ((unsigned)(u ^ ((u >> 31) | (int)0x80000000)) & ~127u) | (unsigned)(127 - (n & 127)); }
struct EpiScoreT {
    static constexpr bool PERM = false, AFTER_DRAIN = false;
    unsigned* S; int row_base;
    __device__ __forceinline__ void operator()(const f32x4 (&acc)[2][2][4][2], const Unit& u, int wr, int wc, int fr, int fq) const {
        int cn0 = wc * 32 + 4 * fq; asm volatile("" : "+v"(cn0));
        const int row0 = row_base + u.pm * BM + wr * 64 + fr, head = u.pn;
        const unsigned ib = (unsigned)(127 - cn0);
#pragma unroll
        for (int ai = 0; ai < 2; ++ai)
#pragma unroll
            for (int m = 0; m < 4; ++m) { const int row = row0 + ai * HALF + m * 16;
                unsigned* bp = S + ((size_t)((row >> 6) * 8 + head) * 256) * 64 + (row & 63) + (size_t)cn0 * 64;
#pragma unroll
                for (int bj = 0; bj < 2; ++bj)
#pragma unroll
                    for (int n = 0; n < 2; ++n) { const f32x4 v = acc[ai][bj][m][n]; unsigned* q = bp + (size_t)(bj * HALF + n * 16) * 64;
#pragma unroll
                        for (int e2 = 0; e2 < 4; ++e2) q[e2 * 64] = score_key(v[e2], cn0 + bj * HALF + n * 16 + e2); }
                asm volatile("" ::: "memory"); }
    }
};

template <class Epi, class Sched, bool ALIGN_EPI = false, bool SP2 = false>
__device__ __forceinline__ void gemm_phase(PG8_LAS unsigned char* lds, const Gemm g, const Sched& S, const Epi& E, const int tid) {
    const int wid = __builtin_amdgcn_readfirstlane(tid >> 6), lane = tid & 63, wr = wid >> 2, wc = wid & 3, fr = lane & 15, fq = lane >> 4;
    const int K = g.K, nt = K / BK;
    unsigned voffA[2], voffB[2];
#pragma unroll
    for (int i = 0; i < 2; ++i) { int R, C; stage_rc(tid * 16 + i * 8192, R, C); const int Rb = Epi::PERM ? ((R & ~31) + perm32(R & 31)) : R;
        voffA[i] = (unsigned)(R * K + C) * 2u; voffB[i] = (unsigned)(Rb * K + C) * 2u; }
    const size_t kstep = (size_t)(BK * 2);
    const size_t hstep = (size_t)HALF * K * 2;
    const size_t tstep = 2 * hstep;
    const unsigned ldsw = (unsigned)wid * 1024u;
    const int aoff = lds_byte(wr * 64 + fr, fq * 8), boff = lds_byte(wc * 32 + fr, fq * 8);
#define PG8_SA(b, h) (((b) * 2 + (h)) * HTB)
#define PG8_SB(b, h) ((4 + (b) * 2 + (h)) * HTB)
#define PG8_STAGE(bufoff, gbase, voff) do { _Pragma("unroll") for (int _i = 0; _i < 2; ++_i) \
        __builtin_amdgcn_global_load_lds((const unsigned*)((const char*)(gbase) + (voff)[_i]), (PG8_LAS unsigned*)(lds + (bufoff) + ldsw + _i * 8192), 16, 0, 0); } while (0)
#define PG8_LDA(dst, b, h) do { _Pragma("unroll") for (int m = 0; m < 4; ++m) _Pragma("unroll") for (int k = 0; k < 2; ++k) dst[m][k] = *(const PG8_LAS bf16x8*)(lds + PG8_SA(b, h) + aoff + m * 2048 + k * 1024); } while (0)
#define PG8_LDB(dst, b, h) do { _Pragma("unroll") for (int n = 0; n < 2; ++n) _Pragma("unroll") for (int k = 0; k < 2; ++k) dst[n][k] = *(const PG8_LAS bf16x8*)(lds + PG8_SB(b, h) + boff + n * 2048 + k * 1024); } while (0)
#define PG8_MMA(ai, bj, At, Bt) do { __builtin_amdgcn_s_setprio(1); _Pragma("unroll") for (int m = 0; m < 4; ++m) _Pragma("unroll") for (int n = 0; n < 2; ++n) _Pragma("unroll") for (int k = 0; k < 2; ++k) \
        acc[ai][bj][m][n] = __builtin_amdgcn_mfma_f32_16x16x32_bf16(Bt[n][k], At[m][k], acc[ai][bj][m][n], 0, 0, 0); __builtin_amdgcn_s_setprio(0); } while (0)
#define PG8_WAIT_V(n) asm volatile("s_waitcnt vmcnt(" #n ")" ::: "memory")
#define PG8_WAIT_L(n) asm volatile("s_waitcnt lgkmcnt(" #n ")" ::: "memory")
#define PG8_BAR __builtin_amdgcn_s_barrier()
#define PG8_SCHED __builtin_amdgcn_sched_barrier(0)
    Unit cur, nxt; int ui = 0;
    if (!S.next(0, cur)) return;
    f32x4 acc[2][2][4][2];
#pragma unroll
    for (int a = 0; a < 2; ++a)
#pragma unroll
        for (int b = 0; b < 2; ++b)
#pragma unroll
            for (int m = 0; m < 4; ++m)
#pragma unroll
                for (int n = 0; n < 2; ++n) acc[a][b][m][n] = (f32x4){0.f, 0.f, 0.f, 0.f};
    bf16x8 At[4][2], B0[2][2], B1[2][2];
    const char* cA = (const char*)g.A + (size_t)cur.pm * tstep; const char* cB = (const char*)g.Bt + (size_t)cur.pn * tstep;
    S.a_ready(cur);
    if constexpr (SP2) {
        PG8_STAGE(PG8_SB(0, 0), cB, voffB); PG8_STAGE(PG8_SB(0, 1), cB + hstep, voffB); PG8_STAGE(PG8_SA(0, 0), cA, voffA); PG8_STAGE(PG8_SA(0, 1), cA + hstep, voffA);
        if (wr == 1) PG8_BAR;
        PG8_WAIT_V(2); PG8_BAR;
        PG8_STAGE(PG8_SB(1, 0), cB + kstep, voffB); PG8_STAGE(PG8_SA(1, 0), cA + kstep, voffA); PG8_STAGE(PG8_SB(1, 1), cB + hstep + kstep, voffB);
        PG8_WAIT_V(6); PG8_BAR;
    } else {
        PG8_STAGE(PG8_SB(0, 0), cB, voffB); PG8_STAGE(PG8_SA(0, 0), cA, voffA); PG8_STAGE(PG8_SB(0, 1), cB + hstep, voffB); PG8_STAGE(PG8_SA(0, 1), cA + hstep, voffA);
        if (wr == 1) PG8_BAR;
        PG8_WAIT_V(4); PG8_BAR;
        PG8_STAGE(PG8_SB(1, 0), cB + kstep, voffB); PG8_STAGE(PG8_SA(1, 0), cA + kstep, voffA); PG8_STAGE(PG8_SB(1, 1), cB + hstep + kstep, voffB);
        PG8_WAIT_V(6); PG8_BAR;
    }
    for (;;) {
        const bool has_next = S.next(ui + 1, nxt);
        const char* nA = has_next ? (const char*)g.A + (size_t)nxt.pm * tstep : cA; const char* nB = has_next ? (const char*)g.Bt + (size_t)nxt.pn * tstep : cB;
        for (int t = 0; t < nt; t += 2) {
            const bool last = (t == nt - 2);
            const char* a1 = cA + (size_t)(t + 1) * kstep;
            const char* a2 = last ? nA : cA + (size_t)(t + 2) * kstep; const char* b2 = last ? nB : cB + (size_t)(t + 2) * kstep;
            const char* a3 = a2 + kstep; const char* b3 = b2 + kstep;
            if (last && has_next) S.a_ready(nxt);
            if constexpr (SP2) {
            PG8_LDB(B0, 0, 0); PG8_LDB(B1, 0, 1); PG8_SCHED; PG8_LDA(At, 0, 0); PG8_STAGE(PG8_SA(1, 1), a1 + hstep, voffA);
            PG8_WAIT_V(8); PG8_WAIT_L(0); PG8_BAR; PG8_MMA(0, 0, At, B0); PG8_MMA(0, 1, At, B1); PG8_BAR; PG8_SCHED;
            PG8_LDA(At, 0, 1); PG8_STAGE(PG8_SB(0, 0), b2, voffB); PG8_STAGE(PG8_SB(0, 1), b2 + hstep, voffB); PG8_STAGE(PG8_SA(0, 0), a2, voffA);
            PG8_WAIT_V(8); PG8_WAIT_L(0); PG8_BAR; PG8_MMA(1, 0, At, B0); PG8_MMA(1, 1, At, B1); PG8_BAR; PG8_SCHED;
            PG8_LDB(B0, 1, 0); PG8_LDB(B1, 1, 1); PG8_SCHED; PG8_LDA(At, 1, 0); PG8_STAGE(PG8_SA(0, 1), a2 + hstep, voffA);
            PG8_WAIT_V(8); PG8_WAIT_L(0); PG8_BAR; PG8_MMA(0, 0, At, B0); PG8_MMA(0, 1, At, B1); PG8_BAR; PG8_SCHED;
            PG8_LDA(At, 1, 1); PG8_STAGE(PG8_SB(1, 0), b3, voffB); PG8_STAGE(PG8_SB(1, 1), b3 + hstep, voffB); PG8_STAGE(PG8_SA(1, 0), a3, voffA);
            PG8_WAIT_V(8); PG8_WAIT_L(0); PG8_BAR; PG8_MMA(1, 0, At, B0); PG8_MMA(1, 1, At, B1); PG8_BAR; PG8_SCHED;
            } else {
            PG8_LDB(B0, 0, 0); PG8_SCHED; PG8_LDA(At, 0, 0); PG8_STAGE(PG8_SA(1, 1), a1 + hstep, voffA);
            PG8_WAIT_L(8); PG8_BAR; PG8_WAIT_L(0); PG8_MMA(0, 0, At, B0); PG8_BAR; PG8_SCHED;
            PG8_LDB(B1, 0, 1); PG8_STAGE(PG8_SB(0, 0), b2, voffB);
            PG8_BAR; PG8_WAIT_L(0); PG8_MMA(0, 1, At, B1); PG8_BAR;
            PG8_LDA(At, 0, 1); PG8_STAGE(PG8_SA(0, 0), a2, voffA);
            PG8_BAR; PG8_WAIT_L(0); PG8_MMA(1, 0, At, B0); PG8_BAR; PG8_SCHED;
            PG8_STAGE(PG8_SB(0, 1), b2 + hstep, voffB);
            PG8_WAIT_V(6); PG8_BAR; PG8_MMA(1, 1, At, B1); PG8_BAR;
            PG8_LDB(B0, 1, 0); PG8_SCHED; PG8_LDA(At, 1, 0); PG8_STAGE(PG8_SA(0, 1), a2 + hstep, voffA);
            PG8_WAIT_L(8); PG8_BAR; PG8_WAIT_L(0); PG8_MMA(0, 0, At, B0); PG8_BAR; PG8_SCHED;
            PG8_LDB(B1, 1, 1); PG8_STAGE(PG8_SB(1, 0), b3, voffB);
            PG8_BAR; PG8_WAIT_L(0); PG8_MMA(0, 1, At, B1); PG8_BAR;
            PG8_LDA(At, 1, 1); PG8_STAGE(PG8_SA(1, 0), a3, voffA);
            PG8_BAR; PG8_WAIT_L(0); PG8_MMA(1, 0, At, B0); PG8_BAR; PG8_SCHED;
            PG8_STAGE(PG8_SB(1, 1), b3 + hstep, voffB);
            PG8_WAIT_V(6); PG8_BAR; PG8_MMA(1, 1, At, B1); PG8_BAR;
            }
        }
        if constexpr (ALIGN_EPI) { if (wr == 0) PG8_BAR; }
        if constexpr (!Epi::AFTER_DRAIN) { E(acc, cur, wr, wc, fr, fq); S.done(cur); }
        if (!has_next) break;
#pragma unroll
        for (int a = 0; a < 2; ++a)
#pragma unroll
            for (int b = 0; b < 2; ++b)
#pragma unroll
                for (int m = 0; m < 4; ++m)
#pragma unroll
                    for (int n = 0; n < 2; ++n) acc[a][b][m][n] = (f32x4){0.f, 0.f, 0.f, 0.f};
        cur = nxt; cA = nA; cB = nB; ++ui;
        if constexpr (ALIGN_EPI) { if (wr == 1) PG8_BAR; }
    }
    PG8_WAIT_V(0);
    if constexpr (!ALIGN_EPI) { if (wr == 0) PG8_BAR; }
    PG8_BAR;
    if constexpr (Epi::AFTER_DRAIN) { E.fused(acc, cur, wr, wc, fr, fq, lds, wid, lane); S.done(cur); }
#undef PG8_SA
#undef PG8_SB
#undef PG8_STAGE
#undef PG8_LDA
#undef PG8_LDB
#undef PG8_MMA
#undef PG8_WAIT_V
#undef PG8_WAIT_L
#undef PG8_BAR
#undef PG8_SCHED
}
}

constexpr int DM = 1024, NB = 4, SEQ = 4096, DEPTH = 4, CTXL = 256;
constexpr int NCTX = NB * CTXL, NLAT = NB * SEQ, NTOK = NCTX + NLAT;
constexpr int PROJ = 2048, NEXP = 16384, NPICK = 128;
constexpr int NCHUNK = NTOK / 128;
constexpr float EPS = 1e-6f;
constexpr int NPH = 3 + 11 * DEPTH;

constexpr size_t MiB = 1u << 20;
constexpr size_t WS_CTL = 0, CTL_ZERO_BYTES = 1 * MiB;
constexpr size_t WS_MODP = 616 * MiB;
constexpr size_t WS_MOD  = 5 * MiB;
constexpr size_t WS_POS  = 6 * MiB;
constexpr size_t WS_AGG  = 7 * MiB;
constexpr size_t WS_WIN  = 8 * MiB;
constexpr size_t WS_WOUT = 24 * MiB;
constexpr size_t WS_WCMB = 32 * MiB;
constexpr size_t WS_PE   = 48 * MiB;
constexpr size_t WS_PC   = 58 * MiB;
constexpr size_t WS_Z    = 72 * MiB;
constexpr size_t WS_XN   = 140 * MiB;
constexpr size_t WS_P    = 176 * MiB;
constexpr size_t WS_Y    = 244 * MiB;
constexpr size_t WS_HS   = 280 * MiB;
constexpr size_t WS_SC   = 348 * MiB;
constexpr size_t WS_UQ   = 484 * MiB;
constexpr size_t WS_VQ   = 548 * MiB;
constexpr size_t WS_US   = 612 * MiB;
constexpr size_t WS_VS   = 613 * MiB;
constexpr size_t WS_SGW  = 614 * MiB;
constexpr size_t WS_CO   = 632 * MiB;
constexpr size_t WS_FQ   = 641 * MiB;
constexpr size_t WS_FS   = 658 * MiB;
constexpr size_t WS_END  = 659 * MiB;
constexpr int CW_BAR = 4096;

constexpr int RING_BYTES = 131072;
constexpr int LDS_BYTES = 163840;
constexpr int LDSCTL_OFF = LDS_BYTES - 1024, MISC_OFF = LDSCTL_OFF + 320;

#define LAS __attribute__((address_space(3)))
typedef unsigned short bf16;
typedef unsigned v4u __attribute__((ext_vector_type(4)));
typedef unsigned v2u __attribute__((ext_vector_type(2)));
typedef int v4i __attribute__((ext_vector_type(4)));
typedef float f32x4 __attribute__((ext_vector_type(4)));
#define LDS_WAIT() asm volatile("s_waitcnt lgkmcnt(0)" ::: "memory")

__device__ __forceinline__ unsigned f2bf(float f) { unsigned u = __builtin_bit_cast(unsigned, f); return (u + 0x7fffu + ((u >> 16) & 1u)) >> 16; }
__device__ __forceinline__ unsigned pk2(float lo, float hi) { return f2bf(lo) | (f2bf(hi) << 16); }
__device__ __forceinline__ float bf2f(unsigned short b) { return __builtin_bit_cast(float, ((unsigned)b) << 16); }
__device__ __forceinline__ float bflo(unsigned w) { return __builtin_bit_cast(float, w << 16); }
__device__ __forceinline__ float bfhi(unsigned w) { return __builtin_bit_cast(float, w & 0xffff0000u); }
__device__ __forceinline__ float gelu_t(float x) {
    const float u = 0.7978845608028654f * (x + 0.044715f * x * x * x);
    const float e = expf(2.f * u);
    const float t = 1.f - 2.f / (e + 1.f);
    return 0.5f * x * (1.f + t);
}
__device__ __forceinline__ float sigmoid_f(float x) { return 1.f / (1.f + expf(-x)); }
#define DPPF(x, ctrl) __builtin_bit_cast(float, __builtin_amdgcn_update_dpp(0, __builtin_bit_cast(int, (x)), (ctrl), 0xf, 0xf, true))
__device__ __forceinline__ float wave_sum(float v) {
    v += DPPF(v, 0xB1); v += DPPF(v, 0x4E); v += DPPF(v, 0x141); v += DPPF(v, 0x140);
    const int iv = __builtin_bit_cast(int, v);
    const float r0 = __builtin_bit_cast(float, __builtin_amdgcn_readlane(iv, 0)), r1 = __builtin_bit_cast(float, __builtin_amdgcn_readlane(iv, 16)),
                r2 = __builtin_bit_cast(float, __builtin_amdgcn_readlane(iv, 32)), r3 = __builtin_bit_cast(float, __builtin_amdgcn_readlane(iv, 48));
    return (r0 + r1) + (r2 + r3);
}

__device__ __forceinline__ void wave_sum2(float& a, float& b) {
    a += DPPF(a, 0xB1); b += DPPF(b, 0xB1); a += DPPF(a, 0x4E); b += DPPF(b, 0x4E); a += DPPF(a, 0x141); b += DPPF(b, 0x141); a += DPPF(a, 0x140); b += DPPF(b, 0x140);
    const int ia = __builtin_bit_cast(int, a), ib = __builtin_bit_cast(int, b);
    const float a0 = __builtin_bit_cast(float, __builtin_amdgcn_readlane(ia, 0)), a1 = __builtin_bit_cast(float, __builtin_amdgcn_readlane(ia, 16)),
                a2 = __builtin_bit_cast(float, __builtin_amdgcn_readlane(ia, 32)), a3 = __builtin_bit_cast(float, __builtin_amdgcn_readlane(ia, 48));
    const float b0 = __builtin_bit_cast(float, __builtin_amdgcn_readlane(ib, 0)), b1 = __builtin_bit_cast(float, __builtin_amdgcn_readlane(ib, 16)),
                b2 = __builtin_bit_cast(float, __builtin_amdgcn_readlane(ib, 32)), b3 = __builtin_bit_cast(float, __builtin_amdgcn_readlane(ib, 48));
    a = (a0 + a1) + (a2 + a3); b = (b0 + b1) + (b2 + b3);
}

#define XB_TMO      128
#define XB_XCNT(j)  (256  + 64 * (j))
#define XB_XSUB(j)  (1280 + 64 * (j))
#define XB_XGEN(j)  (2304 + 64 * (j))
#define XB_TOP      3328
#define XB_TOPGEN   3392
#define XCD_BAR_WORDS 3456
#define XB_SPIN_CAP (1u << 20)

__device__ __forceinline__ unsigned xb_ld(unsigned* p)              { return __hip_atomic_load(p, __ATOMIC_RELAXED, __HIP_MEMORY_SCOPE_AGENT); }
__device__ __forceinline__ unsigned xb_add(unsigned* p, unsigned v) { return __hip_atomic_fetch_add(p, v, __ATOMIC_RELAXED, __HIP_MEMORY_SCOPE_AGENT); }
__device__ __forceinline__ unsigned xb_xcc_id() { return (unsigned)__builtin_amdgcn_s_getreg((3 << 11) | 20) & 0xFu; }
#define XB_SPIN(cond, bar) do { unsigned _sp = 0; while (cond) { __builtin_amdgcn_s_sleep(1); \
    if ((++_sp & 255u) == 0u) { if (xb_ld(&(bar)[XB_TMO])) break; if (_sp > XB_SPIN_CAP) { atomicAdd(&(bar)[XB_TMO], 1u); break; } } } } while (0)

struct XcdBarrier {
    unsigned* bar; unsigned x;
    volatile LAS unsigned* st;
};

__device__ __forceinline__ XcdBarrier xcd_barrier_post(unsigned* bar, volatile LAS unsigned* st) {
    XcdBarrier b; b.bar = bar; b.x = xb_xcc_id(); b.st = st;
    if (threadIdx.x == 0) (void)xb_add(&bar[XB_XCNT(b.x)], 1u);
    return b;
}
__device__ __forceinline__ void xcd_barrier_complete(unsigned* bar, unsigned x, unsigned& nloc, unsigned& nx) {
    const unsigned G = gridDim.x * gridDim.y * gridDim.z;
    unsigned sum, cnt, mine, sp = 0u;
    for (;;) {
        sum = 0u; cnt = 0u; mine = 0u;
#pragma unroll
        for (unsigned j = 0; j < 16; ++j) { const unsigned c = xb_ld(&bar[XB_XCNT(j)]); sum += c; cnt += (c > 0u) ? 1u : 0u; mine = (j == x) ? c : mine; }
        if (sum == G) break;
        __builtin_amdgcn_s_sleep(1);
        if ((++sp & 255u) == 0u) { if (xb_ld(&bar[XB_TMO])) break; if (sp > XB_SPIN_CAP) { atomicAdd(&bar[XB_TMO], 1u); break; } }
    }
    nloc = mine > 0u ? mine : 1u; nx = cnt > 0u ? cnt : 1u;
}

__device__ __forceinline__ void xcd_barrier(const XcdBarrier& b) {
    asm volatile("s_waitcnt vmcnt(0)" ::: "memory");
    __syncthreads();
    if (threadIdx.x == 0) {
        unsigned* bar = b.bar;
        __builtin_amdgcn_s_waitcnt(0);
        unsigned nloc = b.st[0], nx = b.st[1];
        if (nloc == 0u) { xcd_barrier_complete(bar, b.x, nloc, nx); b.st[0] = nloc; b.st[1] = nx; }
        const unsigned old = xb_add(&bar[XB_XSUB(b.x)], 1u);
        const unsigned gen = old / nloc;
        if (old + 1u == (gen + 1u) * nloc) {
            __builtin_amdgcn_fence(__ATOMIC_RELEASE, "agent");
            asm volatile("s_waitcnt vmcnt(0)" ::: "memory");
            const unsigned og = xb_add(&bar[XB_TOP], 1u);
            const unsigned tg = og / nx;
            if (og + 1u == (tg + 1u) * nx) xb_add(&bar[XB_TOPGEN], 1u);
            else XB_SPIN(xb_ld(&bar[XB_TOPGEN]) == tg, bar);
            __builtin_amdgcn_fence(__ATOMIC_ACQUIRE, "agent");
            xb_add(&bar[XB_XGEN(b.x)], 1u);
            asm volatile("s_waitcnt vmcnt(0)" ::: "memory");
        } else {
            XB_SPIN(xb_ld(&bar[XB_XGEN(b.x)]) == gen, bar);
            __builtin_amdgcn_fence(__ATOMIC_ACQUIRE, "agent");
            asm volatile("s_waitcnt vmcnt(0)" ::: "memory");
        }
    }
    __syncthreads();
}


#define AS4 __attribute__((address_space(4)))
struct Ctx {
    LAS unsigned char* lds;
    int tid, lane, wave, vcu, G, bx;
    const AS4 unsigned char* kp;
    unsigned char* ws; float* out;
};
#define IN_(C, k) (*(const float* const AS4*)((C).kp + 8 * (k)))

typedef short bf16x8 __attribute__((ext_vector_type(8)));
#define MFMA16(a, b, c) __builtin_amdgcn_mfma_f32_16x16x32_bf16((a), (b), (c), 0, 0, 0)
__device__ __forceinline__ void p0_transpose_item(const float* W, int K, int N, bf16* WT, LAS float* scr, int item, int lane) {
    const int nblk = N / 32, kb = item / nblk, nb = item % nblk, k0 = 64 * kb, n0 = 32 * nb;
#pragma unroll 8
    for (int i = 0; i < 32; ++i) { const int kk = 2 * i + (lane >> 5); scr[kk * 33 + (lane & 31)] = W[(size_t)(k0 + kk) * N + n0 + (lane & 31)]; }
    LDS_WAIT(); asm volatile("" ::: "memory");
    const int c = lane & 7;
#pragma unroll
    for (int j = 0; j < 4; ++j) { const int n = (lane >> 3) + 8 * j; const LAS float* s = scr + (8 * c) * 33 + n;
        v4u o; o.x = pk2(s[0 * 33], s[1 * 33]); o.y = pk2(s[2 * 33], s[3 * 33]); o.z = pk2(s[4 * 33], s[5 * 33]); o.w = pk2(s[6 * 33], s[7 * 33]);
        *(v4u*)(WT + (size_t)(n0 + n) * K + k0 + 8 * c) = o; }
    LDS_WAIT(); asm volatile("" ::: "memory");
}

__device__ __forceinline__ void convert_tables(const Ctx& C, int l, int it0, int it1) {
    const int gw = C.vcu * 8 + C.wave, NGW = C.G * 8;
    for (int q0 = (it0 * NGW + gw) * 4; q0 < 2 * NEXP && q0 < (it1 * NGW) * 4; q0 += NGW * 4) {
        const bool isv = q0 >= NEXP; const int rr0 = l * NEXP + (isv ? q0 - NEXP : q0);
        const f32x4* src = (const f32x4*)((isv ? IN_(C, 27) : IN_(C, 26)) + (size_t)rr0 * DM) + C.lane;
        f32x4 v[4][4];
#pragma unroll
        for (int q = 0; q < 4; ++q)
#pragma unroll
            for (int j = 0; j < 4; ++j) v[q][j] = __builtin_nontemporal_load(&src[q * 256 + 64 * j]);
        const int bias = 0;
#pragma unroll
        for (int q = 0; q < 4; ++q) {
            float am = 0.f;
#pragma unroll
            for (int j = 0; j < 4; ++j) am = fmaxf(am, fmaxf(fmaxf(fabsf(v[q][j].x), fabsf(v[q][j].y)), fmaxf(fabsf(v[q][j].z), fabsf(v[q][j].w))));
            am = fmaxf(am, DPPF(am, 0xB1)); am = fmaxf(am, DPPF(am, 0x4E)); am = fmaxf(am, DPPF(am, 0x141)); am = fmaxf(am, DPPF(am, 0x140));
            { const int iv = __builtin_bit_cast(int, am);
              am = fmaxf(fmaxf(__builtin_bit_cast(float, __builtin_amdgcn_readlane(iv, 0)), __builtin_bit_cast(float, __builtin_amdgcn_readlane(iv, 16))),
                         fmaxf(__builtin_bit_cast(float, __builtin_amdgcn_readlane(iv, 32)), __builtin_bit_cast(float, __builtin_amdgcn_readlane(iv, 48)))); }
            const float inv = am > 0.f ? 127.0f / am : 0.f;
            unsigned* dst = (unsigned*)(C.ws + (isv ? WS_VQ : WS_UQ) + (size_t)(rr0 + q) * DM) + C.lane;
#pragma unroll
            for (int j = 0; j < 4; ++j) {
                const int q0 = (int)rintf(v[q][j].x * inv) + bias, q1 = (int)rintf(v[q][j].y * inv) + bias, q2 = (int)rintf(v[q][j].z * inv) + bias, q3 = (int)rintf(v[q][j].w * inv) + bias;
                dst[64 * j] = (unsigned)(q0 & 255) | ((unsigned)(q1 & 255) << 8) | ((unsigned)(q2 & 255) << 16) | ((unsigned)(q3 & 255) << 24);
            }
            if (C.lane == 0) ((float*)(C.ws + (isv ? WS_VS : WS_US)))[rr0 + q] = am * (1.0f / 127.0f);
        }
    }
}

__device__ __forceinline__ void phase_p0a(const Ctx& C, int mask) {
    const int gw = C.vcu * 8 + C.wave, NGW = C.G * 8;
    const int gt = C.vcu * 512 + C.tid, NGT = C.G * 512;
    LAS float* scr = (LAS float*)(C.lds + C.wave * 16384);
    if (mask & 1) for (int it = gw; it < 4 * 1024 + 4 * 512; it += NGW) {
        if (it < 4096) { const int l = it >> 10, r = it & 1023; p0_transpose_item(IN_(C, 8) + (size_t)l * 1024 * 2048, 1024, 2048, ((bf16*)(C.ws + WS_WIN)) + (size_t)l * 2048 * 1024, scr, r, C.lane); }
        else { const int q = it - 4096, l = q >> 9, r = q & 511; p0_transpose_item(IN_(C, 9) + (size_t)l * 1024 * 1024, 1024, 1024, ((bf16*)(C.ws + WS_WOUT)) + (size_t)l * 1024 * 1024, scr, r, C.lane); }
    }
    for (int i = gt; i < 4 * 4 * 128 * 128; i += NGT) ((bf16*)(C.ws + WS_SGW))[i] = (bf16)f2bf(IN_(C, 21)[i]);
    for (int i = gt; i < 64 * 512; i += NGT) {
        const int p = i >> 9, j = i & 511, q = j & 255;
        const float omega = powf(10000.0f, -(float)q / 256.0f);
        const float ang = (float)p * omega;
        ((float*)(C.ws + WS_POS))[i] = (j < 256) ? sinf(ang) : cosf(ang);
    }
    if (mask & 2) convert_tables(C, 0, 0, 64);
    if (mask & 4) for (int it = gw; it < 4 * 32 * 24; it += NGW) {
        const int cb = it % 24, ks = (it / 24) & 31, l = it / 768;
        const int col = cb * 256 + 4 * C.lane;
        const float* w = IN_(C, 4) + ((size_t)l * 1024 + ks * 32) * 6144 + col;
        f32x4 wv[32];
#pragma unroll
        for (int k = 0; k < 32; ++k) wv[k] = *(const f32x4*)(w + (size_t)k * 6144);
        int sl[5];
        { const int kk = ks * 32 + (C.lane & 31);
#pragma unroll
          for (int r = 0; r < 5; ++r) { const float v = (r < 4) ? IN_(C, 1)[r * 1024 + kk] : IN_(C, 3)[kk]; sl[r] = __builtin_bit_cast(int, v / (1.f + expf(-v))); } }
        f32x4 a[5];
#pragma unroll
        for (int r = 0; r < 5; ++r) a[r] = (f32x4){0.f, 0.f, 0.f, 0.f};
#pragma unroll
        for (int k = 0; k < 32; ++k)
#pragma unroll
            for (int r = 0; r < 5; ++r) a[r] = a[r] + wv[k] * __builtin_bit_cast(float, __builtin_amdgcn_readlane(sl[r], k));
        float* o = ((float*)(C.ws + WS_MODP)) + (((size_t)ks * 4 + l) * 5) * 6144 + col;
#pragma unroll
        for (int r = 0; r < 5; ++r) *(f32x4*)(o + (size_t)r * 6144) = a[r];
    }
    {
        const int fr = C.lane & 15, fq = C.lane >> 4;
        if (mask & 8) for (int it = gw; it < 8192; it += NGW) {
            const int nt = it & 7, kt = (it >> 3) & 15, side = (it >> 7) & 1, h = (it >> 8) & 7, l = it >> 11;
            const float* key = (side ? IN_(C, 25) : IN_(C, 24)) + (size_t)l * 16384 + (size_t)(nt * 16 + fr) * 128 + 8 * fq;
            const float* wq = IN_(C, 23) + (size_t)l * 1024 * 2048 + (size_t)(kt * 64 + fr) * 2048 + h * 256 + side * 128 + 8 * fq;
            f32x4 kx[4][2], wx[4][4][2];
#pragma unroll
            for (int ks = 0; ks < 4; ++ks) { kx[ks][0] = *(const f32x4*)(key + 32 * ks); kx[ks][1] = *(const f32x4*)(key + 32 * ks + 4); }
#pragma unroll
            for (int ct = 0; ct < 4; ++ct)
#pragma unroll
                for (int ks = 0; ks < 4; ++ks) { const float* wp = wq + (size_t)(16 * ct) * 2048 + 32 * ks; wx[ct][ks][0] = *(const f32x4*)wp; wx[ct][ks][1] = *(const f32x4*)(wp + 4); }
            bf16x8 Bh[4], Bl[4];
#pragma unroll
            for (int ks = 0; ks < 4; ++ks) { const f32x4 x0 = kx[ks][0], x1 = kx[ks][1];
                const float xv[8] = {x0.x, x0.y, x0.z, x0.w, x1.x, x1.y, x1.z, x1.w};
#pragma unroll
                for (int e = 0; e < 8; ++e) { const unsigned hb = f2bf(xv[e]); Bh[ks][e] = (short)hb; Bl[ks][e] = (short)f2bf(xv[e] - __builtin_bit_cast(float, hb << 16)); } }
            bf16* o = (bf16*)(C.ws + WS_WCMB) + ((size_t)l * 2048 + h * 256 + side * 128 + nt * 16 + fr) * 1024 + kt * 64 + 4 * fq;
#pragma unroll
            for (int ct = 0; ct < 4; ++ct) {
                f32x4 acc = {0.f, 0.f, 0.f, 0.f};
#pragma unroll
                for (int ks = 0; ks < 4; ++ks) { const f32x4 x0 = wx[ct][ks][0], x1 = wx[ct][ks][1];
                    const float xv[8] = {x0.x, x0.y, x0.z, x0.w, x1.x, x1.y, x1.z, x1.w};
                    bf16x8 Ah, Al;
#pragma unroll
                    for (int e = 0; e < 8; ++e) { const unsigned hb = f2bf(xv[e]); Ah[e] = (short)hb; Al[e] = (short)f2bf(xv[e] - __builtin_bit_cast(float, hb << 16)); }
                    acc = MFMA16(Ah, Bh[ks], acc); acc = MFMA16(Ah, Bl[ks], acc); acc = MFMA16(Al, Bh[ks], acc); }
                v2u w; w.x = pk2(acc[0], acc[1]); w.y = pk2(acc[2], acc[3]);
                *(v2u*)(o + 16 * ct) = w;
            }
        }
    }
}

__device__ __forceinline__ void phase_p0b(const Ctx& C) {
    const int gt = C.vcu * 512 + C.tid, NGT = C.G * 512;
    for (int i = gt; i < 4 * 5 * 6144; i += NGT) {
        const int l = i / 30720, rem = i % 30720, r = rem / 6144, col = rem % 6144;
        float v = IN_(C, 5)[l * 6144 + col];
#pragma unroll 8
        for (int ks = 0; ks < 32; ++ks) v += ((float*)(C.ws + WS_MODP))[(((size_t)ks * 4 + l) * 5 + r) * 6144 + col];
        ((float*)(C.ws + WS_MOD))[i] = v;
    }
}

template <int MODE>
__device__ __forceinline__ void phase_rows(const Ctx& C, int l, int row_lo) {
    const int gw = C.vcu * 8 + C.wave, NGW = C.G * 8;
    const bool first = (MODE == 0 && l == 0);
    const int n = NTOK - row_lo, per = n / NGW, rem = n - per * NGW;
    int row = row_lo + gw * per + (gw < rem ? gw : rem);
    const int rend = row + per + (gw < rem ? 1 : 0);
#define ROW_LOAD(dst, r) do { if ((r) < rend) { if (first) { const f32x4* sp_ = (const f32x4*)((r) < NCTX ? IN_(C, 2) + (size_t)(r) * DM : IN_(C, 0) + (size_t)((r) - NCTX) * DM) + C.lane; \
            _Pragma("unroll") for (int j = 0; j < 4; ++j) dst[j] = sp_[64 * j]; } \
        else { const v2u* sp_ = (const v2u*)(((const bf16*)(C.ws + WS_Z)) + (size_t)(r) * DM) + C.lane; \
            _Pragma("unroll") for (int j = 0; j < 4; ++j) { const v2u w_ = sp_[64 * j]; dst[j] = (f32x4){bflo(w_.x), bfhi(w_.x), bflo(w_.y), bfhi(w_.y)}; } } } } while (0)
    f32x4 v[4], v1[4], v2[4];
    ROW_LOAD(v, row); ROW_LOAD(v1, row + 1);
    f32x4 gq[4], shq[4], scq[4]; int mr_cur = -1;
    if (MODE != 2) { const f32x4* gp = (const f32x4*)((MODE == 0 ? IN_(C, 6) : IN_(C, 7)) + (size_t)l * DM) + C.lane;
#pragma unroll
        for (int j = 0; j < 4; ++j) gq[j] = gp[64 * j]; }
    else { const f32x4* gp = (const f32x4*)IN_(C, 28) + C.lane;
#pragma unroll
        for (int j = 0; j < 4; ++j) gq[j] = gp[64 * j]; }
    while (row < rend) {
        ROW_LOAD(v2, row + 2);
        float ss = 0.f;
#pragma unroll
        for (int j = 0; j < 4; ++j) ss += (v[j].x * v[j].x + v[j].y * v[j].y) + (v[j].z * v[j].z + v[j].w * v[j].w);
        if (first) { v2u* zp = (v2u*)(((bf16*)(C.ws + WS_Z)) + (size_t)row * DM) + C.lane;
#pragma unroll
            for (int j = 0; j < 4; ++j) { v2u w; w.x = pk2(v[j].x, v[j].y); w.y = pk2(v[j].z, v[j].w); zp[64 * j] = w;
                v[j] = (f32x4){bflo(w.x), bfhi(w.x), bflo(w.y), bfhi(w.y)}; } }
        int mr, t; if (row < NCTX) { mr = 4; t = row & 255; } else { mr = (row - NCTX) >> 12; t = (row - NCTX) & 4095; }
        if (MODE != 2 && mr != mr_cur) { mr_cur = mr;
            const float* mb = ((float*)(C.ws + WS_MOD)) + ((size_t)(l * 5 + mr) * 6 + (MODE == 0 ? 0 : 3)) * DM;
            const f32x4* shp = (const f32x4*)mb + C.lane; const f32x4* scp = (const f32x4*)(mb + DM) + C.lane;
#pragma unroll
            for (int j = 0; j < 4; ++j) { shq[j] = shp[64 * j]; scq[j] = scp[64 * j] + 1.0f; } }
        const float rs = __builtin_amdgcn_rsqf(wave_sum(ss) * (1.0f / DM) + EPS);
        if (MODE == 2) {
            f32x4* op = (f32x4*)(C.out + (size_t)(row - NCTX) * DM) + C.lane;
#pragma unroll
            for (int j = 0; j < 4; ++j) op[64 * j] = v[j] * rs * gq[j];
        } else {
            v2u* op = (v2u*)(((bf16*)(C.ws + WS_XN)) + (size_t)row * DM) + C.lane;
            f32x4 ov[4]; float am = 0.f;
#pragma unroll
            for (int j = 0; j < 4; ++j) {
                f32x4 o = (v[j] * rs * gq[j]) * scq[j] + shq[j];
                if (MODE == 0 && row >= NCTX) {
                    const int p = (j < 2) ? (t >> 6) : (t & 63);
                    o = o + *((const f32x4*)(((float*)(C.ws + WS_POS)) + (size_t)p * 512 + (j & 1) * 256) + C.lane);
                }
                v2u w; w.x = pk2(o.x, o.y); w.y = pk2(o.z, o.w); op[64 * j] = w;
                if (MODE == 1) { ov[j] = (f32x4){bflo(w.x), bfhi(w.x), bflo(w.y), bfhi(w.y)};
                    am = fmaxf(am, fmaxf(fmaxf(fabsf(ov[j].x), fabsf(ov[j].y)), fmaxf(fabsf(ov[j].z), fabsf(ov[j].w)))); }
            }
            if (MODE == 1) {
                am = fmaxf(am, DPPF(am, 0xB1)); am = fmaxf(am, DPPF(am, 0x4E)); am = fmaxf(am, DPPF(am, 0x141)); am = fmaxf(am, DPPF(am, 0x140));
                { const int iv = __builtin_bit_cast(int, am);
                  am = fmaxf(fmaxf(__builtin_bit_cast(float, __builtin_amdgcn_readlane(iv, 0)), __builtin_bit_cast(float, __builtin_amdgcn_readlane(iv, 16))),
                             fmaxf(__builtin_bit_cast(float, __builtin_amdgcn_readlane(iv, 32)), __builtin_bit_cast(float, __builtin_amdgcn_readlane(iv, 48)))); }
                const float inv = am > 0.f ? 127.0f / am : 0.f;
                unsigned* qp = (unsigned*)(C.ws + WS_FQ + (size_t)row * DM) + C.lane;
#pragma unroll
                for (int j = 0; j < 4; ++j) { const int q0 = (int)rintf(ov[j].x * inv), q1 = (int)rintf(ov[j].y * inv), q2 = (int)rintf(ov[j].z * inv), q3 = (int)rintf(ov[j].w * inv);
                    qp[64 * j] = (unsigned)(q0 & 255) | ((unsigned)(q1 & 255) << 8) | ((unsigned)(q2 & 255) << 16) | ((unsigned)(q3 & 255) << 24); }
                if (C.lane == 0) ((float*)(C.ws + WS_FS))[row] = am * (1.0f / 127.0f);
            }
        }
#pragma unroll
        for (int j = 0; j < 4; ++j) { v[j] = v1[j]; v1[j] = v2[j]; }
        ++row;
    }
#undef ROW_LOAD
}

constexpr int XS = 264;
constexpr int VTS = 136;
__device__ __forceinline__ float fexp(float x) { return __builtin_amdgcn_exp2f(x * 1.4426950408889634f); }
__device__ __forceinline__ float fsigmoid(float x) { return __builtin_amdgcn_rcpf(1.0f + fexp(-x)); }
__device__ __forceinline__ float fgelu(float x) {
    const float x2 = x * x;
    const float e = __builtin_amdgcn_exp2f(x * (x2 * (-0.044715f * 2.302208198f) - 2.302208198f));
    return x * __builtin_amdgcn_rcpf(1.0f + e);
}
__device__ __forceinline__ float one_minus_exp(float x) {
    const float p = -x * (1.0f + x * (0.5f + x * (0.16666667f + x * (0.041666668f + x * (0.0083333338f + x * 0.0013888889f)))));
    const float q = 1.0f - fexp(x);
    return (x > -0.25f) ? p : q;
}
__device__ __forceinline__ void seq_of_row(int row0, int& seq0, int& len) { if (row0 < NCTX) { seq0 = row0 & ~255; len = 256; } else { seq0 = NCTX + ((row0 - NCTX) & ~4095); len = 4096; } }
__device__ __forceinline__ void load_bfrags(const float* W, int lane, bf16x8 (&B)[4][2]) {
    const float* w0 = W + (8 * (lane >> 4)) * 64 + (lane & 15);
#pragma unroll
    for (int ct = 0; ct < 4; ++ct)
#pragma unroll
        for (int ks = 0; ks < 2; ++ks) {
            bf16x8 b;
#pragma unroll
            for (int e = 0; e < 8; ++e) b[e] = (short)f2bf(w0[(32 * ks + e) * 64 + 16 * ct]);
            B[ct][ks] = b;
        }
}

__device__ __forceinline__ void mixer_a(const Ctx& C, int l, int chunk) {
    const int row0 = chunk * 128; int seq0, len; seq_of_row(row0, seq0, len); const int t0 = row0 - seq0;
    LAS bf16* xa = (LAS bf16*)C.lds;
    LAS float* tile = (LAS float*)(C.lds + 128 * XS * 2 + C.wave * 8192);
    const bf16* P = (const bf16*)(C.ws + WS_P);
    {
        const float* cw = IN_(C, 10) + (size_t)l * 4 * 256; const float* cbias = IN_(C, 11) + (size_t)l * 256;
        const int c4 = (C.tid & 63) * 4, i0 = (C.tid >> 6) * 16;
        v2u pv[19];
#pragma unroll
        for (int q = 0; q < 19; ++q) { const int t = t0 + i0 - 2 + q; pv[q] = (v2u){0u, 0u}; if (t >= 0 && t < len) pv[q] = *(const v2u*)(P + (size_t)(seq0 + t) * PROJ + c4); }
        f32x4 w[4];
#pragma unroll
        for (int k = 0; k < 4; ++k) w[k] = *(const f32x4*)(cw + k * 256 + c4);
        const f32x4 bias = *(const f32x4*)(cbias + c4);
#pragma unroll
        for (int i = 0; i < 16; ++i) {
            f32x4 acc = bias;
#pragma unroll
            for (int k = 0; k < 4; ++k) { const v2u x = pv[i + k]; acc.x += w[k].x * bflo(x.x); acc.y += w[k].y * bfhi(x.x); acc.z += w[k].z * bflo(x.y); acc.w += w[k].w * bfhi(x.y); }
            v2u o; o.x = pk2(acc.x, acc.y); o.y = pk2(acc.z, acc.w);
            *(LAS v2u*)(xa + (i0 + i) * XS + c4) = o;
        }
    }
    __syncthreads();
    const int d = C.wave >> 2, h = C.wave & 3, fr = C.lane & 15, fq = C.lane >> 4;
    bf16x8 Br[4][2], Bi[4][2];
    load_bfrags(IN_(C, 13) + ((size_t)(l * 2 + d) * 4 + h) * 4096, C.lane, Br);
    load_bfrags(IN_(C, 15) + ((size_t)(l * 2 + d) * 4 + h) * 4096, C.lane, Bi);
    float brv[4], biv[4], spv[4];
#pragma unroll
    for (int ct = 0; ct < 4; ++ct) { const int j = 16 * ct + fr;
        brv[ct] = IN_(C, 14)[((l * 2 + d) * 4 + h) * 64 + j]; biv[ct] = IN_(C, 16)[((l * 2 + d) * 4 + h) * 64 + j];
        const float lam = IN_(C, 12)[(l * 2 + d) * 256 + h * 64 + j]; spv[ct] = fmaxf(-lam, 0.f) + log1pf(expf(-fabsf(lam))); }
    float hst = 0.f, acum = 1.f;
    bf16* HX = (bf16*)(C.ws + WS_HS) + (size_t)d * NTOK * 256 + h * 64 + C.lane; bf16* AX = (bf16*)(C.ws + WS_HS) + (size_t)(2 + d) * NTOK * 256 + h * 64 + C.lane;
    for (int it = 0; it < 8; ++it) {
        const int rt = d ? 7 - it : it;
        const LAS bf16* ap = xa + (16 * rt + fr) * XS + h * 64 + 8 * fq;
        const bf16x8 a0 = *(const LAS bf16x8*)ap, a1 = *(const LAS bf16x8*)(ap + 32);
        f32x4 ar[4], ai[4];
#pragma unroll
        for (int ct = 0; ct < 4; ++ct) {
            ar[ct] = MFMA16(a0, Br[ct][0], ((f32x4){0.f, 0.f, 0.f, 0.f})); ar[ct] = MFMA16(a1, Br[ct][1], ar[ct]);
            ai[ct] = MFMA16(a0, Bi[ct][0], ((f32x4){0.f, 0.f, 0.f, 0.f})); ai[ct] = MFMA16(a1, Bi[ct][1], ai[ct]);
        }
#pragma unroll
        for (int ct = 0; ct < 4; ++ct)
#pragma unroll
            for (int r = 0; r < 4; ++r) {
                const int tl = 4 * fq + r, j = 16 * ct + fr;
                const float xav = bf2f(xa[(16 * rt + tl) * XS + h * 64 + j]);
                const float rg = fsigmoid(ar[ct][r] + brv[ct]), ig = fsigmoid(ai[ct][r] + biv[ct]);
                const float la = -8.0f * rg * spv[ct];
                tile[tl * 64 + j] = fexp(la);
                tile[1024 + tl * 64 + j] = __builtin_amdgcn_sqrtf(one_minus_exp(2.0f * la)) * (ig * xav);
            }
        asm volatile("s_waitcnt lgkmcnt(0)" ::: "memory");
#pragma unroll 4
        for (int s = 0; s < 16; ++s) {
            const int tl = d ? 15 - s : s;
            const float a = tile[tl * 64 + C.lane], b = tile[1024 + tl * 64 + C.lane];
            hst = a * hst + b; acum *= a;
            const size_t ro = (size_t)(row0 + 16 * rt + tl) * 256;
            HX[ro] = (bf16)f2bf(hst); AX[ro] = (bf16)f2bf(acum);
        }
        asm volatile("s_waitcnt lgkmcnt(0)" ::: "memory");
    }
    { float* ag = (float*)(C.ws + WS_AGG) + ((size_t)(chunk * 2 + d) * 2) * 256 + h * 64 + C.lane; ag[0] = acum; ag[256] = hst; }
    __syncthreads();
}

__device__ __forceinline__ void mixer_b(const Ctx& C, int l, int chunk) {
    const int row0 = chunk * 128; int seq0, len; seq_of_row(row0, seq0, len); const int t0 = row0 - seq0;
    LAS bf16* dm = (LAS bf16*)C.lds;
    LAS bf16* xs = (LAS bf16*)(C.lds + 128 * XS * 2);
    const bf16* P = (const bf16*)(C.ws + WS_P); bf16* Y = (bf16*)(C.ws + WS_Y);
    const int half = C.wave >> 2, g = C.wave & 3, fr = C.lane & 15, fq = C.lane >> 4;
    bf16x8 Bw[4][2];
    load_bfrags(IN_(C, 17) + ((size_t)(l * 4 + g)) * 4096, C.lane, Bw);
    float scv[4];
#pragma unroll
    for (int ct = 0; ct < 4; ++ct) scv[ct] = IN_(C, 18)[l * 256 + g * 64 + 16 * ct + fr];
    {
        v4u tmp[9];
#pragma unroll
        for (int q = 0; q < 9; ++q) { const int idx = C.tid + 512 * q, i = idx >> 5, c8 = (idx & 31) * 8, t = t0 - 8 + i;
            tmp[q] = (v4u){0u, 0u, 0u, 0u}; if (t >= 0 && t < len) tmp[q] = *(const v4u*)(P + (size_t)(seq0 + t) * PROJ + 512 + c8); }
#pragma unroll
        for (int q = 0; q < 9; ++q) { const int idx = C.tid + 512 * q, i = idx >> 5, c8 = (idx & 31) * 8; *(LAS v4u*)(xs + i * 256 + c8) = tmp[q]; }
    }
    __syncthreads();
    {
        const int wh = C.wave >> 2, ri = C.lane >> 4, c4 = g * 64 + (C.lane & 15) * 4, hw = 1 << g;
        const int i0 = wh * 64 + ri * 16;
        f32x4 s = {0.f, 0.f, 0.f, 0.f};
        for (int o = -hw; o < hw; ++o) { const v2u pv = *(const LAS v2u*)(xs + (i0 + 8 + o) * 256 + c4); s.x += bflo(pv.x); s.y += bfhi(pv.x); s.z += bflo(pv.y); s.w += bfhi(pv.y); }
#pragma unroll 4
        for (int it = 0; it < 16; ++it) {
            const int i = i0 + it, t = t0 + i;
            int lo = t - hw, hi = t + hw; lo = lo < 0 ? 0 : lo; hi = hi > len ? len : hi;
            const float inv = 1.0f / (float)(hi - lo);
            const v2u xv = *(const LAS v2u*)(xs + (i + 8) * 256 + c4);
            v2u o2; o2.x = pk2(s.x * inv - bflo(xv.x), s.y * inv - bfhi(xv.x)); o2.y = pk2(s.z * inv - bflo(xv.y), s.w * inv - bfhi(xv.y));
            *(LAS v2u*)(dm + i * XS + c4) = o2;
            const v2u pa = *(const LAS v2u*)(xs + (i + 8 + hw) * 256 + c4), pd = *(const LAS v2u*)(xs + (i + 8 - hw) * 256 + c4);
            s.x += bflo(pa.x) - bflo(pd.x); s.y += bfhi(pa.x) - bfhi(pd.x); s.z += bflo(pa.y) - bflo(pd.y); s.w += bfhi(pa.y) - bfhi(pd.y);
        }
    }
    __syncthreads();
#pragma unroll
    for (int q = 0; q < 4; ++q) {
        const int rt = half * 4 + q;
        const LAS bf16* ap = dm + (16 * rt + fr) * XS + g * 64 + 8 * fq;
        const bf16x8 a0 = *(const LAS bf16x8*)ap, a1 = *(const LAS bf16x8*)(ap + 32);
#pragma unroll
        for (int ct = 0; ct < 4; ++ct) {
            f32x4 acc = MFMA16(a0, Bw[ct][0], ((f32x4){0.f, 0.f, 0.f, 0.f})); acc = MFMA16(a1, Bw[ct][1], acc);
#pragma unroll
            for (int r = 0; r < 4; ++r) Y[(size_t)(row0 + 16 * rt + 4 * fq + r) * DM + 256 + g * 64 + 16 * ct + fr] = (bf16)f2bf(acc[r] * scv[ct]);
        }
    }
    __syncthreads();
}

__device__ __forceinline__ void mixer_c(const Ctx& C, int l, int chunk) {
    const int row0 = chunk * 128; int seq0, len; seq_of_row(row0, seq0, len); const int t0 = row0 - seq0;
    const float* cw = IN_(C, 19) + (size_t)l * 3 * 256;
    const bf16* P = (const bf16*)(C.ws + WS_P); bf16* Y = (bf16*)(C.ws + WS_Y);
    const int c4 = (C.tid & 63) * 4;
    f32x4 w[3];
#pragma unroll
    for (int k = 0; k < 3; ++k) w[k] = *(const f32x4*)(cw + k * 256 + c4);
#pragma unroll 1
    for (int hf = 0; hf < 2; ++hf) {
        const int i0 = (C.tid >> 6) * 16 + hf * 8;
        v2u pa[10], pb[10], pc[8];
#pragma unroll
        for (int q = 0; q < 10; ++q) { const int t = t0 + i0 - 1 + q; pa[q] = (v2u){0u, 0u}; pb[q] = (v2u){0u, 0u};
            if (t >= 0 && t < len) { const bf16* p = P + (size_t)(seq0 + t) * PROJ; pa[q] = *(const v2u*)(p + 1024 + c4); pb[q] = *(const v2u*)(p + 1280 + c4); } }
#pragma unroll
        for (int i = 0; i < 8; ++i) pc[i] = *(const v2u*)(P + (size_t)(row0 + i0 + i) * PROJ + 768 + c4);
        f32x4 pr[10];
#pragma unroll
        for (int q = 0; q < 10; ++q) { pr[q].x = bflo(pa[q].x) * bflo(pb[q].x); pr[q].y = bfhi(pa[q].x) * bfhi(pb[q].x); pr[q].z = bflo(pa[q].y) * bflo(pb[q].y); pr[q].w = bfhi(pa[q].y) * bfhi(pb[q].y); }
#pragma unroll
        for (int i = 0; i < 8; ++i) {
            const f32x4 acc = w[0] * pr[i] + w[1] * pr[i + 1] + w[2] * pr[i + 2];
            v2u o; o.x = pk2(bflo(pc[i].x) * acc.x, bfhi(pc[i].x) * acc.y); o.y = pk2(bflo(pc[i].y) * acc.z, bfhi(pc[i].y) * acc.w);
            *(v2u*)(Y + (size_t)(row0 + i0 + i) * DM + 512 + c4) = o;
        }
    }
}

__device__ __forceinline__ void mixer_d(const Ctx& C, int l, int chunk) {
    const int row0 = chunk * 128;
    LAS bf16* vt = (LAS bf16*)C.lds;
    const bf16* P = (const bf16*)(C.ws + WS_P); bf16* Y = (bf16*)(C.ws + WS_Y);
    const int qh = C.wave >> 2, h = C.wave & 3, fr = C.lane & 15, fq = C.lane >> 4;
    const bf16* WSb = (const bf16*)(C.ws + WS_SGW) + ((size_t)(l * 4 + h) * 128) * 128;
    bf16x8 Bqa[4][4];
#pragma unroll
    for (int qq = 0; qq < 4; ++qq)
#pragma unroll
        for (int ks = 0; ks < 4; ++ks) Bqa[qq][ks] = *(const bf16x8*)(WSb + (size_t)(16 * (qh * 4 + qq) + fr) * 128 + 32 * ks + 8 * fq);
    {
        v2u pvv[16];
#pragma unroll
        for (int q = 0; q < 16; ++q) pvv[q] = *(const v2u*)(P + (size_t)(row0 + C.wave + 8 * q) * PROJ + 1792 + 4 * C.lane);
        const f32x4 gg = *(const f32x4*)(IN_(C, 20) + (size_t)l * 256 + 4 * C.lane);
#pragma unroll 4
        for (int q = 0; q < 16; ++q) {
            const int i = C.wave + 8 * q; const v2u pv = pvv[q];
            f32x4 g; g.x = fgelu(bflo(pv.x)); g.y = fgelu(bfhi(pv.x)); g.z = fgelu(bflo(pv.y)); g.w = fgelu(bfhi(pv.y));
            float s1 = (g.x + g.y) + (g.z + g.w), s2 = (g.x * g.x + g.y * g.y) + (g.z * g.z + g.w * g.w);
            wave_sum2(s1, s2);
            const float mean = s1 * (1.0f / 256.0f);
            const float var = fmaxf(s2 * (1.0f / 256.0f) - mean * mean, 0.f);
            const float rs = __builtin_amdgcn_rsqf(var + EPS);
            g = g - mean;
            g = g * rs * gg;
            LAS bf16* o = vt + (4 * C.lane) * VTS + i;
            o[0] = (bf16)f2bf(g.x); o[VTS] = (bf16)f2bf(g.y); o[2 * VTS] = (bf16)f2bf(g.z); o[3 * VTS] = (bf16)f2bf(g.w);
        }
    }
    __syncthreads();
    bf16x8 Av[4][4];
#pragma unroll
    for (int ct = 0; ct < 4; ++ct)
#pragma unroll
        for (int ks = 0; ks < 4; ++ks) Av[ct][ks] = *(const LAS bf16x8*)(vt + (h * 64 + 16 * ct + fr) * VTS + 32 * ks + 8 * fq);
    const float* BS = IN_(C, 22) + (size_t)(l * 4 + h) * 128;
#pragma unroll
    for (int qq = 0; qq < 4; ++qq) {
        const int qt = qh * 4 + qq, q = 16 * qt + fr;
        const float bias = BS[q];
        const size_t row = (size_t)(row0 + q);
#pragma unroll
        for (int ct = 0; ct < 4; ++ct) {
            f32x4 acc = {0.f, 0.f, 0.f, 0.f};
#pragma unroll
            for (int ks = 0; ks < 4; ++ks) acc = MFMA16(Av[ct][ks], Bqa[qq][ks], acc);
            const int c0 = h * 64 + 16 * ct + 4 * fq;
            const v2u pu = *(const v2u*)(P + row * PROJ + 1536 + c0);
            v2u o; o.x = pk2(fgelu(bflo(pu.x)) * (acc[0] + bias), fgelu(bfhi(pu.x)) * (acc[1] + bias)); o.y = pk2(fgelu(bflo(pu.y)) * (acc[2] + bias), fgelu(bfhi(pu.y)) * (acc[3] + bias));
            *(v2u*)(Y + row * DM + 768 + c0) = o;
        }
    }
    __syncthreads();
}

__device__ __forceinline__ void phase_mixers(const Ctx& C, int l, int sel) {
    if (C.G >= 2 * NCHUNK - 16) {
        if (C.bx < NCHUNK) { if (sel != 2) { mixer_a(C, l, C.bx); mixer_c(C, l, C.bx); } }
        else if (sel != 1) { const int nb = C.G - NCHUNK;
            for (int u = C.bx - NCHUNK; u < 2 * NCHUNK; u += nb) {
                if (u < NCHUNK) mixer_d(C, l, u); else mixer_b(C, l, u - NCHUNK); } }
    } else {
        for (int u = C.bx; u < 4 * NCHUNK; u += C.G) {
            if (u < NCHUNK) mixer_a(C, l, u); else if (u < 2 * NCHUNK) mixer_d(C, l, u - NCHUNK); else if (u < 3 * NCHUNK) mixer_b(C, l, u - 2 * NCHUNK); else mixer_c(C, l, u - 3 * NCHUNK); }
    }
}

__device__ __forceinline__ void phase_fixup(const Ctx& C, int l) {
    LAS float* cr = (LAS float*)C.lds;
    const bf16* P = (const bf16*)(C.ws + WS_P); bf16* Y = (bf16*)(C.ws + WS_Y);
    for (int u = C.bx; u < 2 * NCHUNK; u += C.G) {
        const int chunk = u >> 1, hf = u & 1;
        const bf16* H0 = (const bf16*)(C.ws + WS_HS); const bf16* H1 = H0 + (size_t)NTOK * 256; const bf16* A0 = H0 + (size_t)2 * NTOK * 256; const bf16* A1 = H0 + (size_t)3 * NTOK * 256;
        v2u hv[8][5];
#pragma unroll
        for (int q = 0; q < 8; ++q) { const int idx = C.tid + 512 * q, i = idx >> 6, c4 = (idx & 63) * 4; const size_t row = (size_t)chunk * 128 + hf * 64 + i;
            hv[q][0] = *(const v2u*)(H0 + row * 256 + c4); hv[q][1] = *(const v2u*)(H1 + row * 256 + c4); hv[q][2] = *(const v2u*)(A0 + row * 256 + c4); hv[q][3] = *(const v2u*)(A1 + row * 256 + c4);
            hv[q][4] = *(const v2u*)(P + row * PROJ + 256 + c4); }
        {
            const int c = C.tid & 255, d = C.wave >> 2;
            const bool isctx = chunk < 8; const int b = isctx ? (chunk >> 1) : ((chunk - 8) >> 5), k = isctx ? (chunk & 1) : ((chunk - 8) & 31);
            const int n = isctx ? (d ? 1 - k : k) : (d ? 2 + 31 - k : 2 + k);
            const float* AG = (const float*)(C.ws + WS_AGG);
            float av[33], bv[33];
#pragma unroll
            for (int q = 0; q < 33; ++q) {
                const int cid = (q < 2) ? (b * 2 + (d ? 1 - q : q)) : (8 + b * 32 + (d ? 31 - (q - 2) : (q - 2)));
                const float* ag = AG + ((size_t)(cid * 2 + d) * 2) * 256 + c;
                av[q] = (q < n) ? ag[0] : 1.0f; bv[q] = (q < n) ? ag[256] : 0.0f;
            }
            float carry = 0.f;
#pragma unroll
            for (int q = 0; q < 33; ++q) carry = av[q] * carry + bv[q];
            cr[d * 256 + c] = carry;
        }
        __syncthreads();
#pragma unroll
        for (int q = 0; q < 8; ++q) {
            const int idx = C.tid + 512 * q, i = idx >> 6, c4 = (idx & 63) * 4; const size_t row = (size_t)chunk * 128 + hf * 64 + i;
            const v2u h0 = hv[q][0], h1 = hv[q][1], a0 = hv[q][2], a1 = hv[q][3], ag = hv[q][4];
            const f32x4 cf = *(const LAS f32x4*)(cr + c4), cb = *(const LAS f32x4*)(cr + 256 + c4);
            const float y0 = (bflo(h0.x) + bflo(a0.x) * cf.x + bflo(h1.x) + bflo(a1.x) * cb.x) * fgelu(bflo(ag.x));
            const float y1 = (bfhi(h0.x) + bfhi(a0.x) * cf.y + bfhi(h1.x) + bfhi(a1.x) * cb.y) * fgelu(bfhi(ag.x));
            const float y2 = (bflo(h0.y) + bflo(a0.y) * cf.z + bflo(h1.y) + bflo(a1.y) * cb.z) * fgelu(bflo(ag.y));
            const float y3 = (bfhi(h0.y) + bfhi(a0.y) * cf.w + bfhi(h1.y) + bfhi(a1.y) * cb.w) * fgelu(bfhi(ag.y));
            v2u o; o.x = pk2(y0, y1); o.y = pk2(y2, y3);
            *(v2u*)(Y + row * DM + c4) = o;
        }
        __syncthreads();
    }
}

__device__ __forceinline__ unsigned okey(float x) { const int u = __builtin_bit_cast(int, x); return (unsigned)(u ^ ((u >> 31) | (int)0x80000000)); }
__device__ __forceinline__ unsigned med3u(unsigned a, unsigned b, unsigned c) { unsigned r; asm("v_med3_u32 %0, %1, %2, %3" : "=v"(r) : "v"(a), "v"(b), "v"(c)); return r; }
#define TK_INS(L, xx) do { const unsigned x_ = (xx); _Pragma("unroll") for (int k_ = 15; k_ >= 1; --k_) L[k_] = med3u(L[k_ - 1], L[k_], x_); L[0] = L[0] > x_ ? L[0] : x_; } while (0)

__device__ __forceinline__ void phase_topk(const Ctx& C, int row_lo) {
    LAS unsigned* tl = (LAS unsigned*)C.lds;
    const int NGW = C.G * 8, u0 = (row_lo >> 6) * 8, nun = (NTOK >> 6) * 8 - u0;
    for (int j = 0; ; ++j) {
        int unit;
        if ((j + 1) * NGW <= nun) unit = u0 + j * NGW + C.vcu * 8 + C.wave;
        else { const int rem = nun - j * NGW; if (rem <= 0) break;
               const int q = C.wave * C.G + C.bx; if (q >= rem) break; unit = u0 + j * NGW + q; }
        const int tb = unit >> 3, h = unit & 7; const int row = tb * 64 + C.lane;
        const unsigned* s = ((const unsigned*)(C.ws + WS_SC)) + ((size_t)unit * 256) * 64 + C.lane;
#pragma unroll 1
        for (int side = 0; side < 2; ++side) {
            unsigned L[16];
#pragma unroll
            for (int k = 0; k < 16; ++k) L[k] = 0u;
            const unsigned* ss = s + (size_t)(side * 128) * 64;
            unsigned va[32], vb[32];
#pragma unroll
            for (int q = 0; q < 32; ++q) va[q] = ss[(size_t)q * 64];
#pragma unroll
            for (int nb = 0; nb < 128; nb += 64) {
#pragma unroll
                for (int q = 0; q < 32; ++q) vb[q] = ss[(size_t)(nb + 32 + q) * 64];
#pragma unroll
                for (int q = 0; q < 32; ++q) TK_INS(L, va[q]);
                if (nb + 64 < 128) {
#pragma unroll
                    for (int q = 0; q < 32; ++q) va[q] = ss[(size_t)(nb + 64 + q) * 64];
                }
#pragma unroll
                for (int q = 0; q < 32; ++q) TK_INS(L, vb[q]);
            }
#pragma unroll
            for (int k = 0; k < 16; ++k) {
                const unsigned kk = L[k] & ~127u; const unsigned ub = (kk & 0x80000000u) ? (kk ^ 0x80000000u) : ~kk;
                tl[(side * 32 + k) * 512 + C.tid] = 127u - (L[k] & 127u); tl[(side * 32 + 16 + k) * 512 + C.tid] = ub;
            }
        }
        float v1[16], v2[16];
#pragma unroll
        for (int k = 0; k < 16; ++k) { v1[k] = __builtin_bit_cast(float, tl[(16 + k) * 512 + C.tid]); v2[k] = __builtin_bit_cast(float, tl[(48 + k) * 512 + C.tid]); }
        unsigned M[16];
#pragma unroll
        for (int k = 0; k < 16; ++k) M[k] = 0u;
#pragma unroll
        for (int a = 0; a < 16; ++a)
#pragma unroll
            for (int b = 0; b < 16; ++b)
                if ((a + 1) * (b + 1) <= 16) { const float sm = v1[a] + v2[b]; TK_INS(M, (okey(sm) & ~255u) | (unsigned)(255 - (a * 16 + b))); }
        float sums[16]; int ex[16]; float mx = -3.0e38f;
#pragma unroll
        for (int k = 0; k < 16; ++k) {
            const int f = 255 - (int)(M[k] & 255u), a = f >> 4, b = f & 15;
            const int i1 = (int)tl[a * 512 + C.tid], i2 = (int)tl[(32 + b) * 512 + C.tid];
            const float va = __builtin_bit_cast(float, tl[(16 + a) * 512 + C.tid]), vb = __builtin_bit_cast(float, tl[(48 + b) * 512 + C.tid]);
            sums[k] = va + vb; ex[k] = i1 * 128 + i2; mx = fmaxf(mx, sums[k]);
        }
        float den = 0.f;
#pragma unroll
        for (int k = 0; k < 16; ++k) { sums[k] = expf(sums[k] - mx); den += sums[k]; }
        const float inv = 1.0f / den;
        v4i* pe = (v4i*)(((int*)(C.ws + WS_PE)) + (size_t)row * NPICK + h * 16); f32x4* pc = (f32x4*)(((float*)(C.ws + WS_PC)) + (size_t)row * NPICK + h * 16);
#pragma unroll
        for (int q = 0; q < 4; ++q) { v4i e4; e4.x = ex[4 * q]; e4.y = ex[4 * q + 1]; e4.z = ex[4 * q + 2]; e4.w = ex[4 * q + 3]; pe[q] = e4;
            f32x4 c4; c4.x = sums[4 * q] * inv; c4.y = sums[4 * q + 1] * inv; c4.z = sums[4 * q + 2] * inv; c4.w = sums[4 * q + 3] * inv; pc[q] = c4; }
    }
}

__device__ __forceinline__ int red16_add(int x) {
    x += __builtin_amdgcn_update_dpp(0, x, 0xB1, 0xf, 0xf, true);
    x += __builtin_amdgcn_update_dpp(0, x, 0x4E, 0xf, 0xf, true);
    x += __builtin_amdgcn_update_dpp(0, x, 0x141, 0xf, 0xf, true);
    x += __builtin_amdgcn_update_dpp(0, x, 0x140, 0xf, 0xf, true);
    return x;
}
__device__ __forceinline__ float red16_max(float x) {
    x = fmaxf(x, __builtin_bit_cast(float, __builtin_amdgcn_update_dpp(0, __builtin_bit_cast(int, x), 0xB1, 0xf, 0xf, true)));
    x = fmaxf(x, __builtin_bit_cast(float, __builtin_amdgcn_update_dpp(0, __builtin_bit_cast(int, x), 0x4E, 0xf, 0xf, true)));
    x = fmaxf(x, __builtin_bit_cast(float, __builtin_amdgcn_update_dpp(0, __builtin_bit_cast(int, x), 0x141, 0xf, 0xf, true)));
    x = fmaxf(x, __builtin_bit_cast(float, __builtin_amdgcn_update_dpp(0, __builtin_bit_cast(int, x), 0x140, 0xf, 0xf, true)));
    return x;
}
#define UB0(w) ((float)((w) & 0xffu))
#define UB1(w) ((float)(((w) >> 8) & 0xffu))
#define UB2(w) ((float)(((w) >> 16) & 0xffu))
#define UB3(w) ((float)((w) >> 24))
struct UBuf { v4u u[4]; };
struct VBuf { v4u v[4]; };
__device__ __forceinline__ void u_issue(UBuf& B, int k, int g, int i16, int e_lo, int e_hi, const unsigned char* UQ) {
    const int p = 4 * k + g;
    const int e = __builtin_amdgcn_ds_bpermute((p & 63) << 2, (k < 16) ? e_lo : e_hi);
    const unsigned char* ur = UQ + (size_t)e * DM + 16 * i16;
#pragma unroll
    for (int c = 0; c < 4; ++c) B.u[c] = *(const v4u*)(ur + 256 * c);
}
__device__ __forceinline__ void u_compute(const UBuf& B, int k, int i16, const int (&fq)[16], int& d_lo, int& d_hi) {
    int acc = 0;
#pragma unroll
    for (int c = 0; c < 4; ++c) {
        acc = __builtin_amdgcn_sdot4((int)B.u[c].x, fq[4 * c + 0], acc, false); acc = __builtin_amdgcn_sdot4((int)B.u[c].y, fq[4 * c + 1], acc, false);
        acc = __builtin_amdgcn_sdot4((int)B.u[c].z, fq[4 * c + 2], acc, false); acc = __builtin_amdgcn_sdot4((int)B.u[c].w, fq[4 * c + 3], acc, false);
    }
    acc = red16_add(acc);
    if (k < 16) d_lo = (i16 == (k & 15)) ? acc : d_lo; else d_hi = (i16 == (k & 15)) ? acc : d_hi;
}
__device__ __forceinline__ void v_issue(VBuf& B, int k, int lane, int e_lo, int e_hi, const unsigned char* VQ) {
    const int ev = (k < 16) ? e_lo : e_hi;
#pragma unroll
    for (int q = 0; q < 4; ++q) { const int eq = __builtin_amdgcn_readlane(ev, (4 * k + q) & 63); B.v[q] = *((const v4u*)(VQ + (size_t)eq * DM) + lane); }
}
__device__ __forceinline__ void v_compute(const VBuf& B, int k, int pk_lo, int pk_hi, int (&acc)[16]) {
    const int cq4 = __builtin_amdgcn_readlane((k < 16) ? pk_lo : pk_hi, (4 * k) & 63);
    const unsigned a[4] = {B.v[0].x, B.v[0].y, B.v[0].z, B.v[0].w}, b[4] = {B.v[1].x, B.v[1].y, B.v[1].z, B.v[1].w},
                   c[4] = {B.v[2].x, B.v[2].y, B.v[2].z, B.v[2].w}, d[4] = {B.v[3].x, B.v[3].y, B.v[3].z, B.v[3].w};
#pragma unroll
    for (int w = 0; w < 4; ++w) {
        const unsigned ab_lo = __builtin_amdgcn_perm(b[w], a[w], 0x05010400u), ab_hi = __builtin_amdgcn_perm(b[w], a[w], 0x07030602u);
        const unsigned cd_lo = __builtin_amdgcn_perm(d[w], c[w], 0x05010400u), cd_hi = __builtin_amdgcn_perm(d[w], c[w], 0x07030602u);
        const unsigned t0 = __builtin_amdgcn_perm(cd_lo, ab_lo, 0x05040100u), t1 = __builtin_amdgcn_perm(cd_lo, ab_lo, 0x07060302u);
        const unsigned t2 = __builtin_amdgcn_perm(cd_hi, ab_hi, 0x05040100u), t3 = __builtin_amdgcn_perm(cd_hi, ab_hi, 0x07060302u);
        acc[4 * w + 0] = __builtin_amdgcn_sdot4((int)t0, cq4, acc[4 * w + 0], false); acc[4 * w + 1] = __builtin_amdgcn_sdot4((int)t1, cq4, acc[4 * w + 1], false);
        acc[4 * w + 2] = __builtin_amdgcn_sdot4((int)t2, cq4, acc[4 * w + 2], false); acc[4 * w + 3] = __builtin_amdgcn_sdot4((int)t3, cq4, acc[4 * w + 3], false);
    }
}
__device__ __forceinline__ void phase_gather(const Ctx& C, int l, bf16* Zt, bool fuse_next, int row_lo) {
    const int gw = C.vcu * 8 + C.wave, NGW = C.G * 8;
    const unsigned char* UQ = C.ws + WS_UQ + (size_t)l * NEXP * DM; const unsigned char* VQ = C.ws + WS_VQ + (size_t)l * NEXP * DM;
    const float* US = (const float*)(C.ws + WS_US) + (size_t)l * NEXP; const float* VS = (const float*)(C.ws + WS_VS) + (size_t)l * NEXP;
    const int g = C.lane >> 4, i16 = C.lane & 15;
    const int nrows_all = NTOK - row_lo, nfull = nrows_all / NGW, nrem = nrows_all - nfull * NGW, xq = C.wave * C.G + C.bx;
    const int nmine = nfull + (xq < nrem ? 1 : 0);
#define G_CONV_ITERS ((2 * NEXP + 4 * NGW - 1) / (4 * NGW))
#define G_ROW(k) (((k) < nfull) ? (row_lo + (k) * NGW + gw) : (((k) < nmine) ? (row_lo + nfull * NGW + xq) : NTOK))
    v4u nfq[4]; float nfs = 0.f; int ne_lo = 0, ne_hi = 0; float nc_lo = 0.f, nc_hi = 0.f;
#define U_PREFETCH(r) do { if ((r) < NTOK) { const unsigned char* fq_ = C.ws + WS_FQ + (size_t)(r) * DM + 16 * i16; \
        _Pragma("unroll") for (int c = 0; c < 4; ++c) nfq[c] = *(const v4u*)(fq_ + 256 * c); nfs = ((const float*)(C.ws + WS_FS))[(r)]; \
        const int* pe_ = ((int*)(C.ws + WS_PE)) + (size_t)(r) * NPICK; const float* pc_ = ((float*)(C.ws + WS_PC)) + (size_t)(r) * NPICK; \
        ne_lo = pe_[C.lane]; ne_hi = pe_[64 + C.lane]; nc_lo = pc_[C.lane]; nc_hi = pc_[64 + C.lane]; } } while (0)
#ifdef PROBE_GSEL
    if (fuse_next || PROBE_GSEL == 1)
#endif
    U_PREFETCH(G_ROW(0));
#ifdef PROBE_GSEL
    if (fuse_next || PROBE_GSEL == 1)
#endif
    for (int kr = 0; kr < nmine; ++kr) {
        const int row = G_ROW(kr);
        int fq[16]; const float fs = nfs;
        const int e_lo = ne_lo, e_hi = ne_hi; const float c_lo = nc_lo, c_hi = nc_hi;
#pragma unroll
        for (int c = 0; c < 4; ++c) { fq[4 * c] = (int)nfq[c].x; fq[4 * c + 1] = (int)nfq[c].y; fq[4 * c + 2] = (int)nfq[c].z; fq[4 * c + 3] = (int)nfq[c].w; }
        U_PREFETCH(G_ROW(kr + 1));
        const int pp = 4 * i16 + g;
        const int ep_lo = __builtin_amdgcn_ds_bpermute(pp << 2, e_lo), ep_hi = __builtin_amdgcn_ds_bpermute(pp << 2, e_hi);
        const float cp_lo = __builtin_bit_cast(float, __builtin_amdgcn_ds_bpermute(pp << 2, __builtin_bit_cast(int, c_lo))), cp_hi = __builtin_bit_cast(float, __builtin_amdgcn_ds_bpermute(pp << 2, __builtin_bit_cast(int, c_hi)));
        const float us_lo = US[ep_lo], us_hi = US[ep_hi], vs_lo = VS[ep_lo], vs_hi = VS[ep_hi];
        int d_lo = 0, d_hi = 0;
        UBuf A, B;
        u_issue(A, 0, g, i16, e_lo, e_hi, UQ);
#pragma unroll
        for (int k = 0; k < 32; k += 2) {
            u_issue(B, k + 1, g, i16, e_lo, e_hi, UQ);
            u_compute(A, k, i16, fq, d_lo, d_hi);
            if (k + 2 < 32) u_issue(A, k + 2, g, i16, e_lo, e_hi, UQ);
            u_compute(B, k + 1, i16, fq, d_lo, d_hi);
        }
        float* cor = ((float*)(C.ws + WS_CO)) + (size_t)row * NPICK;
        cor[pp] = gelu_t((float)d_lo * (fs * us_lo)) * (cp_lo * vs_lo);
        cor[64 + pp] = gelu_t((float)d_hi * (fs * us_hi)) * (cp_hi * vs_hi);
    }
#define V_PREFETCH(r) do { if ((r) < NTOK) { const int* pe_ = ((int*)(C.ws + WS_PE)) + (size_t)(r) * NPICK; const float* co_ = ((float*)(C.ws + WS_CO)) + (size_t)(r) * NPICK; \
        ne_lo = pe_[C.lane]; ne_hi = pe_[64 + C.lane]; nc_lo = co_[C.lane]; nc_hi = co_[64 + C.lane]; } } while (0)
    V_PREFETCH(G_ROW(0));
#ifdef PROBE_GSEL
    if (fuse_next || PROBE_GSEL == 2)
#endif
    for (int kr = 0; kr < nmine; ++kr) {
        const int row = G_ROW(kr);
        const int e_lo = ne_lo, e_hi = ne_hi;
        const float co_lo = nc_lo, co_hi = nc_hi;
        V_PREFETCH(G_ROW(kr + 1));
        if (fuse_next && l < DEPTH - 1 && !(kr & 1)) convert_tables(C, l + 1, kr >> 1, (kr >> 1) + 1);
        float cs; int pk_lo, pk_hi;
        {
            float am = fmaxf(fabsf(co_lo), fabsf(co_hi));
            am = fmaxf(am, DPPF(am, 0xB1)); am = fmaxf(am, DPPF(am, 0x4E)); am = fmaxf(am, DPPF(am, 0x141)); am = fmaxf(am, DPPF(am, 0x140));
            { const int iv = __builtin_bit_cast(int, am);
              am = fmaxf(fmaxf(__builtin_bit_cast(float, __builtin_amdgcn_readlane(iv, 0)), __builtin_bit_cast(float, __builtin_amdgcn_readlane(iv, 16))),
                         fmaxf(__builtin_bit_cast(float, __builtin_amdgcn_readlane(iv, 32)), __builtin_bit_cast(float, __builtin_amdgcn_readlane(iv, 48)))); }
            const float inv = am > 0.f ? 127.0f / am : 0.f; cs = am * (1.0f / 127.0f);
            const int sh = 8 * (C.lane & 3);
            int yl = (((int)rintf(co_lo * inv)) & 255) << sh, yh = (((int)rintf(co_hi * inv)) & 255) << sh;
            yl |= __builtin_amdgcn_update_dpp(0, yl, 0xB1, 0xf, 0xf, true); yl |= __builtin_amdgcn_update_dpp(0, yl, 0x4E, 0xf, 0xf, true);
            yh |= __builtin_amdgcn_update_dpp(0, yh, 0xB1, 0xf, 0xf, true); yh |= __builtin_amdgcn_update_dpp(0, yh, 0x4E, 0xf, 0xf, true);
            pk_lo = yl; pk_hi = yh;
        }
        int acc[16];
#pragma unroll
        for (int i = 0; i < 16; ++i) acc[i] = 0;
        const int mr = (row < NCTX) ? 4 : ((row - NCTX) >> 12);
        v4u* zp = (v4u*)(Zt + (size_t)row * DM) + 2 * C.lane;
        f32x4 zold[4], g2v[4], gpv[4], shv[4], scv[4], ppv[4];
        {
            const f32x4* g2 = (const f32x4*)(((float*)(C.ws + WS_MOD)) + ((size_t)(l * 5 + mr) * 6 + 5) * DM) + 4 * C.lane;
#pragma unroll
            for (int q = 0; q < 4; ++q) g2v[q] = g2[q];
            { const v4u za = zp[0], zb = zp[1];
              zold[0] = (f32x4){bflo(za.x), bfhi(za.x), bflo(za.y), bfhi(za.y)}; zold[1] = (f32x4){bflo(za.z), bfhi(za.z), bflo(za.w), bfhi(za.w)};
              zold[2] = (f32x4){bflo(zb.x), bfhi(zb.x), bflo(zb.y), bfhi(zb.y)}; zold[3] = (f32x4){bflo(zb.z), bfhi(zb.z), bflo(zb.w), bfhi(zb.w)}; }
            if (fuse_next) {
                if (l < DEPTH - 1) {
                    const int l1 = l + 1;
                    const f32x4* gp = (const f32x4*)(IN_(C, 6) + (size_t)l1 * DM) + 4 * C.lane;
                    const float* mb = ((float*)(C.ws + WS_MOD)) + ((size_t)(l1 * 5 + mr) * 6) * DM;
                    const f32x4* shp = (const f32x4*)mb + 4 * C.lane; const f32x4* scp = (const f32x4*)(mb + DM) + 4 * C.lane;
                    const int t = (row - NCTX) & 4095, seg = C.lane >> 4, p = (seg < 2) ? (t >> 6) : (t & 63);
                    const f32x4* pp = (const f32x4*)(((float*)(C.ws + WS_POS)) + (size_t)p * 512 + (seg & 1) * 256 + 16 * (C.lane & 15));
#pragma unroll
                    for (int q = 0; q < 4; ++q) { gpv[q] = gp[q]; shv[q] = shp[q]; scv[q] = scp[q]; ppv[q] = pp[q]; }
                } else {
                    const f32x4* gp = (const f32x4*)IN_(C, 28) + 4 * C.lane;
#pragma unroll
                    for (int q = 0; q < 4; ++q) gpv[q] = gp[q];
                }
            }
        }
        VBuf A, B;
        v_issue(A, 0, C.lane, e_lo, e_hi, VQ);
#pragma unroll
        for (int k = 0; k < 32; k += 2) {
            v_issue(B, k + 1, C.lane, e_lo, e_hi, VQ);
            v_compute(A, k, pk_lo, pk_hi, acc);
            if (k + 2 < 32) v_issue(A, k + 2, C.lane, e_lo, e_hi, VQ);
            v_compute(B, k + 1, pk_lo, pk_hi, acc);
        }
        float out[16];
#pragma unroll
        for (int i = 0; i < 16; ++i) out[i] = (float)acc[i] * cs;
        f32x4 zn[4]; float ss = 0.f;
#pragma unroll
        for (int q = 0; q < 4; ++q) { const f32x4 gg = g2v[q]; f32x4 z = zold[q];
            z.x += gg.x * out[4 * q]; z.y += gg.y * out[4 * q + 1]; z.z += gg.z * out[4 * q + 2]; z.w += gg.w * out[4 * q + 3];
            zn[q] = z; ss += (z.x * z.x + z.y * z.y) + (z.z * z.z + z.w * z.w); }
        if (l < DEPTH - 1 || !fuse_next) {
            v4u za, zb; za.x = pk2(zn[0].x, zn[0].y); za.y = pk2(zn[0].z, zn[0].w); za.z = pk2(zn[1].x, zn[1].y); za.w = pk2(zn[1].z, zn[1].w);
            zb.x = pk2(zn[2].x, zn[2].y); zb.y = pk2(zn[2].z, zn[2].w); zb.z = pk2(zn[3].x, zn[3].y); zb.w = pk2(zn[3].z, zn[3].w);
            zp[0] = za; zp[1] = zb;
        }
        if (fuse_next) {
            const float rs = __builtin_amdgcn_rsqf(wave_sum(ss) * (1.0f / DM) + EPS);
            if (l < DEPTH - 1) {
                unsigned w[8];
#pragma unroll
                for (int q = 0; q < 4; ++q) {
                    f32x4 o = (zn[q] * rs * gpv[q]) * (scv[q] + 1.0f) + shv[q];
                    if (row >= NCTX) o = o + ppv[q];
                    w[2 * q] = pk2(o.x, o.y); w[2 * q + 1] = pk2(o.z, o.w);
                }
                v4u* op = (v4u*)(((bf16*)(C.ws + WS_XN)) + (size_t)row * DM) + 2 * C.lane;
                v4u w0; w0.x = w[0]; w0.y = w[1]; w0.z = w[2]; w0.w = w[3]; v4u w1; w1.x = w[4]; w1.y = w[5]; w1.z = w[6]; w1.w = w[7];
                op[0] = w0; op[1] = w1;
            } else if (row >= NCTX) {
                f32x4* op = (f32x4*)(C.out + (size_t)(row - NCTX) * DM) + 4 * C.lane;
#pragma unroll
                for (int q = 0; q < 4; ++q) op[q] = zn[q] * rs * gpv[q];
            }
        }
    }
    if (fuse_next && l < DEPTH - 1) convert_tables(C, l + 1, (nmine + 1) >> 1, 64);
}

struct CtxEpiP { bf16* P; __device__ __forceinline__ void operator()(const f32x4 (&acc)[2][2], int m0, int n0, int fr, int fq) const {
#pragma unroll
    for (int mt = 0; mt < 2; ++mt)
#pragma unroll
        for (int nt = 0; nt < 2; ++nt) { const f32x4 v = acc[mt][nt]; v2u w; w.x = pk2(v[0], v[1]); w.y = pk2(v[2], v[3]);
            *(v2u*)(P + (size_t)(m0 + 16 * mt + fr) * PROJ + n0 + 16 * nt + 4 * fq) = w; } } };
struct CtxEpiResid { bf16* Z; const float* gate; __device__ __forceinline__ void operator()(const f32x4 (&acc)[2][2], int m0, int n0, int fr, int fq) const {
    v2u zv[2][2];
#pragma unroll
    for (int mt = 0; mt < 2; ++mt)
#pragma unroll
        for (int nt = 0; nt < 2; ++nt) zv[mt][nt] = *(const v2u*)(Z + (size_t)(m0 + 16 * mt + fr) * DM + n0 + 16 * nt + 4 * fq);
#pragma unroll
    for (int mt = 0; mt < 2; ++mt)
#pragma unroll
        for (int nt = 0; nt < 2; ++nt) { const f32x4 g = *(const f32x4*)(gate + n0 + 16 * nt + 4 * fq); const v2u z = zv[mt][nt]; const f32x4 a = g * acc[mt][nt];
            v2u w; w.x = pk2(bflo(z.x) + a[0], bfhi(z.x) + a[1]); w.y = pk2(bflo(z.y) + a[2], bfhi(z.y) + a[3]);
            *(v2u*)(Z + (size_t)(m0 + 16 * mt + fr) * DM + n0 + 16 * nt + 4 * fq) = w; } } };
struct CtxEpiScoreT { unsigned* S; __device__ __forceinline__ void operator()(const f32x4 (&acc)[2][2], int m0, int n0, int fr, int fq) const {
#pragma unroll
    for (int mt = 0; mt < 2; ++mt)
#pragma unroll
        for (int nt = 0; nt < 2; ++nt) { const int row = m0 + 16 * mt + fr, col = n0 + 16 * nt + 4 * fq, head = col >> 8, cn = col & 255; const f32x4 v = acc[mt][nt];
            unsigned* bp = S + ((size_t)((row >> 6) * 8 + head) * 256 + cn) * 64 + (row & 63);
            bp[0] = pg8::score_key(v[0], cn); bp[64] = pg8::score_key(v[1], cn + 1); bp[128] = pg8::score_key(v[2], cn + 2); bp[192] = pg8::score_key(v[3], cn + 3); } } };

template <class Epi>
__device__ __forceinline__ void ctx_gemm(const Ctx& C, const bf16* A, const bf16* Bt, int M, int N, const Epi& E) {
    constexpr int AST = 1032;
    LAS bf16* As = (LAS bf16*)C.lds;
    const int ntn = N >> 8, ntiles = (M >> 5) * ntn, fr = C.lane & 15, fq = C.lane >> 4;
    for (int t = C.bx; t < ntiles; t += C.G) {
        const int tm = t / ntn, tn = t - tm * ntn, m0 = tm * 32, n0 = tn * 256 + 32 * C.wave;
        const bf16* bp = Bt + (size_t)(n0 + fr) * 1024 + 8 * fq;
        bf16x8 B0[8][2], B1[8][2];
#define CG_LOAD(BUF, ch) do { _Pragma("unroll") for (int ks = 0; ks < 8; ++ks) _Pragma("unroll") for (int nt = 0; nt < 2; ++nt) \
            BUF[ks][nt] = *(const bf16x8*)(bp + (size_t)(16 * nt) * 1024 + 32 * (8 * (ch) + ks)); } while (0)
#define CG_COMP(BUF, ch) do { _Pragma("unroll") for (int ks = 0; ks < 8; ++ks) { const LAS bf16* ap = As + fr * AST + 32 * (8 * (ch) + ks) + 8 * fq; \
            const bf16x8 a0 = *(const LAS bf16x8*)ap, a1 = *(const LAS bf16x8*)(ap + 16 * AST); \
            _Pragma("unroll") for (int nt = 0; nt < 2; ++nt) { acc[0][nt] = MFMA16(BUF[ks][nt], a0, acc[0][nt]); acc[1][nt] = MFMA16(BUF[ks][nt], a1, acc[1][nt]); } } } while (0)
        CG_LOAD(B0, 0);
        {
            v4u tmp[8];
#pragma unroll
            for (int q = 0; q < 8; ++q) { const int idx = C.tid + 512 * q, r = idx >> 7, c8 = (idx & 127) * 8; tmp[q] = *(const v4u*)(A + (size_t)(m0 + r) * 1024 + c8); }
#pragma unroll
            for (int q = 0; q < 8; ++q) { const int idx = C.tid + 512 * q, r = idx >> 7, c8 = (idx & 127) * 8; *(LAS v4u*)(As + r * AST + c8) = tmp[q]; }
        }
        __syncthreads();
        f32x4 acc[2][2];
#pragma unroll
        for (int mt = 0; mt < 2; ++mt)
#pragma unroll
            for (int nt = 0; nt < 2; ++nt) acc[mt][nt] = (f32x4){0.f, 0.f, 0.f, 0.f};
        CG_LOAD(B1, 1); CG_COMP(B0, 0);
        CG_LOAD(B0, 2); CG_COMP(B1, 1);
        CG_LOAD(B1, 3); CG_COMP(B0, 2);
        CG_COMP(B1, 3);
#undef CG_LOAD
#undef CG_COMP
        E(acc, m0, n0, fr, fq);
        __syncthreads();
    }
}

#ifndef PROBE_PHASE
#define PROBE_PHASE -1
#define PROBE_REP 0
#endif
#ifndef PGA
#define PGA true
#endif
#ifndef PGS
#define PGS true
#endif
#ifndef PROBE_P0MASK
#define PROBE_P0MASK 15
#endif
#ifndef PROBE_MIXSEL
#define PROBE_MIXSEL 0
#endif
struct Args { const float* in[29]; float* out; unsigned char* ws; int ph_lo, ph_hi; };
__global__ void __launch_bounds__(512, 2) mk_fwd(Args args) {
    extern __shared__ __attribute__((aligned(16))) unsigned char lds_raw[];
    {
        LAS unsigned char* l0 = (LAS unsigned char*)lds_raw;
        for (int u = threadIdx.x; u < (LDS_BYTES - LDSCTL_OFF) / 4; u += 512) ((LAS unsigned*)(l0 + LDSCTL_OFF))[u] = 0u;
        __syncthreads();
    }
    const int lo = args.ph_lo, hi = args.ph_hi;
    XcdBarrier bar; bar.bar = (unsigned*)(args.ws + WS_CTL) + CW_BAR; bar.x = 0; bar.st = nullptr;
    if (hi - lo > 1) bar = xcd_barrier_post((unsigned*)(args.ws + WS_CTL) + CW_BAR, (volatile LAS unsigned*)((LAS unsigned char*)lds_raw + MISC_OFF) + 8);

#if PROBE_REP > 0
    int ph = lo, rep = 0;
#else
    int ph = lo; constexpr int rep = 0;
#endif
    while (ph < hi) {
        int tid = threadIdx.x; asm volatile("" : "+v"(tid));
        int bx = blockIdx.x; asm volatile("" : "+s"(bx));
        const AS4 unsigned char* kp = (const AS4 unsigned char*)__builtin_amdgcn_kernarg_segment_ptr(); asm volatile("" : "+s"(kp));
        Ctx C;
        unsigned ldsoff = 0; asm volatile("" : "+s"(ldsoff));
        C.lds = (LAS unsigned char*)lds_raw + ldsoff;
        C.tid = tid; C.lane = tid & 63; C.wave = __builtin_amdgcn_readfirstlane(tid >> 6);
        C.G = gridDim.x; C.bx = bx; C.vcu = (C.G % 8 == 0) ? (bx % 8) * (C.G / 8) + bx / 8 : bx;
        C.kp = kp; C.out = *(float* const AS4*)(kp + 232); C.ws = *(unsigned char* const AS4*)(kp + 240);
        if (ph == 0) { const int m1 = (C.bx & 1) ? 12 : 3; phase_p0a(C, m1); phase_p0a(C, 15 ^ m1); if (PROBE_PHASE == 100) { xcd_barrier(bar); phase_p0a(C, PROBE_P0MASK & m1); phase_p0a(C, PROBE_P0MASK & (15 ^ m1)); } }
        else if (ph == 1) { phase_p0b(C); if (PROBE_PHASE == 200) { for (int q = 0; q < 32; ++q) xcd_barrier(bar); } }
        else if (ph == 2) phase_rows<0>(C, 0, 0);
        else {
            const int l = (ph - 3) / 11, st = (ph - 3) % 11;
            const int s = (st < 2) ? 1 : (st < 4) ? st : (st < 6) ? 4 : (st == 6) ? 5 : (st < 9) ? 6 : st - 2;
            const bool tail = (st == 1 || st == 5 || st == 8);
            bf16* Zt = (rep > 0) ? (bf16*)(C.ws + WS_SC) : (bf16*)(C.ws + WS_Z);
            if (s == 1 && !tail) { pg8::Gemm g{((bf16*)(C.ws + WS_XN)) + (size_t)NCTX * DM, ((bf16*)(C.ws + WS_WIN)) + (size_t)l * 2048 * 1024, NLAT, 2048, 1024}; pg8::StaticOrder S; S.init(NLAT, 2048, C.G, C.bx);
                pg8::EpiBf16 E{((bf16*)(C.ws + WS_P)) + (size_t)NCTX * PROJ, PROJ}; pg8::gemm_phase<pg8::EpiBf16, pg8::StaticOrder, PGA, PGS>(C.lds, g, S, E, C.tid); }
            else if (s == 1) {
                CtxEpiP EC{(bf16*)(C.ws + WS_P)}; ctx_gemm(C, (const bf16*)(C.ws + WS_XN), ((const bf16*)(C.ws + WS_WIN)) + (size_t)l * 2048 * 1024, NCTX, (l == DEPTH - 1) ? 256 : 2048, EC); }
            else if (s == 2) phase_mixers(C, l, rep > 0 ? PROBE_MIXSEL : 0);
            else if (s == 3) phase_fixup(C, l);
            else if (s == 4 && !tail) { const int r0 = NCTX;
                pg8::Gemm g{((bf16*)(C.ws + WS_Y)) + (size_t)r0 * DM, ((bf16*)(C.ws + WS_WOUT)) + (size_t)l * 1024 * 1024, NTOK - r0, 1024, 1024}; pg8::StaticOrder S; S.init(NTOK - r0, 1024, C.G, C.bx);
                pg8::EpiResid E{Zt + (size_t)r0 * DM, DM, ((float*)(C.ws + WS_MOD)) + ((size_t)(l * 5) * 6 + 2) * DM, 6 * DM, r0 / 256}; pg8::gemm_phase<pg8::EpiResid, pg8::StaticOrder, PGA, PGS>(C.lds, g, S, E, C.tid); }
            else if (s == 4) { if (l < DEPTH - 1) { CtxEpiResid EC{Zt, ((float*)(C.ws + WS_MOD)) + ((size_t)(l * 5 + 4) * 6 + 2) * DM}; ctx_gemm(C, (const bf16*)(C.ws + WS_Y), ((const bf16*)(C.ws + WS_WOUT)) + (size_t)l * 1024 * 1024, NCTX, 1024, EC); } }
            else if (s == 5) phase_rows<1>(C, l, (l == DEPTH - 1) ? NCTX : 0);
            else if (s == 6 && !tail) { const int r0 = NCTX;
                pg8::Gemm g{((bf16*)(C.ws + WS_XN)) + (size_t)r0 * DM, ((bf16*)(C.ws + WS_WCMB)) + (size_t)l * 2048 * 1024, NTOK - r0, 2048, 1024}; pg8::StaticOrder S; S.init(NTOK - r0, 2048, C.G, C.bx);
                pg8::EpiScoreT E{((unsigned*)(C.ws + WS_SC)), r0}; pg8::gemm_phase<pg8::EpiScoreT, pg8::StaticOrder, PGA, PGS>(C.lds, g, S, E, C.tid); }
            else if (s == 6) { if (l < DEPTH - 1) { CtxEpiScoreT EC{(unsigned*)(C.ws + WS_SC)}; ctx_gemm(C, (const bf16*)(C.ws + WS_XN), ((const bf16*)(C.ws + WS_WCMB)) + (size_t)l * 2048 * 1024, NCTX, 2048, EC); } }
            else if (s == 7) phase_topk(C, (l == DEPTH - 1) ? NCTX : 0);
            else phase_gather(C, l, Zt, rep == 0, (l == DEPTH - 1) ? NCTX : 0);
        }
        bool need_bar = true;
#if PROBE_REP > 0
        { const int st_ = (ph >= 3) ? (ph - 3) % 11 : -1;
          const int s_ = (st_ < 0) ? -1 : (st_ < 2) ? 1 : (st_ < 4) ? st_ : (st_ < 6) ? 4 : (st_ == 6) ? 5 : (st_ < 9) ? 6 : st_ - 2;
          const bool main_gemm = (st_ == 0 || st_ == 4 || st_ == 7);
          if (PROBE_PHASE == 11 && st_ == 1 && rep < PROBE_REP) ++rep;
          else if (PROBE_PHASE == 11) { ++ph; rep = 0; if (main_gemm) need_bar = false; }
          else if (s_ == PROBE_PHASE && rep < PROBE_REP && !main_gemm && st_ != 1 && st_ != 5 && st_ != 8) ++rep;
          else if (s_ == PROBE_PHASE && rep < PROBE_REP && (st_ == 1 || st_ == 5 || st_ == 8)) { ++rep; --ph; }
          else { ++ph; rep = (main_gemm ? rep : 0); if (main_gemm) need_bar = false; } }
#else
        { const int st_ = (ph >= 3) ? (ph - 3) % 11 : -1; need_bar = !(st_ == 0 || st_ == 4 || st_ == 7); ++ph; }
#endif
        if (ph < hi && need_bar) xcd_barrier(bar);
    }
}

extern "C" void kernel_launch(void* const* d_in, const int* in_sizes, int n_in, void* d_out, int out_size, void* d_ws, size_t ws_size, hipStream_t stream) {
    static int grid = 0;
    if (grid == 0) {
        if (n_in != 29 || out_size != NLAT * DM || ws_size < WS_END) { fprintf(stderr, "kernel_launch: unexpected shapes (n_in %d, out %d, ws %zu)\n", n_in, out_size, ws_size); grid = -1; return; }
        int dev = 0, cus = 0, per_cu = 0;
        if (hipGetDevice(&dev) != hipSuccess || hipDeviceGetAttribute(&cus, hipDeviceAttributeMultiprocessorCount, dev) != hipSuccess) { grid = -1; return; }
        if (hipFuncSetAttribute((const void*)mk_fwd, hipFuncAttributeMaxDynamicSharedMemorySize, LDS_BYTES) != hipSuccess) { fprintf(stderr, "kernel_launch: hipFuncSetAttribute failed\n"); grid = -1; return; }
        if (hipOccupancyMaxActiveBlocksPerMultiprocessor(&per_cu, (const void*)mk_fwd, 512, LDS_BYTES) != hipSuccess || per_cu < 1) { fprintf(stderr, "kernel_launch: occupancy query says %d blocks per CU\n", per_cu); (void)hipGetLastError(); grid = -1; return; }
        grid = cus;
    }
    if (grid < 0) return;
    if (hipMemsetAsync((char*)d_ws + WS_CTL, 0, CTL_ZERO_BYTES, stream) != hipSuccess) return;
    Args a{};
    for (int i = 0; i < 29; ++i) a.in[i] = (const float*)d_in[i];
    a.out = (float*)d_out; a.ws = (unsigned char*)d_ws;
#if MK_SINGLE
    a.ph_lo = 0; a.ph_hi = NPH;
    void* kargs[] = {&a};
    hipError_t le = hipLaunchCooperativeKernel((const void*)mk_fwd, dim3(grid), dim3(512), kargs, LDS_BYTES, stream);
    if (le != hipSuccess) fprintf(stderr, "kernel_launch: cooperative launch failed: %s (grid %d)\n", hipGetErrorName(le), grid);
#else
    for (int ph = 0; ph < NPH; ++ph) {
        a.ph_lo = ph; a.ph_hi = ph + 1;
        hipLaunchKernelGGL(mk_fwd, dim3(grid), dim3(512), LDS_BYTES, stream, a);
    }
#endif
}
```
